# Optimizing an MI355X kernel written in HIP

```python
import math
import jax
import jax.numpy as jnp
from jax import lax
import numpy as np

D_MODEL = 1024
BATCH = 4
SEQ = 4096
DEPTH = 2

CTX_LEN = 256
GRID_W = 64
CONV_W = 3
NORM_EPS = 1e-6
F32 = jnp.float32

M_HEADS = 4
M_HEAD_DIM = 64
M_INNER = M_HEADS * M_HEAD_DIM
M_GROUPS = 2
M_STATE = 128
M_CONV_DIM = M_INNER + 2 * M_GROUPS * M_STATE
M_COLS = M_INNER + M_CONV_DIM + 2 * M_HEADS
M_CHUNK = 128

DN_HEADS = 4
DN_HEAD_K = 128
DN_HEAD_V = 128
DN_KD = DN_HEADS * DN_HEAD_K
DN_VD = DN_HEADS * DN_HEAD_V
DN_CONV_DIM = 2 * DN_KD + DN_VD
DN_COLS = DN_CONV_DIM + DN_VD + 4 * DN_HEADS
DN_CHUNK = 64

RW_HEADS = 4
RW_HEAD = 64
RW_DIM = RW_HEADS * RW_HEAD
RW_DECAY_LORA = 64
RW_ICLR_LORA = 64
RW_GATE_LORA = 128
RW_COLS = 3 * RW_DIM + 2 * RW_DECAY_LORA + RW_ICLR_LORA + RW_GATE_LORA
RW_LN_EPS = RW_HEAD * 1e-5

IN_COLS = M_COLS + DN_COLS + RW_COLS
MIX_OUT = M_INNER + DN_VD + RW_DIM

N_EXPERTS = 32
TOP_K = 4
D_FF = 1024
SWIGLU_ALPHA = 1.702
SWIGLU_LIMIT = 7.0
MOE_BLOCK = 256

kernel_name = 'hybrid_ssd_deltanet_rwkv7_moe_prefix_dit'


def split_cols(t, sizes):
    return jnp.split(t, [int(o) for o in np.cumsum(sizes)[:-1]], axis=-1)


def rms_norm(t, w, eps=NORM_EPS):
    tf = t.astype(F32)
    y = tf * lax.rsqrt(jnp.mean(tf * tf, axis=-1, keepdims=True) + eps)
    return (y * w).astype(t.dtype)


def l2norm(t, eps=1e-6):
    return t * lax.rsqrt(jnp.sum(t * t, axis=-1, keepdims=True) + eps)


def modulate(h, shift, scale):
    return h * (1 + scale) + shift


def centred_conv(t, w):
    half = CONV_W // 2
    n = t.shape[1]
    tp = jnp.pad(t, ((0, 0), (half, half), (0, 0)))
    out = tp[:, 0:n] * w[0]
    for j in range(1, CONV_W):
        out = out + tp[:, j:j + n] * w[j]
    return out


def to_col_major(t, rows):
    b, n, ch = t.shape
    return t.reshape(b, rows, GRID_W, ch).transpose(0, 2, 1, 3).reshape(b, n, ch)


def to_raster(t, rows):
    b, n, ch = t.shape
    return t.reshape(b, GRID_W, rows, ch).transpose(0, 2, 1, 3).reshape(b, n, ch)


def q_shift(t, rows):
    b, n, ch = t.shape
    g = t.reshape(b, rows, GRID_W, ch)
    from_left = jnp.pad(g[:, :, :-1], ((0, 0), (0, 0), (1, 0), (0, 0)))
    from_right = jnp.pad(g[:, :, 1:], ((0, 0), (0, 0), (0, 1), (0, 0)))
    from_up = jnp.pad(g[:, :-1], ((0, 0), (1, 0), (0, 0), (0, 0)))
    from_down = jnp.pad(g[:, 1:], ((0, 0), (0, 1), (0, 0), (0, 0)))
    sel = jnp.arange(ch) % 4
    out = jnp.where(sel == 0, from_left, jnp.where(sel == 1, from_right, jnp.where(sel == 2, from_up, from_down)))
    return out.reshape(b, n, ch)


def bi_shift(t):
    prev = jnp.pad(t[:, :-1], ((0, 0), (1, 0), (0, 0)))
    nxt = jnp.pad(t[:, 1:], ((0, 0), (0, 1), (0, 0)))
    return jnp.where(jnp.arange(t.shape[-1]) % 2 == 0, prev, nxt)


def two_segment_scan(scan_fn, ctx_args, lat_args, state0, reverse):
    flip = (lambda t: jnp.flip(t, axis=1)) if reverse else (lambda t: t)
    y_c, s_c = scan_fn(*[flip(t) for t in ctx_args], state0)
    y_l, _ = scan_fn(*[flip(t) for t in lat_args], s_c)
    return flip(y_c), flip(y_l)


def ssd_chunk_scan(xs, log_a, bm, cm, h0):
    b, n, H, P = xs.shape
    nc = n // M_CHUNK
    ch = lambda t: t.reshape((b, nc, M_CHUNK) + t.shape[2:])
    xs, log_a, bm, cm = ch(xs), ch(log_a), ch(bm), ch(cm)
    a_cum = jnp.cumsum(log_a, axis=2)
    idx = jnp.arange(M_CHUNK)
    incl = (idx[:, None] >= idx[None, :])[None, None, :, :, None]
    seg = jnp.exp(jnp.where(incl, a_cum[:, :, :, None, :] - a_cum[:, :, None, :, :], -jnp.inf))
    scores = jnp.einsum('bcihn,bcjhn->bcijh', cm, bm) * seg
    y_diag = jnp.einsum('bcijh,bcjhp->bcihp', scores, xs)
    to_end = jnp.exp(a_cum[:, :, -1:] - a_cum)
    states = jnp.einsum('bcjhn,bcjhp->bchpn', bm * to_end[..., None], xs)
    chunk_decay = jnp.exp(a_cum[:, :, -1])

    def step(h, inp):
        s, dec = inp
        return h * dec[:, :, None, None] + s, h

    h_last, h_in = lax.scan(step, h0, (jnp.moveaxis(states, 1, 0), jnp.moveaxis(chunk_decay, 1, 0)))
    h_in = jnp.moveaxis(h_in, 0, 1)
    y_off = jnp.einsum('bcihn,bchpn->bcihp', cm, h_in) * jnp.exp(a_cum)[..., None]
    return (y_diag + y_off).reshape(b, n, H, P), h_last


def gated_delta_chunk_scan(q, k, v, g, beta, s0):
    b, n, H, K = q.shape
    V = v.shape[-1]
    nc = n // DN_CHUNK
    ch = lambda t: t.reshape((b, nc, DN_CHUNK) + t.shape[2:])
    q, k, v, g, beta = ch(q), ch(k), ch(v), ch(g), ch(beta)
    g_cum = jnp.cumsum(g, axis=2)
    idx = jnp.arange(DN_CHUNK)
    incl = idx[:, None] >= idx[None, :]
    strict = idx[:, None] > idx[None, :]
    gh = jnp.moveaxis(g_cum, 3, 2)
    decay = jnp.exp(jnp.where(incl, gh[..., :, None] - gh[..., None, :], -jnp.inf))
    kb = k * beta[..., None]
    lower = jnp.where(strict, jnp.einsum('bcihk,bcjhk->bchij', kb, k) * decay, 0.0)
    eye = jnp.eye(DN_CHUNK, dtype=q.dtype)
    rhs = jnp.concatenate([v * beta[..., None], kb * jnp.exp(g_cum)[..., None]], axis=-1)
    rhs = jnp.moveaxis(rhs, 3, 2)
    sol = lax.linalg.triangular_solve(eye + lower, rhs, left_side=True, lower=True, unit_diagonal=True)
    u, w = sol[..., :V], sol[..., V:]
    attn = jnp.einsum('bcihk,bcjhk->bchij', q, k) * decay
    q_dec = jnp.moveaxis(q * jnp.exp(g_cum)[..., None], 3, 2)
    k_dec = jnp.moveaxis(k * jnp.exp(g_cum[:, :, -1:] - g_cum)[..., None], 3, 2)
    g_last = jnp.exp(g_cum[:, :, -1])

    def step(S, inp):
        u_i, w_i, attn_i, qd_i, kd_i, gl_i = inp
        v_new = u_i - jnp.einsum('bhck,bhkv->bhcv', w_i, S)
        o = jnp.einsum('bhck,bhkv->bhcv', qd_i, S) + jnp.einsum('bhij,bhjv->bhiv', attn_i, v_new)
        S = S * gl_i[..., None, None] + jnp.einsum('bhck,bhcv->bhkv', kd_i, v_new)
        return S, o

    xs = tuple(jnp.moveaxis(t, 1, 0) for t in (u, w, attn, q_dec, k_dec, g_last))
    s_last, o = lax.scan(step, s0, xs)
    o = jnp.transpose(o, (1, 0, 3, 2, 4)).reshape(b, n, H, V)
    return o, s_last


def rwkv7_scan(r, log_w, k, v, a_vec, b_vec, s0):
    def step(S, inp):
        r_t, w_t, k_t, v_t, a_t, b_t = inp
        sa = jnp.einsum('bhvk,bhk->bhv', S, a_t)
        S = S * w_t[:, :, None, :] + sa[..., None] * b_t[:, :, None, :] + v_t[..., None] * k_t[:, :, None, :]
        return S, jnp.einsum('bhvk,bhk->bhv', S, r_t)

    xs = tuple(jnp.moveaxis(t, 1, 0) for t in (r, jnp.exp(log_w), k, v, a_vec, b_vec))
    s_last, y = lax.scan(step, s0, xs)
    return jnp.moveaxis(y, 0, 1), s_last


def mamba2_mixer(p_c, p_l, conv_w, conv_b, dt_bias, a_log, d_skip, norm_w):
    a_neg = -jnp.exp(a_log.astype(F32))
    rep = M_HEADS // M_GROUPS

    def prep(p):
        b, n = p.shape[:2]
        z, xbc, dt_raw = split_cols(p, (M_INNER, M_CONV_DIM, 2 * M_HEADS))
        xbc = jax.nn.silu(centred_conv(xbc, conv_w) + conv_b)
        xs, bm, cm = split_cols(xbc, (M_INNER, M_GROUPS * M_STATE, M_GROUPS * M_STATE))
        grp = lambda t: jnp.repeat(t.astype(F32).reshape(b, n, M_GROUPS, M_STATE), rep, axis=2)
        return z, xs.astype(F32).reshape(b, n, M_HEADS, M_HEAD_DIM), grp(bm), grp(cm), dt_raw.astype(F32)

    def scan_args(direction, xs, bm, cm, dt_raw):
        dt = jax.nn.softplus(dt_raw[..., direction * M_HEADS:(direction + 1) * M_HEADS] + dt_bias[direction])
        return (xs * dt[..., None], dt * a_neg[direction], bm, cm)

    zc, xc, bc, cc, dtc = prep(p_c)
    zl, xl, bl, cl, dtl = prep(p_l)
    state0 = jnp.zeros((p_c.shape[0], M_HEADS, M_HEAD_DIM, M_STATE), F32)
    yc = xc * d_skip[:, None]
    yl = xl * d_skip[:, None]
    for direction in range(2):
        oc, ol = two_segment_scan(ssd_chunk_scan, scan_args(direction, xc, bc, cc, dtc),
                                  scan_args(direction, xl, bl, cl, dtl), state0, direction == 1)
        yc, yl = yc + oc, yl + ol

    def finish(y, z):
        b, n = z.shape[:2]
        y = y.reshape(b, n, M_INNER) * jax.nn.silu(z.astype(F32))
        y = y.reshape(b, n, M_GROUPS, M_INNER // M_GROUPS)
        y = y * lax.rsqrt(jnp.mean(y * y, axis=-1, keepdims=True) + 1e-5)
        return (y.reshape(b, n, M_INNER) * norm_w).astype(z.dtype)

    return finish(yc, zc), finish(yl, zl)


def gated_deltanet_mixer(p_c, p_l, rows, conv_w, dt_bias, a_log, norm_w):
    a_pos = jnp.exp(a_log.astype(F32))

    def prep(p):
        b, n = p.shape[:2]
        qkv, gate, beta_raw, a_raw = split_cols(p, (DN_CONV_DIM, DN_VD, 2 * DN_HEADS, 2 * DN_HEADS))
        qkv = jax.nn.silu(centred_conv(qkv, conv_w)).astype(F32)
        q, k, v = split_cols(qkv, (DN_KD, DN_KD, DN_VD))
        q = l2norm(q.reshape(b, n, DN_HEADS, DN_HEAD_K)) * DN_HEAD_K ** -0.5
        k = l2norm(k.reshape(b, n, DN_HEADS, DN_HEAD_K))
        v = v.reshape(b, n, DN_HEADS, DN_HEAD_V)
        return q, k, v, gate, beta_raw.astype(F32), a_raw.astype(F32)

    def scan_args(direction, q, k, v, beta_raw, a_raw):
        sl = slice(direction * DN_HEADS, (direction + 1) * DN_HEADS)
        beta = jax.nn.sigmoid(beta_raw[..., sl])
        g = -a_pos[direction] * jax.nn.softplus(a_raw[..., sl] + dt_bias[direction])
        return (q, k, v, g, beta)

    qc, kc, vc, gate_c, brc, arc = prep(p_c)
    ql, kl, vl, gate_l, brl, arl = prep(to_col_major(p_l, rows))
    state0 = jnp.zeros((p_c.shape[0], DN_HEADS, DN_HEAD_K, DN_HEAD_V), F32)
    oc, ol = 0.0, 0.0
    for direction in range(2):
        dc, dl = two_segment_scan(gated_delta_chunk_scan, scan_args(direction, qc, kc, vc, brc, arc),
                                  scan_args(direction, ql, kl, vl, brl, arl), state0, direction == 1)
        oc, ol = oc + dc, ol + dl

    def finish(o, gate):
        b, n = gate.shape[:2]
        o = o * lax.rsqrt(jnp.mean(o * o, axis=-1, keepdims=True) + 1e-6) * norm_w
        return (o.reshape(b, n, DN_VD) * jax.nn.silu(gate.astype(F32))).astype(gate.dtype)

    return finish(oc, gate_c), to_raster(finish(ol, gate_l), rows)


def rwkv7_mixer(p_c, p_l, rows, mu, w0, w2, a0, a2, g2, k_k, k_a, r_k, ln_w, ln_b):
    def prep(p, shifted):
        b, n = p.shape[:2]
        p = p + (shifted - p) * mu
        r, k, v, wd, ad, gd = split_cols(p, (RW_DIM, RW_DIM, RW_DIM, 2 * RW_DECAY_LORA, RW_ICLR_LORA, RW_GATE_LORA))
        heads = lambda t: t.astype(F32).reshape(b, n, RW_HEADS, RW_HEAD)
        a = jax.nn.sigmoid(a0 + ad @ a2)
        g = jax.nn.sigmoid(gd) @ g2
        kk = l2norm(heads(k * k_k))
        k = k * (1 + (a - 1) * k_a)
        log_w = [heads(-jnp.exp(-jax.nn.softplus(-(w0[j] + jnp.tanh(wd_j) @ w2[j]).astype(F32)) - 0.5))
                 for j, wd_j in enumerate(jnp.split(wd, 2, axis=-1))]
        return heads(r), heads(k), heads(v), kk, heads(a), g, log_w

    rc, kc, vc, kkc, ac, gc, lwc = prep(p_c, bi_shift(p_c))
    rl, kl, vl, kkl, al, gl, lwl = prep(p_l, q_shift(p_l, rows))
    state0 = jnp.zeros((p_c.shape[0], RW_HEADS, RW_HEAD, RW_HEAD), F32)
    yc, yl = 0.0, 0.0
    for j in range(2):
        oc, ol = two_segment_scan(rwkv7_scan, (rc, lwc[j], kc, vc, -kkc, kkc * ac),
                                  (rl, lwl[j], kl, vl, -kkl, kkl * al), state0, j == 1)
        yc, yl = yc + oc, yl + ol

    def finish(y, r, k, v, g):
        b, n = y.shape[:2]
        mean = jnp.mean(y, axis=-1, keepdims=True)
        var = jnp.mean(jnp.square(y - mean), axis=-1, keepdims=True)
        y = ((y - mean) * lax.rsqrt(var + RW_LN_EPS)).reshape(b, n, RW_DIM) * ln_w + ln_b
        bonus = (jnp.sum(r * k * r_k, axis=-1, keepdims=True) * v).reshape(b, n, RW_DIM)
        return ((y + bonus) * g).astype(p_c.dtype)

    return finish(yc, rc, kc, vc, gc), finish(yl, rl, kl, vl, gl)


def moe_ffn(h, w_router, b_router, w_gate_up, b_gate_up, w_down, b_down):
    n, d = h.shape
    logits = (h @ w_router).astype(F32) + b_router
    top_logit, top_e = lax.top_k(logits, TOP_K)
    gate = jax.nn.softmax(top_logit, axis=-1)
    nk = n * TOP_K
    flat_e = top_e.reshape(nk)
    flat_tok = jnp.arange(nk, dtype=jnp.int32) // TOP_K
    order = jnp.argsort(flat_e)
    sorted_e = flat_e[order]
    counts = jnp.bincount(flat_e, length=N_EXPERTS)
    padded = (counts + MOE_BLOCK - 1) // MOE_BLOCK * MOE_BLOCK
    pad_start = jnp.cumsum(padded) - padded
    start = jnp.cumsum(counts) - counts
    dest = pad_start[sorted_e] + jnp.arange(nk) - start[sorted_e]
    n_blocks = -(-nk // MOE_BLOCK) + N_EXPERTS
    slots = n_blocks * MOE_BLOCK
    slot_tok = jnp.full((slots,), n, jnp.int32).at[dest].set(flat_tok[order])
    slot_gate = jnp.zeros((slots,), h.dtype).at[dest].set(gate.reshape(nk)[order].astype(h.dtype))
    block_end = jnp.cumsum(padded) // MOE_BLOCK
    block_expert = jnp.minimum(jnp.searchsorted(block_end, jnp.arange(n_blocks), side='right'), N_EXPERTS - 1)
    h_pad = jnp.concatenate([h, jnp.zeros((1, d), h.dtype)], axis=0)

    def expert_block(args):
        tok, e = args
        gu = h_pad[tok] @ w_gate_up[e] + b_gate_up[e]
        g_, u_ = jnp.split(gu, 2, axis=-1)
        g_ = jnp.minimum(g_, SWIGLU_LIMIT)
        u_ = jnp.clip(u_, -SWIGLU_LIMIT, SWIGLU_LIMIT)
        act = g_ * jax.nn.sigmoid(SWIGLU_ALPHA * g_) * (u_ + 1)
        return act @ w_down[e] + b_down[e]

    y_slots = lax.map(expert_block, (slot_tok.reshape(n_blocks, MOE_BLOCK), block_expert))
    out = jnp.zeros((n + 1, d), h.dtype).at[slot_tok].add(y_slots.reshape(slots, d) * slot_gate[:, None])
    return out[:n]


def setup_inputs(seed: int = 0) -> dict:
    key = jax.random.key(seed)
    ks = iter(jax.random.split(key, 48))
    nrm = lambda shape, scale: scale * jax.random.normal(next(ks), shape, F32)
    unif = lambda shape, lo, hi: jax.random.uniform(next(ks), shape, F32, lo, hi)
    gain = lambda shape: 1.0 + nrm(shape, 0.01)

    def dt_bias(shape):
        dt = jnp.exp(unif(shape, math.log(1e-3), math.log(1e-1)))
        return dt + jnp.log(-jnp.expm1(-dt))

    L, D = DEPTH, D_MODEL
    return {
        'x': nrm((BATCH, SEQ, D), 1.0),
        'c': nrm((BATCH, D), 1.0),
        'ctx': nrm((BATCH, CTX_LEN, D), 1.0),
        'c_ctx': nrm((D,), 1.0),
        'w_mod': nrm((L, D, 6 * D), 0.5 * D ** -0.5),
        'b_mod': nrm((L, 6 * D), 0.01),
        'norm1_w': gain((L, D)),
        'norm2_w': gain((L, D)),
        'w_in': nrm((L, D, IN_COLS), D ** -0.5),
        'w_out': nrm((L, MIX_OUT, D), MIX_OUT ** -0.5),
        'm_conv_w': nrm((L, CONV_W, M_CONV_DIM), CONV_W ** -0.5),
        'm_conv_b': nrm((L, M_CONV_DIM), 0.01),
        'm_dt_bias': dt_bias((L, 2, M_HEADS)),
        'm_a_log': jnp.log(unif((L, 2, M_HEADS), 1.0, 16.0)),
        'm_d': 1.0 + nrm((L, M_HEADS), 0.1),
        'm_norm_w': gain((L, M_INNER)),
        'dn_conv_w': nrm((L, CONV_W, DN_CONV_DIM), CONV_W ** -0.5),
        'dn_dt_bias': dt_bias((L, 2, DN_HEADS)),
        'dn_a_log': jnp.log(unif((L, 2, DN_HEADS), 1.0, 16.0)),
        'dn_norm_w': gain((L, DN_HEAD_V)),
        'rw_mu': unif((L, RW_COLS), 0.0, 1.0),
        'rw_w0': unif((L, 2, RW_DIM), -5.0, 0.0),
        'rw_w2': nrm((L, 2, RW_DECAY_LORA, RW_DIM), 0.1 * RW_DECAY_LORA ** -0.5),
        'rw_a0': nrm((L, RW_DIM), 0.1),
        'rw_a2': nrm((L, RW_ICLR_LORA, RW_DIM), 0.1 * RW_ICLR_LORA ** -0.5),
        'rw_g2': nrm((L, RW_GATE_LORA, RW_DIM), RW_GATE_LORA ** -0.5),
        'rw_k_k': 0.85 + nrm((L, RW_DIM), 0.05),
        'rw_k_a': 1.0 + nrm((L, RW_DIM), 0.05),
        'rw_r_k': nrm((L, RW_HEADS, RW_HEAD), 0.1),
        'rw_ln_w': gain((L, RW_DIM)),
        'rw_ln_b': nrm((L, RW_DIM), 0.01),
        'w_router': nrm((L, D, N_EXPERTS), D ** -0.5),
        'b_router': nrm((L, N_EXPERTS), 0.01),
        'w_gate_up': nrm((L, N_EXPERTS, D, 2 * D_FF), D ** -0.5),
        'b_gate_up': nrm((L, N_EXPERTS, 2 * D_FF), 0.01),
        'w_down': nrm((L, N_EXPERTS, D_FF, D), D_FF ** -0.5),
        'b_down': nrm((L, N_EXPERTS, D), 0.01),
        'norm_f_w': gain((D,)),
    }


def reference(x, c, ctx, c_ctx, w_mod, b_mod, norm1_w, norm2_w, w_in, w_out,
              m_conv_w, m_conv_b, m_dt_bias, m_a_log, m_d, m_norm_w,
              dn_conv_w, dn_dt_bias, dn_a_log, dn_norm_w,
              rw_mu, rw_w0, rw_w2, rw_a0, rw_a2, rw_g2, rw_k_k, rw_k_a, rw_r_k, rw_ln_w, rw_ln_b,
              w_router, b_router, w_gate_up, b_gate_up, w_down, b_down, norm_f_w):
    seq, d = x.shape[1], x.shape[2]
    rows = seq // GRID_W
    x_l, x_c = x, ctx
    silu_c = jax.nn.silu(c)
    silu_cc = jax.nn.silu(c_ctx)
    for i in range(DEPTH):
        last = i == DEPTH - 1
        mod_l = jnp.split((silu_c @ w_mod[i] + b_mod[i])[:, None, :], 6, axis=-1)
        mod_c = jnp.split(silu_cc @ w_mod[i] + b_mod[i], 6, axis=-1)
        h_l = modulate(rms_norm(x_l, norm1_w[i]), mod_l[0], mod_l[1])
        h_c = modulate(rms_norm(x_c, norm1_w[i]), mod_c[0], mod_c[1])
        pa_l, pb_l, pc_l = split_cols(h_l @ w_in[i], (M_COLS, DN_COLS, RW_COLS))
        pa_c, pb_c, pc_c = split_cols(h_c @ w_in[i], (M_COLS, DN_COLS, RW_COLS))
        ya_c, ya_l = mamba2_mixer(pa_c, pa_l, m_conv_w[i], m_conv_b[i], m_dt_bias[i], m_a_log[i], m_d[i], m_norm_w[i])
        yb_c, yb_l = gated_deltanet_mixer(pb_c, pb_l, rows, dn_conv_w[i], dn_dt_bias[i], dn_a_log[i], dn_norm_w[i])
        yc_c, yc_l = rwkv7_mixer(pc_c, pc_l, rows, rw_mu[i], rw_w0[i], rw_w2[i], rw_a0[i], rw_a2[i], rw_g2[i],
                                 rw_k_k[i], rw_k_a[i], rw_r_k[i], rw_ln_w[i], rw_ln_b[i])
        x_l = x_l + mod_l[2] * (jnp.concatenate([ya_l, yb_l, yc_l], axis=-1) @ w_out[i])
        h2_l = modulate(rms_norm(x_l, norm2_w[i]), mod_l[3], mod_l[4])
        moe_args = (w_router[i], b_router[i], w_gate_up[i], b_gate_up[i], w_down[i], b_down[i])
        if last:
            x_l = x_l + mod_l[5] * moe_ffn(h2_l.reshape(-1, d), *moe_args).reshape(x_l.shape)
        else:
            x_c = x_c + mod_c[2] * (jnp.concatenate([ya_c, yb_c, yc_c], axis=-1) @ w_out[i])
            h2_c = modulate(rms_norm(x_c, norm2_w[i]), mod_c[3], mod_c[4])
            n_c = h2_c.shape[0] * h2_c.shape[1]
            f = moe_ffn(jnp.concatenate([h2_c.reshape(-1, d), h2_l.reshape(-1, d)], axis=0), *moe_args)
            x_c = x_c + mod_c[5] * f[:n_c].reshape(x_c.shape)
            x_l = x_l + mod_l[5] * f[n_c:].reshape(x_l.shape)
    return rms_norm(x_l, norm_f_w)
```

```cpp
#include <hip/hip_runtime.h>
#include <cstdio>
#include <cstdint>

#ifndef PROBE_REP
#define PROBE_REP 0
#endif
#define REPN(k) ((((PROBE_REP) >> (k)) & 1) + 1)
#ifndef PROBE_SCAN
#define PROBE_SCAN 0
#endif
#ifndef PROBE_MIX
#define PROBE_MIX 0
#endif
#ifndef MIXPARTS
#define MIXPARTS 7
#endif
#ifndef MK_PER_PHASE
#define MK_PER_PHASE 0
#endif

#define GAS __attribute__((address_space(1)))
#define LAS __attribute__((address_space(3)))
typedef unsigned short bf16_t;
typedef short bf16x8 __attribute__((ext_vector_type(8)));
typedef float f32x4 __attribute__((ext_vector_type(4)));
typedef unsigned u32x4 __attribute__((ext_vector_type(4)));
typedef unsigned u32x2 __attribute__((ext_vector_type(2)));

constexpr int D = 1024, NB = 4, SEQ = 4096, CTXL = 256;
constexpr int NL = NB * SEQ, NC = NB * CTXL, MALL = NL + NC;
constexpr int INC = 4184, INP = 4352;
constexpr int DN_OFF = 1032, RW_OFF = 3096;
constexpr int NE = 32, DFF = 1024;
constexpr int MAXBLK = 304, MAXSLOT = MAXBLK * 256;
constexpr int NPHASE = 22;

constexpr size_t MiB = 1u << 20;
constexpr size_t WS_CTL = 0, CTL_BYTES = 1 * MiB;
constexpr size_t WS_MOD = 1 * MiB;
constexpr size_t WS_LORA = 1 * MiB + 512 * 1024;
constexpr size_t WS_TOK = 1332 * MiB, TOK_STRIDE = 2 * MiB;
constexpr size_t WS_WIN = 4 * MiB, WS_WOUT = 21 * MiB, WS_WGU = 25 * MiB, WS_WD = 281 * MiB;
constexpr size_t WS_XA = 409 * MiB, WS_XB = 477 * MiB, WS_HN = 545 * MiB, WS_YMIX = 579 * MiB;
constexpr size_t WS_P = 613 * MiB, WS_MXBC = 902 * MiB, WS_MDT = 953 * MiB, WS_DNQKV = 955 * MiB, WS_DNGB = 1057 * MiB;
constexpr size_t WS_RWW = 1108 * MiB;
constexpr size_t WS_RW = 1060 * MiB, WS_RWG = 1179 * MiB, WS_YM = 1196 * MiB, WS_ODN = 1230 * MiB, WS_YRW = 1298 * MiB;
constexpr size_t WS_DNC = 1336 * MiB, WS_DNU = 1482 * MiB, WS_DNG = 1550 * MiB, WS_MBC = 1551 * MiB, WS_RWC = 1585 * MiB, WS_END = 1724 * MiB;
constexpr int DN_NSUB = (CTXL + SEQ) / 16, DN_UNITS = 32 * DN_NSUB, MB_UNITS = 8 * DN_NSUB;
constexpr int DN_UNITS_DUMMY = 0;
constexpr size_t WS_HS = WS_P, WS_ACT = 765 * MiB, WS_Y = 917 * MiB;
constexpr int CW_CNT = 64;
constexpr int CW_BAR = 4096;
constexpr int TK_E = 0, TK_G = MALL * 4, TK_POS = MALL * 8, TK_SLOT = MALL * 12, TK_BLKE = MALL * 16, TK_NBLK = MALL * 16 + 512, TK_BCNT = MALL * 16 + 1024;

constexpr int RING_BYTES = 131072, LDS_BYTES = 147456, MISC_OFF = LDS_BYTES - 256;

struct Args { const float* in[38]; float* out; unsigned char* ws; int ph_lo, ph_hi; };

__device__ __forceinline__ unsigned f2bf(float f) { unsigned u = __builtin_bit_cast(unsigned, f); return (u + 0x7fffu + ((u >> 16) & 1u)) >> 16; }
__device__ __forceinline__ unsigned pk2(float lo, float hi) { return f2bf(lo) | (f2bf(hi) << 16); }
__device__ __forceinline__ f32x4 ldp4(const bf16_t* p) { const u32x2 v = *(const u32x2*)p; return (f32x4){__builtin_bit_cast(float, v.x << 16), __builtin_bit_cast(float, v.x & 0xffff0000u), __builtin_bit_cast(float, v.y << 16), __builtin_bit_cast(float, v.y & 0xffff0000u)}; }
__device__ __forceinline__ float frcp(float x) { return __builtin_amdgcn_rcpf(x); }
__device__ __forceinline__ float frsq(float x) { return __builtin_amdgcn_rsqf(x); }
typedef __bf16 bf16x2_t __attribute__((ext_vector_type(2)));
typedef float f32x2_ __attribute__((ext_vector_type(2)));
__device__ __forceinline__ unsigned cvt2(float lo, float hi) { const f32x2_ v = {lo, hi}; return __builtin_bit_cast(unsigned, __builtin_convertvector(v, bf16x2_t)); }
__device__ __forceinline__ float siluf(float x) { return x * frcp(1.f + __expf(-x)); }
__device__ __forceinline__ float sigm(float x) { return frcp(1.f + __expf(-x)); }
__device__ __forceinline__ float softplusf(float x) { return fmaxf(x, 0.f) + __logf(1.f + __expf(-fabsf(x))); }
__device__ __forceinline__ float tanh_fast(float x) { return 1.f - 2.f * frcp(__expf(2.f * x) + 1.f); }
template <int CTRL> __device__ __forceinline__ float dppf(float v) { return __builtin_bit_cast(float, __builtin_amdgcn_update_dpp(0, __builtin_bit_cast(int, v), CTRL, 0xF, 0xF, true)); }
__device__ __forceinline__ void pswap16(float& a, float& b) { asm("s_nop 1\n\tv_permlane16_swap_b32 %0, %1" : "+v"(a), "+v"(b)); }
__device__ __forceinline__ void pswap32(float& a, float& b) { asm("s_nop 1\n\tv_permlane32_swap_b32 %0, %1" : "+v"(a), "+v"(b)); }
template <int W> __device__ __forceinline__ float grp_sum(float v) {
    v += dppf<0xB1>(v); v += dppf<0x4E>(v); v += dppf<0x141>(v); v += dppf<0x140>(v);
    if (W >= 32) { float a = v, b = v; pswap16(a, b); v = a + b; }
    if (W >= 64) { float a = v, b = v; pswap32(a, b); v = a + b; }
    return v;
}
__device__ __forceinline__ float wave_sum(float v) { return grp_sum<64>(v); }
__device__ __forceinline__ float wave_max(float v) {
    v = fmaxf(v, dppf<0xB1>(v)); v = fmaxf(v, dppf<0x4E>(v)); v = fmaxf(v, dppf<0x141>(v)); v = fmaxf(v, dppf<0x140>(v));
    { float a = v, b = v; pswap16(a, b); v = fmaxf(a, b); }
    { float a = v, b = v; pswap32(a, b); v = fmaxf(a, b); }
    return v;
}
#define LDS_WAIT() asm volatile("s_waitcnt lgkmcnt(0)" ::: "memory")
__device__ __forceinline__ int lane_id_v() { int l; asm volatile("v_mbcnt_lo_u32_b32 %0, -1, 0\n\tv_mbcnt_hi_u32_b32 %0, -1, %0" : "=v"(l)); return l; }
__device__ __forceinline__ int opq(int v) { asm volatile("" : "+v"(v)); return v; }

#define XB_TMO      128
#define XB_XCNT(j)  (256  + 64 * (j))
#define XB_XSUB(j)  (1280 + 64 * (j))
#define XB_XGEN(j)  (2304 + 64 * (j))
#define XB_TOP      3328
#define XB_TOPGEN   3392
#define XCD_BAR_WORDS 3456
#define XB_SPIN_CAP (1u << 18)
__device__ __forceinline__ unsigned xb_ld(unsigned* p)              { return __hip_atomic_load(p, __ATOMIC_RELAXED, __HIP_MEMORY_SCOPE_AGENT); }
__device__ __forceinline__ unsigned xb_add(unsigned* p, unsigned v) { return __hip_atomic_fetch_add(p, v, __ATOMIC_RELAXED, __HIP_MEMORY_SCOPE_AGENT); }
__device__ __forceinline__ unsigned xb_xcc_id() { return (unsigned)__builtin_amdgcn_s_getreg((3 << 11) | 20) & 0xFu; }
#define XB_SPIN(cond, bar) do { unsigned _sp = 0; while (cond) { __builtin_amdgcn_s_sleep(1); \
    if ((++_sp & 255u) == 0u) { if (xb_ld(&(bar)[XB_TMO])) break; if (_sp > XB_SPIN_CAP) { atomicAdd(&(bar)[XB_TMO], 1u); break; } } } } while (0)
struct XcdBarrier { unsigned* bar; unsigned x; volatile LAS unsigned* st; };
__device__ __forceinline__ XcdBarrier xcd_barrier_post(unsigned* bar, volatile LAS unsigned* st) {
    XcdBarrier b; b.bar = bar; b.x = xb_xcc_id(); b.st = st;
    if (threadIdx.x == 0) (void)xb_add(&bar[XB_XCNT(b.x)], 1u);
    return b;
}
__device__ __forceinline__ void xcd_barrier_complete(unsigned* bar, unsigned x, unsigned& nloc, unsigned& nx) {
    const unsigned G = gridDim.x * gridDim.y * gridDim.z;
    unsigned sum, cnt, mine, sp = 0u;
    for (;;) {
        sum = 0u; cnt = 0u; mine = 0u;
#pragma unroll
        for (unsigned j = 0; j < 16; ++j) { const unsigned c = xb_ld(&bar[XB_XCNT(j)]); sum += c; cnt += (c > 0u) ? 1u : 0u; mine = (j == x) ? c : mine; }
        if (sum == G) break;
        __builtin_amdgcn_s_sleep(1);
        if ((++sp & 255u) == 0u) { if (xb_ld(&bar[XB_TMO])) break; if (sp > XB_SPIN_CAP) { atomicAdd(&bar[XB_TMO], 1u); break; } }
    }
    nloc = mine > 0u ? mine : 1u; nx = cnt > 0u ? cnt : 1u;
}
__device__ __forceinline__ void xcd_barrier(const XcdBarrier& b) {
    asm volatile("s_waitcnt vmcnt(0)" ::: "memory");
    __syncthreads();
    if (threadIdx.x == 0) {
        unsigned* bar = b.bar;
        __builtin_amdgcn_s_waitcnt(0);
        unsigned nloc = b.st[0], nx = b.st[1];
        if (nloc == 0u) { xcd_barrier_complete(bar, b.x, nloc, nx); b.st[0] = nloc; b.st[1] = nx; }
        const unsigned old = xb_add(&bar[XB_XSUB(b.x)], 1u);
        const unsigned gen = old / nloc;
        if (old + 1u == (gen + 1u) * nloc) {
            __builtin_amdgcn_fence(__ATOMIC_RELEASE, "agent");
            asm volatile("s_waitcnt vmcnt(0)" ::: "memory");
            const unsigned og = xb_add(&bar[XB_TOP], 1u);
            const unsigned tg = og / nx;
            if (og + 1u == (tg + 1u) * nx) xb_add(&bar[XB_TOPGEN], 1u);
            else XB_SPIN(xb_ld(&bar[XB_TOPGEN]) == tg, bar);
            __builtin_amdgcn_fence(__ATOMIC_ACQUIRE, "agent");
            xb_add(&bar[XB_XGEN(b.x)], 1u);
            asm volatile("s_waitcnt vmcnt(0)" ::: "memory");
        } else {
            XB_SPIN(xb_ld(&bar[XB_XGEN(b.x)]) == gen, bar);
            __builtin_amdgcn_fence(__ATOMIC_ACQUIRE, "agent");
            asm volatile("s_waitcnt vmcnt(0)" ::: "memory");
        }
    }
    __syncthreads();
}

namespace pg8 {
constexpr int BM = 256, BK = 64, HALF = 128, HTB = HALF * BK * 2, STAGE_BYTES = 8 * HTB, NXCD = 8, WGM = 8;
__host__ __device__ __forceinline__ int lds_byte(int r, int c) { const int st = (r >> 4) * 2 + (c >> 5), rr = r & 15, cc = c & 31, ob = rr * 64 + cc * 2; return st * 1024 + (ob ^ (((ob >> 9) & 1) << 5)); }
__host__ __device__ __forceinline__ void stage_rc(int b, int& R, int& C) { const int st = b / 1024, sb = b % 1024, swz = sb ^ (((sb >> 9) & 1) << 5); R = (st >> 1) * 16 + swz / 64; C = (st & 1) * 32 + (swz % 64) / 2; }
struct Unit { int pm, pn; };

struct StaticSched {
    int nM, nN, nwg, G, c; const char* A; const char* Bt; size_t tstep;
    __device__ void init(const bf16_t* A_, const bf16_t* Bt_, int M, int N, int K, int G_, int c_) { nM = M / BM; nN = N / BM; nwg = nM * nN; G = G_; c = c_; A = (const char*)A_; Bt = (const char*)Bt_; tstep = (size_t)BM * K * 2; }
    __device__ bool next(int i, Unit& u) const {
        const long L = (long)i * G + c; if (L >= nwg) return false;
        int wgid = (int)L; { const int q = nwg / NXCD, r = nwg % NXCD, xcd = wgid % NXCD, off = wgid / NXCD; wgid = (xcd < r ? xcd * (q + 1) : r * (q + 1) + (xcd - r) * q) + off; }
        const int nig = WGM * nN, gid = wgid / nig, fm = gid * WGM, gsz = (nM - fm) < WGM ? (nM - fm) : WGM;
        u.pm = fm + ((wgid % nig) % gsz); u.pn = (wgid % nig) / gsz; return true;
    }
    __device__ __forceinline__ const char* a_base(const Unit& u) const { return A + (size_t)u.pm * tstep; }
    __device__ __forceinline__ const char* b_base(const Unit& u) const { return Bt + (size_t)u.pn * tstep; }
};
struct MoeSched {
    int nunits, nN, G, c; const char* A; const char* W; size_t tstep, estride; const int* blk_e;
    __device__ bool next(int i, Unit& u) const {
        long L;
        if ((G & 7) == 0) { const int per = (nunits + 7) >> 3, v = i * (G >> 3) + (c >> 3); if (v >= per) return false; L = (long)(c & 7) * per + v; }
        else L = (long)i * G + c;
        if (L >= nunits) return false; u.pm = (int)(L / nN); u.pn = (int)(L % nN); return true; }
    __device__ __forceinline__ const char* a_base(const Unit& u) const { return A + (size_t)u.pm * tstep; }
    __device__ __forceinline__ const char* b_base(const Unit& u) const { return W + (size_t)blk_e[u.pm] * estride + (size_t)u.pn * tstep; }
};

template <class Epi, class Sched>
__device__ __forceinline__ void gemm_phase(LAS unsigned char* lds, const int K, const Sched& S, const Epi& E, const int wave0) {
    const int lane = lane_id_v(), wid = wave0, tid = wid * 64 + lane, wr = wid >> 2, wc = wid & 3, fr = lane & 15, fq = lane >> 4;
    const int nt = K / BK;
    unsigned voffA[2], voffB[2];
#pragma unroll
    for (int i = 0; i < 2; ++i) { int R, C; stage_rc(tid * 16 + i * 8192, R, C); voffA[i] = (unsigned)(R * K + C) * 2u; voffB[i] = voffA[i]; }
    asm volatile("" : "+v"(voffA[0]), "+v"(voffA[1]), "+v"(voffB[0]), "+v"(voffB[1]));
    const size_t kstep = (size_t)(BK * 2);
    const size_t hstep = (size_t)HALF * K * 2;
    const unsigned ldsw = (unsigned)wid * 1024u;
    const int aoff = lds_byte(wr * 64 + fr, fq * 8), boff = lds_byte(wc * 32 + fr, fq * 8);
#define PG8_SA(b, h) (((b) * 2 + (h)) * HTB)
#define PG8_SB(b, h) ((4 + (b) * 2 + (h)) * HTB)
#define PG8_STAGE(bufoff, gbase, voff) do { _Pragma("unroll") for (int _i = 0; _i < 2; ++_i) \
        __builtin_amdgcn_global_load_lds((const unsigned*)((const char*)(gbase) + (voff)[_i]), (LAS unsigned*)(lds + (bufoff) + ldsw + _i * 8192), 16, 0, 0); } while (0)
#define PG8_LDA(dst, b, h) do { _Pragma("unroll") for (int m = 0; m < 4; ++m) _Pragma("unroll") for (int k = 0; k < 2; ++k) dst[m][k] = *(const LAS bf16x8*)(lds + PG8_SA(b, h) + aoff + m * 2048 + k * 1024); } while (0)
#define PG8_LDB(dst, b, h) do { _Pragma("unroll") for (int n = 0; n < 2; ++n) _Pragma("unroll") for (int k = 0; k < 2; ++k) dst[n][k] = *(const LAS bf16x8*)(lds + PG8_SB(b, h) + boff + n * 2048 + k * 1024); } while (0)
#define PG8_MMA(ai, bj, At, Bt) do { __builtin_amdgcn_s_setprio(1); _Pragma("unroll") for (int m = 0; m < 4; ++m) _Pragma("unroll") for (int n = 0; n < 2; ++n) _Pragma("unroll") for (int k = 0; k < 2; ++k) \
        acc[ai][bj][m][n] = __builtin_amdgcn_mfma_f32_16x16x32_bf16(Bt[n][k], At[m][k], acc[ai][bj][m][n], 0, 0, 0); __builtin_amdgcn_s_setprio(0); } while (0)
#define PG8_WAIT_V(n) asm volatile("s_waitcnt vmcnt(" #n ")" ::: "memory")
#define PG8_WAIT_L(n) asm volatile("s_waitcnt lgkmcnt(" #n ")" ::: "memory")
#define PG8_BAR __builtin_amdgcn_s_barrier()
#define PG8_SCHED __builtin_amdgcn_sched_barrier(0)
    Unit cur, nxt; int ui = 0;
    if (!S.next(0, cur)) return;
    f32x4 acc[2][2][4][2];
#pragma unroll
    for (int a = 0; a < 2; ++a)
#pragma unroll
        for (int b = 0; b < 2; ++b)
#pragma unroll
            for (int m = 0; m < 4; ++m)
#pragma unroll
                for (int n = 0; n < 2; ++n) acc[a][b][m][n] = (f32x4){0.f, 0.f, 0.f, 0.f};
    bf16x8 At[4][2], B0[2][2], B1[2][2];
    const char* cA = S.a_base(cur); const char* cB = S.b_base(cur);
    PG8_STAGE(PG8_SB(0, 0), cB, voffB); PG8_STAGE(PG8_SA(0, 0), cA, voffA); PG8_STAGE(PG8_SB(0, 1), cB + hstep, voffB); PG8_STAGE(PG8_SA(0, 1), cA + hstep, voffA);
    if (wr == 1) PG8_BAR;
    PG8_WAIT_V(4); PG8_BAR;
    PG8_STAGE(PG8_SB(1, 0), cB + kstep, voffB); PG8_STAGE(PG8_SA(1, 0), cA + kstep, voffA); PG8_STAGE(PG8_SB(1, 1), cB + hstep + kstep, voffB);
    PG8_WAIT_V(6); PG8_BAR;
    for (;;) {
        const bool has_next = S.next(ui + 1, nxt);
        const char* nA = has_next ? S.a_base(nxt) : cA; const char* nB = has_next ? S.b_base(nxt) : cB;
        for (int t = 0; t < nt; t += 2) {
            const bool last = (t == nt - 2);
            const char* a1 = cA + (size_t)(t + 1) * kstep;
            const char* a2 = last ? nA : cA + (size_t)(t + 2) * kstep; const char* b2 = last ? nB : cB + (size_t)(t + 2) * kstep;
            const char* a3 = a2 + kstep; const char* b3 = b2 + kstep;
            PG8_LDB(B0, 0, 0); PG8_SCHED; PG8_LDA(At, 0, 0); PG8_STAGE(PG8_SA(1, 1), a1 + hstep, voffA);
            PG8_WAIT_L(8); PG8_BAR; PG8_WAIT_L(0); PG8_MMA(0, 0, At, B0); PG8_BAR; PG8_SCHED;
            PG8_LDB(B1, 0, 1); PG8_STAGE(PG8_SB(0, 0), b2, voffB);
            PG8_BAR; PG8_WAIT_L(0); PG8_MMA(0, 1, At, B1); PG8_BAR;
            PG8_LDA(At, 0, 1); PG8_STAGE(PG8_SA(0, 0), a2, voffA);
            PG8_BAR; PG8_WAIT_L(0); PG8_MMA(1, 0, At, B0); PG8_BAR; PG8_SCHED;
            PG8_STAGE(PG8_SB(0, 1), b2 + hstep, voffB);
            PG8_WAIT_V(6); PG8_BAR; PG8_MMA(1, 1, At, B1); PG8_BAR;
            PG8_LDB(B0, 1, 0); PG8_SCHED; PG8_LDA(At, 1, 0); PG8_STAGE(PG8_SA(0, 1), a2 + hstep, voffA);
            PG8_WAIT_L(8); PG8_BAR; PG8_WAIT_L(0); PG8_MMA(0, 0, At, B0); PG8_BAR; PG8_SCHED;
            PG8_LDB(B1, 1, 1); PG8_STAGE(PG8_SB(1, 0), b3, voffB);
            PG8_BAR; PG8_WAIT_L(0); PG8_MMA(0, 1, At, B1); PG8_BAR;
            PG8_LDA(At, 1, 1); PG8_STAGE(PG8_SA(1, 0), a3, voffA);
            PG8_BAR; PG8_WAIT_L(0); PG8_MMA(1, 0, At, B0); PG8_BAR; PG8_SCHED;
            PG8_STAGE(PG8_SB(1, 1), b3 + hstep, voffB);
            PG8_WAIT_V(6); PG8_BAR; PG8_MMA(1, 1, At, B1); PG8_BAR;
        }
        E(acc, cur, wr, wc, fr, fq);
        if (!has_next) break;
#pragma unroll
        for (int a = 0; a < 2; ++a)
#pragma unroll
            for (int b = 0; b < 2; ++b)
#pragma unroll
                for (int m = 0; m < 4; ++m)
#pragma unroll
                    for (int n = 0; n < 2; ++n) acc[a][b][m][n] = (f32x4){0.f, 0.f, 0.f, 0.f};
        cur = nxt; cA = nA; cB = nB; ++ui;
    }
    PG8_WAIT_V(0);
    if (wr == 0) PG8_BAR;
    PG8_BAR;
#undef PG8_SA
#undef PG8_SB
#undef PG8_STAGE
#undef PG8_LDA
#undef PG8_LDB
#undef PG8_MMA
#undef PG8_WAIT_V
#undef PG8_WAIT_L
#undef PG8_BAR
#undef PG8_SCHED
}
}

struct EpiP {
    float* C;
    __device__ __forceinline__ void operator()(const f32x4 (&acc)[2][2][4][2], const pg8::Unit& u, int wr, int wc, int fr, int fq) const {
        const int row0 = u.pm * 256 + wr * 64 + fr, col0 = u.pn * 256 + wc * 32 + 4 * fq;
#pragma unroll
        for (int ai = 0; ai < 2; ++ai)
#pragma unroll
            for (int m = 0; m < 4; ++m) { float* rowp = C + (size_t)(row0 + ai * 128 + m * 16) * INP + col0;
#pragma unroll
                for (int bj = 0; bj < 2; ++bj)
#pragma unroll
                    for (int n = 0; n < 2; ++n) *(f32x4*)(rowp + bj * 128 + n * 16) = acc[ai][bj][m][n]; }
    }
};
struct EpiOut {
    const float* xl; const float* xc; float* xo; const float* gate;
    __device__ __forceinline__ void operator()(const f32x4 (&acc)[2][2][4][2], const pg8::Unit& u, int wr, int wc, int fr, int fq) const {
        const bool lat = u.pm < 64; const int bi = lat ? (u.pm >> 4) : 4;
        const float* xin = lat ? xl + (size_t)u.pm * 256 * D : xc + (size_t)(u.pm - 64) * 256 * D;
        float* xop = xo + (size_t)u.pm * 256 * D;
        const int r0 = wr * 64 + fr, c0 = u.pn * 256 + wc * 32 + 4 * fq;
        f32x4 gv[2][2];
#pragma unroll
        for (int bj = 0; bj < 2; ++bj)
#pragma unroll
            for (int n = 0; n < 2; ++n) gv[bj][n] = *(const f32x4*)(gate + (size_t)bi * 6144 + c0 + bj * 128 + n * 16);
#pragma unroll
        for (int ai = 0; ai < 2; ++ai)
#pragma unroll
            for (int m = 0; m < 4; ++m) { const size_t ro = (size_t)(r0 + ai * 128 + m * 16) * D + c0;
#pragma unroll
                for (int bj = 0; bj < 2; ++bj)
#pragma unroll
                    for (int n = 0; n < 2; ++n) { const f32x4 xv = *(const f32x4*)(xin + ro + bj * 128 + n * 16);
                        *(f32x4*)(xop + ro + bj * 128 + n * 16) = xv + gv[bj][n] * acc[ai][bj][m][n]; } }
    }
};
struct EpiGU {
    bf16_t* act; const float* bias; const int* blk_e;
    __device__ __forceinline__ void operator()(const f32x4 (&acc)[2][2][4][2], const pg8::Unit& u, int wr, int wc, int fr, int fq) const {
        const int e = blk_e[u.pm];
        const float* bg = bias + (size_t)e * 2048 + u.pn * 128 + wc * 32 + 4 * fq;
        f32x4 bgv[2], buv[2];
#pragma unroll
        for (int n = 0; n < 2; ++n) { bgv[n] = *(const f32x4*)(bg + n * 16); buv[n] = *(const f32x4*)(bg + 1024 + n * 16); }
#pragma unroll
        for (int ai = 0; ai < 2; ++ai)
#pragma unroll
            for (int m = 0; m < 4; ++m) { bf16_t* rowp = act + (size_t)(u.pm * 256 + ai * 128 + wr * 64 + m * 16 + fr) * DFF + u.pn * 128 + wc * 32 + 4 * fq;
#pragma unroll
                for (int n = 0; n < 2; ++n) { const f32x4 g = acc[ai][0][m][n] + bgv[n], uu = acc[ai][1][m][n] + buv[n]; float o[4];
#pragma unroll
                    for (int i = 0; i < 4; ++i) { const float g_ = fminf(g[i], 7.f), u_ = fminf(fmaxf(uu[i], -7.f), 7.f); o[i] = g_ * sigm(1.702f * g_) * (u_ + 1.f); }
                    u32x2 pk; pk.x = pk2(o[0], o[1]); pk.y = pk2(o[2], o[3]); *(u32x2*)(rowp + n * 16) = pk; } }
    }
};
struct EpiDown {
    bf16_t* Y; const float* bias; const int* blk_e;
    __device__ __forceinline__ void operator()(const f32x4 (&acc)[2][2][4][2], const pg8::Unit& u, int wr, int wc, int fr, int fq) const {
        const int e = blk_e[u.pm];
        const int row0 = u.pm * 256 + wr * 64 + fr, col0 = u.pn * 256 + wc * 32 + 4 * fq;
        f32x4 bv[2][2];
#pragma unroll
        for (int bj = 0; bj < 2; ++bj)
#pragma unroll
            for (int n = 0; n < 2; ++n) bv[bj][n] = *(const f32x4*)(bias + (size_t)e * D + col0 + bj * 128 + n * 16);
#pragma unroll
        for (int ai = 0; ai < 2; ++ai)
#pragma unroll
            for (int m = 0; m < 4; ++m) { bf16_t* rowp = Y + (size_t)(row0 + ai * 128 + m * 16) * D + col0;
#pragma unroll
                for (int bj = 0; bj < 2; ++bj)
#pragma unroll
                    for (int n = 0; n < 2; ++n) { const f32x4 v = acc[ai][bj][m][n] + bv[bj][n]; u32x2 pk; pk.x = pk2(v.x, v.y); pk.y = pk2(v.z, v.w); *(u32x2*)(rowp + bj * 128 + n * 16) = pk; } }
    }
};

template <int MODE>
__device__ __forceinline__ void transpose_item(const float* W, int ldn, int nvalid, bf16_t* WT, LAS float* scr, int kb, int nb, int lane) {
    const int k0 = 64 * kb, n0 = 32 * nb;
    const int nn = n0 + (lane & 31); const bool ok = nn < nvalid;
#pragma unroll 8
    for (int i = 0; i < 32; ++i) { const int kk = 2 * i + (lane >> 5); scr[kk * 33 + (lane & 31)] = ok ? W[(size_t)(k0 + kk) * ldn + nn] : 0.f; }
    LDS_WAIT(); asm volatile("" ::: "memory");
    const int c = lane & 7;
#pragma unroll
    for (int j = 0; j < 4; ++j) { const int n = (lane >> 3) + 8 * j; const LAS float* s = scr + (8 * c) * 33 + n;
        u32x4 o; o.x = pk2(s[0 * 33], s[1 * 33]); o.y = pk2(s[2 * 33], s[3 * 33]); o.z = pk2(s[4 * 33], s[5 * 33]); o.w = pk2(s[6 * 33], s[7 * 33]);
        int gn = n0 + n, drow = gn;
        if (MODE == 1) drow = (gn < 1024) ? ((gn >> 7) * 256 + (gn & 127)) : (((gn - 1024) >> 7) * 256 + 128 + ((gn - 1024) & 127));
        *(u32x4*)(WT + (size_t)drow * 1024 + k0 + 8 * c) = o; }
    LDS_WAIT(); asm volatile("" ::: "memory");
}
__device__ __forceinline__ void phase_prep(const Args& a, LAS unsigned char* lds, int tid, int lane, int wave, int bid, int G) {
    LAS float* scr = (LAS float*)(lds + wave * 16384);
    const int gw = bid * 8 + wave, NGW = G * 8;
    constexpr int I_IN = 16 * 136, I_OUT = 16 * 32, I_GU = 16 * 64, I_D = 16 * 32;
    constexpr int N_IN = 2 * I_IN, N_OUT = 2 * I_OUT, N_GU = 64 * I_GU, N_D = 64 * I_D, NITEMS = N_IN + N_OUT + N_GU + N_D;
    bf16_t* WinT = (bf16_t*)(a.ws + WS_WIN); bf16_t* WoutT = (bf16_t*)(a.ws + WS_WOUT); bf16_t* WguT = (bf16_t*)(a.ws + WS_WGU); bf16_t* WdT = (bf16_t*)(a.ws + WS_WD);
    for (int it = gw; it < NITEMS; it += NGW) {
        int r = it;
        if (r < N_IN) { const int l = r / I_IN, q = r % I_IN; transpose_item<0>(a.in[8] + (size_t)l * 1024 * INC, INC, INC, WinT + (size_t)l * INP * 1024, scr, q / 136, q % 136, lane); continue; } r -= N_IN;
        if (r < N_OUT) { const int l = r / I_OUT, q = r % I_OUT; transpose_item<0>(a.in[9] + (size_t)l * 1024 * 1024, 1024, 1024, WoutT + (size_t)l * 1024 * 1024, scr, q / 32, q % 32, lane); continue; } r -= N_OUT;
        if (r < N_GU) { const int le = r / I_GU, q = r % I_GU; transpose_item<1>(a.in[33] + (size_t)le * 1024 * 2048, 2048, 2048, WguT + (size_t)le * 2048 * 1024, scr, q / 64, q % 64, lane); continue; } r -= N_GU;
        { const int le = r / I_D, q = r % I_D; transpose_item<0>(a.in[35] + (size_t)le * 1024 * 1024, 1024, 1024, WdT + (size_t)le * 1024 * 1024, scr, q / 32, q % 32, lane); }
    }
    __syncthreads();
    LAS float* sv = (LAS float*)lds; LAS float* red = sv + 5 * 1024;
    for (int i = tid; i < 5 * 1024; i += 512) { const int r = i >> 10, k = i & 1023; const float cv = (r < 4) ? a.in[1][r * 1024 + k] : a.in[3][k]; sv[i] = siluf(cv); }
    __syncthreads();
    float* mod = (float*)(a.ws + WS_MOD);
    for (int grp = bid; grp < 768; grp += G) {
        const int l = grp / 384, j0 = (grp % 384) * 16, col = tid & 15, ks = tid >> 4;
        const float* w = a.in[4] + (size_t)l * 1024 * 6144 + j0 + col;
        float a0 = 0.f, a1 = 0.f, a2 = 0.f, a3 = 0.f, a4 = 0.f;
#pragma unroll 8
        for (int kk = 0; kk < 32; ++kk) { const int k = ks * 32 + kk; const float wv = w[(size_t)k * 6144];
            a0 += sv[k] * wv; a1 += sv[1024 + k] * wv; a2 += sv[2048 + k] * wv; a3 += sv[3072 + k] * wv; a4 += sv[4096 + k] * wv; }
        LAS float* rp = red + (ks * 16 + col) * 5; rp[0] = a0; rp[1] = a1; rp[2] = a2; rp[3] = a3; rp[4] = a4;
        __syncthreads();
        if (tid < 80) { const int c = tid / 5, r = tid % 5; float s = 0.f;
            for (int q = 0; q < 32; ++q) s += red[(q * 16 + c) * 5 + r];
            mod[(size_t)(l * 5 + r) * 6144 + j0 + c] = s + a.in[5][l * 6144 + j0 + c]; }
        __syncthreads();
    }
    bf16_t* LW = (bf16_t*)(a.ws + WS_LORA);
    for (int i = bid * 512 + tid; i < 2 * 81920; i += G * 512) {
        const int l = i / 81920, r = i % 81920;
        if (r < 16384) { const int q = r >> 8, c = r & 255; LW[(size_t)l * 81920 + c * 64 + q] = (bf16_t)f2bf(a.in[24][(size_t)l * 16384 + r]); }
        else if (r < 49152) { const int r2 = r - 16384, dj = r2 >> 14, q = (r2 >> 8) & 63, c = r2 & 255; LW[(size_t)l * 81920 + 16384 + dj * 16384 + c * 64 + q] = (bf16_t)f2bf(a.in[22][(size_t)l * 32768 + r2]); }
        else { const int r2 = r - 49152, q = r2 >> 8, c = r2 & 255; LW[(size_t)l * 81920 + 49152 + c * 128 + q] = (bf16_t)f2bf(a.in[25][(size_t)l * 32768 + r2]); }
    }
}

__device__ __forceinline__ void norm_mod_store(f32x4 (&v)[4], const float* nw, const float* shift, const float* scale, bf16_t* hrow, int lane) {
    float ss = 0.f;
#pragma unroll
    for (int j = 0; j < 4; ++j) ss += (v[j].x * v[j].x + v[j].y * v[j].y) + (v[j].z * v[j].z + v[j].w * v[j].w);
    const float r = frsq(wave_sum(ss) * (1.f / D) + 1e-6f);
#pragma unroll
    for (int j = 0; j < 4; ++j) { const int c = j * 256 + lane * 4;
        const f32x4 w4 = *(const f32x4*)(nw + c), sh = *(const f32x4*)(shift + c), sc = *(const f32x4*)(scale + c);
        v[j] = (v[j] * r * w4) * (sc + 1.f) + sh;
        u32x2 pk; pk.x = pk2(v[j].x, v[j].y); pk.y = pk2(v[j].z, v[j].w); *(u32x2*)(hrow + c) = pk; }
}
__device__ __forceinline__ void phase_norm1(const Args& a, int L, const float* xl, const float* xc, int lane, int wave, int bid, int G) {
    const float* mod = (const float*)(a.ws + WS_MOD) + (size_t)L * 5 * 6144;
    bf16_t* Hn = (bf16_t*)(a.ws + WS_HN);
    for (int row = bid * 8 + wave; row < MALL; row += G * 8) {
        const float* xr = row < NL ? xl + (size_t)row * D : xc + (size_t)(row - NL) * D;
        const int bi = row < NL ? (row >> 12) : 4;
        f32x4 v[4];
#pragma unroll
        for (int j = 0; j < 4; ++j) v[j] = *(const f32x4*)(xr + j * 256 + lane * 4);
        norm_mod_store(v, a.in[6] + L * D, mod + (size_t)bi * 6144, mod + (size_t)bi * 6144 + 1024, Hn + (size_t)row * D, lane);
    }
}

__device__ __forceinline__ void phase_mixprep(const Args& a, int L, LAS unsigned char* lds, int lane_, int wave, int bid, int G) {
    const float* P = (const float*)(a.ws + WS_P);
    const int gw = bid * 8 + wave, NGW = G * 8;
    for (int rp_ = 0; rp_ < 1 + ((PROBE_MIX >> 0) & 1); ++rp_) if (MIXPARTS & 1) {
        float* MX = (float*)(a.ws + WS_MXBC); float* MD = (float*)(a.ws + WS_MDT);
        const float* cw = a.in[10] + (size_t)L * 3 * 768; const float* cb = a.in[11] + (size_t)L * 768;
        float w0[12], w1[12], w2[12], wb[12];
#pragma unroll
        for (int j = 0; j < 12; ++j) { const int c = j * 64 + lane_; w0[j] = cw[c]; w1[j] = cw[768 + c]; w2[j] = cw[1536 + c]; wb[j] = cb[c]; }
        const float dtb = lane_ < 8 ? a.in[12][L * 8 + lane_] : 0.f, aneg = lane_ < 8 ? -__expf(a.in[13][L * 8 + lane_]) : 0.f;
        for (int row = gw; row < MALL; row += NGW) {
            const int lane = opq(lane_);
            int t, len; if (row < NL) { t = row & 4095; len = 4096; } else { t = (row - NL) & 255; len = 256; }
            const bool hp = t > 0, hn = t < len - 1;
            const float* p1 = P + (size_t)row * INP + 256 + lane;
            float x0[12], x1[12], x2[12];
#pragma unroll
            for (int j = 0; j < 12; ++j) { x0[j] = hp ? p1[j * 64 - INP] : 0.f; x1[j] = p1[j * 64]; x2[j] = hn ? p1[j * 64 + INP] : 0.f; }
            const float draw = lane < 8 ? P[(size_t)row * INP + 1024 + lane] : 0.f;
#pragma unroll
            for (int j = 0; j < 12; ++j) MX[(size_t)row * 768 + j * 64 + lane] = siluf(w0[j] * x0[j] + w1[j] * x1[j] + w2[j] * x2[j] + wb[j]);
            if (lane < 8) { const float dt = softplusf(draw + dtb); MD[(size_t)row * 16 + lane] = dt; MD[(size_t)row * 16 + 8 + lane] = dt * aneg; }
        }
    }
    for (int rp_ = 0; rp_ < 1 + ((PROBE_MIX >> 1) & 1); ++rp_) if (MIXPARTS & 2) {
        bf16_t* DQ = (bf16_t*)(a.ws + WS_DNQKV); float* DG = (float*)(a.ws + WS_DNGB);
        const float* cw = a.in[16] + (size_t)L * 3 * 1536;
#define DN_ROWS(dr) size_t r0, r1, r2; bool hp, hn; \
            if (dr < NL) { const int b = dr >> 12, pos = dr & 4095; hp = pos > 0; hn = pos < 4095; const int pp = pos - 1, pn = pos + 1; \
                r1 = (size_t)b * 4096 + ((pos & 63) * 64 + (pos >> 6)); r0 = (size_t)b * 4096 + ((pp & 63) * 64 + ((pp >> 6) & 63)); r2 = (size_t)b * 4096 + ((pn & 63) * 64 + ((pn >> 6) & 63)); } \
            else { const int t = (dr - NL) & 255; hp = t > 0; hn = t < 255; r1 = dr; r0 = dr - 1; r2 = dr + 1; }
        {
            float w0[16], w1[16], w2[16];
#pragma unroll
            for (int j = 0; j < 16; ++j) { const int c = j * 64 + lane_; w0[j] = cw[c]; w1[j] = cw[1536 + c]; w2[j] = cw[3072 + c]; }
            const float dtb = lane_ < 8 ? a.in[17][L * 8 + lane_] : 0.f, apos = lane_ < 8 ? __expf(a.in[18][L * 8 + lane_]) : 0.f;
            for (int dr = gw; dr < MALL; dr += NGW) {
                const int lane = opq(lane_);
                DN_ROWS(dr)
                const float* q0 = P + r0 * INP + DN_OFF + lane; const float* q1 = P + r1 * INP + DN_OFF + lane; const float* q2 = P + r2 * INP + DN_OFF + lane;
                float x0[16], x1[16], x2[16];
#pragma unroll
                for (int j = 0; j < 16; ++j) { x0[j] = hp ? q0[j * 64] : 0.f; x1[j] = q1[j * 64]; x2[j] = hn ? q2[j * 64] : 0.f; }
                const float braw = lane < 8 ? q1[2048] : 0.f, araw = lane < 8 ? q1[2056] : 0.f;
                float v[16];
#pragma unroll
                for (int j = 0; j < 16; ++j) v[j] = siluf(w0[j] * x0[j] + w1[j] * x1[j] + w2[j] * x2[j]);
                float qk[4];
#pragma unroll
                for (int h = 0; h < 4; ++h) {
                    const float sq = wave_sum(v[2 * h] * v[2 * h] + v[2 * h + 1] * v[2 * h + 1]);
                    const float sk = wave_sum(v[8 + 2 * h] * v[8 + 2 * h] + v[8 + 2 * h + 1] * v[8 + 2 * h + 1]);
                    const float rq = frsq(sq + 1e-6f) * 0.08838834764831845f, rk = frsq(sk + 1e-6f);
                    v[2 * h] *= rq; v[2 * h + 1] *= rq; v[8 + 2 * h] *= rk; v[8 + 2 * h + 1] *= rk;
                    qk[h] = wave_sum(v[2 * h] * v[8 + 2 * h] + v[2 * h + 1] * v[8 + 2 * h + 1]);
                }
#pragma unroll
                for (int j = 0; j < 16; ++j) DQ[(size_t)dr * 1536 + j * 64 + lane] = (bf16_t)f2bf(v[j]);
                if (lane < 8) { const float beta = sigm(braw); const float g = -apos * softplusf(araw + dtb);
                    DG[(size_t)dr * 32 + lane] = beta; DG[(size_t)dr * 32 + 8 + lane] = __expf(g); DG[(size_t)dr * 32 + 16 + lane] = g; }
                if (lane < 4) { const float s = lane == 0 ? qk[0] : lane == 1 ? qk[1] : lane == 2 ? qk[2] : qk[3]; DG[(size_t)dr * 32 + 24 + lane] = s; }
            }
        }
        {
            float w0[8], w1[8], w2[8];
#pragma unroll
            for (int j = 0; j < 8; ++j) { const int c = 1024 + j * 64 + lane_; w0[j] = cw[c]; w1[j] = cw[1536 + c]; w2[j] = cw[3072 + c]; }
            for (int dr = gw; dr < MALL; dr += NGW) {
                const int lane = opq(lane_);
                DN_ROWS(dr)
                const float* q0 = P + r0 * INP + DN_OFF + 1024 + lane; const float* q1 = P + r1 * INP + DN_OFF + 1024 + lane; const float* q2 = P + r2 * INP + DN_OFF + 1024 + lane;
                float x0[8], x1[8], x2[8];
#pragma unroll
                for (int j = 0; j < 8; ++j) { x0[j] = hp ? q0[j * 64] : 0.f; x1[j] = q1[j * 64]; x2[j] = hn ? q2[j * 64] : 0.f; }
#pragma unroll
                for (int j = 0; j < 8; ++j) DQ[(size_t)dr * 1536 + 1024 + j * 64 + lane] = (bf16_t)f2bf(siluf(w0[j] * x0[j] + w1[j] * x1[j] + w2[j] * x2[j]));
            }
        }
#undef DN_ROWS
    }
    for (int rp_ = 0; rp_ < 1 + ((PROBE_MIX >> 2) & 1); ++rp_) if (MIXPARTS & 4) {
        bf16_t* RW = (bf16_t*)(a.ws + WS_RW); float* RWW = (float*)(a.ws + WS_RWW); float* RG = (float*)(a.ws + WS_RWG);
        const bf16_t* LW = (const bf16_t*)(a.ws + WS_LORA) + (size_t)L * 81920;
        LAS float* KS = (LAS float*)lds;
        LAS bf16_t* INB = (LAS bf16_t*)(lds + 16640);
        const int hh = wave >> 1, half = wave & 1, tokn = lane_ & 15, g4 = lane_ >> 4;
        float mu[17];
#pragma unroll
        for (int j = 0; j < 17; ++j) mu[j] = a.in[20][(size_t)L * 1088 + j * 64 + lane_];
        bf16x8 fa[4][2], fb[4][4];
        {
            const bf16_t* m0 = half == 0 ? LW : LW + 16384 + 16384;
#pragma unroll
            for (int ct = 0; ct < 4; ++ct)
#pragma unroll
                for (int kb = 0; kb < 2; ++kb) fa[ct][kb] = *(const bf16x8*)(m0 + (size_t)(hh * 64 + ct * 16 + tokn) * 64 + kb * 32 + g4 * 8);
            if (half == 0) {
#pragma unroll
                for (int ct = 0; ct < 4; ++ct)
#pragma unroll
                    for (int kb = 0; kb < 4; ++kb) fb[ct][kb] = *(const bf16x8*)(LW + 16384 + (size_t)(hh * 64 + ct * 16 + tokn) * 64 + (kb & 1) * 32 + g4 * 8);
            } else {
#pragma unroll
                for (int ct = 0; ct < 4; ++ct)
#pragma unroll
                    for (int kb = 0; kb < 4; ++kb) fb[ct][kb] = *(const bf16x8*)(LW + 49152 + (size_t)(hh * 64 + ct * 16 + tokn) * 128 + kb * 32 + g4 * 8);
            }
        }
        __syncthreads();
        for (int ti = bid; ti < MALL / 16; ti += G) {
            const int lane = opq(lane_);
#pragma unroll
            for (int t2 = 0; t2 < 2; ++t2) {
                const int tk = wave * 2 + t2, row = ti * 16 + tk; int nb; bool ok;
                if (row < NL) { const int t = row & 4095, gr = t >> 6, gc = t & 63, sel = lane & 3;
                    nb = sel == 0 ? -1 : sel == 1 ? 1 : sel == 2 ? -64 : 64; ok = sel == 0 ? gc > 0 : sel == 1 ? gc < 63 : sel == 2 ? gr > 0 : gr < 63; }
                else { const int t = (row - NL) & 255; nb = (lane & 1) ? 1 : -1; ok = (lane & 1) ? t < 255 : t > 0; }
                const float* p = P + (size_t)row * INP + RW_OFF + lane; const float* ps = p + (long)nb * INP;
                bf16_t* o = RW + (size_t)row * 1280 + lane;
                float xv[17], sv[17];
#pragma unroll
                for (int j = 0; j < 17; ++j) { xv[j] = p[j * 64]; sv[j] = ok ? ps[j * 64] : 0.f; }
#pragma unroll
                for (int j = 0; j < 17; ++j) { const float m = xv[j] + (sv[j] - xv[j]) * mu[j];
                    if (j < 4) o[j * 64] = (bf16_t)f2bf(m); else if (j < 8) KS[tk * 260 + (j - 4) * 64 + lane] = m; else if (j < 12) o[j * 64] = (bf16_t)f2bf(m);
                    else if (j < 14) INB[tk * 328 + (j - 12) * 64 + lane] = (bf16_t)f2bf(tanh_fast(m)); else if (j < 15) INB[tk * 328 + 128 + lane] = (bf16_t)f2bf(m);
                    else INB[tk * 328 + 192 + (j - 15) * 64 + lane] = (bf16_t)f2bf(sigm(m)); }
            }
            __syncthreads();
            {
                const size_t row = (size_t)ti * 16 + tokn;
                const int ch0 = hh * 64 + g4 * 4;
                const LAS bf16_t* ib = INB + tokn * 328 + g4 * 8;
                f32x4 accA[4], accB[4];
#pragma unroll
                for (int ct = 0; ct < 4; ++ct) { accA[ct] = (f32x4){0.f, 0.f, 0.f, 0.f}; accB[ct] = accA[ct]; }
                if (half == 0) {
                    bf16x8 bi[2], bw[2];
#pragma unroll
                    for (int kb = 0; kb < 2; ++kb) { bi[kb] = *(const LAS bf16x8*)(ib + 128 + kb * 32); bw[kb] = *(const LAS bf16x8*)(ib + kb * 32); }
#pragma unroll
                    for (int ct = 0; ct < 4; ++ct)
#pragma unroll
                        for (int kb = 0; kb < 2; ++kb) { accA[ct] = __builtin_amdgcn_mfma_f32_16x16x32_bf16(fa[ct][kb], bi[kb], accA[ct], 0, 0, 0); accB[ct] = __builtin_amdgcn_mfma_f32_16x16x32_bf16(fb[ct][kb], bw[kb], accB[ct], 0, 0, 0); }
                    f32x4 kx[4], kn[4]; float ss = 0.f;
#pragma unroll
                    for (int ct = 0; ct < 4; ++ct) { kx[ct] = *(const LAS f32x4*)(KS + tokn * 260 + ch0 + ct * 16);
                        kn[ct] = kx[ct] * *(const f32x4*)(a.in[26] + L * 256 + ch0 + ct * 16); ss += (kn[ct].x * kn[ct].x + kn[ct].y * kn[ct].y) + (kn[ct].z * kn[ct].z + kn[ct].w * kn[ct].w); }
                    { float u = ss, v = ss; pswap16(u, v); ss = u + v; u = ss; v = ss; pswap32(u, v); ss = u + v; }
                    const float rn = frsq(ss + 1e-6f);
                    bf16_t* o = RW + row * 1280 + ch0; float* ow = RWW + row * 512 + ch0;
#pragma unroll
                    for (int ct = 0; ct < 4; ++ct) { const f32x4 a0v = *(const f32x4*)(a.in[23] + L * 256 + ch0 + ct * 16), kav = *(const f32x4*)(a.in[27] + L * 256 + ch0 + ct * 16), w0v = *(const f32x4*)(a.in[21] + L * 512 + ch0 + ct * 16);
                        f32x4 av, km, wv;
#pragma unroll
                        for (int i = 0; i < 4; ++i) { av[i] = sigm(a0v[i] + accA[ct][i]); km[i] = kx[ct][i] * (1.f + (av[i] - 1.f) * kav[i]); wv[i] = __expf(-__expf(-softplusf(-(w0v[i] + accB[ct][i])) - 0.5f)); }
                        const f32x4 knn = kn[ct] * rn;
                        const f32x4 bb = knn * av; u32x2 pk;
                        pk.x = cvt2(km.x, km.y); pk.y = cvt2(km.z, km.w); *(u32x2*)(o + 256 + ct * 16) = pk;
                        pk.x = cvt2(-knn.x, -knn.y); pk.y = cvt2(-knn.z, -knn.w); *(u32x2*)(o + 768 + ct * 16) = pk;
                        pk.x = cvt2(bb.x, bb.y); pk.y = cvt2(bb.z, bb.w); *(u32x2*)(o + 1024 + ct * 16) = pk;
                        *(f32x4*)(ow + ct * 16) = wv; }
                } else {
                    bf16x8 bw[2], bg[4];
#pragma unroll
                    for (int kb = 0; kb < 2; ++kb) bw[kb] = *(const LAS bf16x8*)(ib + 64 + kb * 32);
#pragma unroll
                    for (int kb = 0; kb < 4; ++kb) bg[kb] = *(const LAS bf16x8*)(ib + 192 + kb * 32);
#pragma unroll
                    for (int ct = 0; ct < 4; ++ct) {
#pragma unroll
                        for (int kb = 0; kb < 2; ++kb) accA[ct] = __builtin_amdgcn_mfma_f32_16x16x32_bf16(fa[ct][kb], bw[kb], accA[ct], 0, 0, 0);
#pragma unroll
                        for (int kb = 0; kb < 4; ++kb) accB[ct] = __builtin_amdgcn_mfma_f32_16x16x32_bf16(fb[ct][kb], bg[kb], accB[ct], 0, 0, 0); }
                    float* o = RWW + row * 512 + 256 + ch0; float* og = RG + row * 256 + ch0;
#pragma unroll
                    for (int ct = 0; ct < 4; ++ct) { const f32x4 w0v = *(const f32x4*)(a.in[21] + L * 512 + 256 + ch0 + ct * 16); f32x4 wv;
#pragma unroll
                        for (int i = 0; i < 4; ++i) wv[i] = __expf(-__expf(-softplusf(-(w0v[i] + accA[ct][i])) - 0.5f));
                        *(f32x4*)(o + ct * 16) = wv; *(f32x4*)(og + ct * 16) = accB[ct]; }
                }
            }
            __syncthreads();
        }
    }
}

__device__ __forceinline__ int seqrow(int b, int dir, int s) {
    if (s < 256) return NL + b * 256 + (dir ? 255 - s : s);
    const int p = s - 256; return b * 4096 + (dir ? 4095 - p : p);
}
template <int CTRL> __device__ __forceinline__ float dppz(float v) { return __builtin_bit_cast(float, __builtin_amdgcn_update_dpp(0, __builtin_bit_cast(int, v), CTRL, 0xF, 0xF, true)); }
__device__ __forceinline__ void phase_dnpre(const Args& a, LAS unsigned char* lds, int lane_, int wave, int bid, int G) {
    const bf16_t* DQ = (const bf16_t*)(a.ws + WS_DNQKV); const float* DG = (const float*)(a.ws + WS_DNGB);
    LAS float* sc = (LAS float*)(lds + wave * 13312);
    LAS unsigned char* stg = (LAS unsigned char*)(sc + 576);
    for (int u = bid * 8 + wave; u < DN_UNITS; u += G * 8) {
        const int lane = opq(lane_);
        const int chain = u / DN_NSUB, c = u % DN_NSUB, dir = chain & 1, h = (chain >> 1) & 3, b = chain >> 3;
        const int ti = lane & 15, kg = lane >> 4;
        const int Lh = lane & 31; const bool isw = lane >= 32;
        const size_t rowi = (size_t)seqrow(b, dir, c * 16 + ti);
        const float gi = DG[rowi * 32 + 16 + dir * 4 + h], bi = DG[rowi * 32 + dir * 4 + h];
        u32x4 kk[4], qq[4];
#pragma unroll
        for (int s = 0; s < 4; ++s) { kk[s] = *(const u32x4*)(DQ + rowi * 1536 + 512 + h * 128 + 32 * s + 8 * kg); qq[s] = *(const u32x4*)(DQ + rowi * 1536 + h * 128 + 32 * s + 8 * kg); }
        const bf16_t* src = DQ + (isw ? 512 : 1024) + h * 128 + 4 * Lh;
        f32x4 x[16];
#pragma unroll
        for (int i = 0; i < 16; ++i) { const size_t row = (size_t)seqrow(b, dir, c * 16 + i); x[i] = ldp4(src + row * 1536); }
        float gc = gi; gc += dppz<0x111>(gc); gc += dppz<0x112>(gc); gc += dppz<0x114>(gc); gc += dppz<0x118>(gc);
        if (lane < 16) { sc[lane] = gc; sc[16 + lane] = bi; }
        f32x4 KKd = {0.f, 0.f, 0.f, 0.f}, QKd = KKd;
#pragma unroll
        for (int s = 0; s < 4; ++s) { const bf16x8 kf = __builtin_bit_cast(bf16x8, kk[s]);
            KKd = __builtin_amdgcn_mfma_f32_16x16x32_bf16(kf, kf, KKd, 0, 0, 0); QKd = __builtin_amdgcn_mfma_f32_16x16x32_bf16(__builtin_bit_cast(bf16x8, qq[s]), kf, QKd, 0, 0, 0); }
        LDS_WAIT(); asm volatile("" ::: "memory");
        {
            const f32x4 gci = *(const LAS f32x4*)(sc + 4 * kg), bti = *(const LAS f32x4*)(sc + 16 + 4 * kg);
#pragma unroll
            for (int r = 0; r < 4; ++r) { const int i = 4 * kg + r; const float dec = __expf(gci[r] - gc);
                sc[32 + i * 16 + ti] = (i > ti) ? bti[r] * KKd[r] * dec : 0.f; sc[288 + i * 16 + ti] = (i >= ti) ? QKd[r] * dec : 0.f; }
        }
        {
            const float eq = __expf(gc);
#pragma unroll
            for (int s = 0; s < 4; ++s) { const unsigned w0 = qq[s].x, w1 = qq[s].y, w2 = qq[s].z, w3 = qq[s].w;
                u32x2 lo, hi2;
                lo.x = cvt2(__builtin_bit_cast(float, w0 << 16) * eq, __builtin_bit_cast(float, w0 & 0xffff0000u) * eq); lo.y = cvt2(__builtin_bit_cast(float, w1 << 16) * eq, __builtin_bit_cast(float, w1 & 0xffff0000u) * eq);
                hi2.x = cvt2(__builtin_bit_cast(float, w2 << 16) * eq, __builtin_bit_cast(float, w2 & 0xffff0000u) * eq); hi2.y = cvt2(__builtin_bit_cast(float, w3 << 16) * eq, __builtin_bit_cast(float, w3 & 0xffff0000u) * eq);
                const int kq0 = 2 * (kg & 1), hf = kg >> 1;
                *(LAS u32x2*)(stg + 4096 + ((s * 64 + kq0 * 16 + ti) * 8 + hf * 4) * 2) = lo; *(LAS u32x2*)(stg + 4096 + ((s * 64 + (kq0 + 1) * 16 + ti) * 8 + hf * 4) * 2) = hi2; }
        }
        LDS_WAIT(); asm volatile("" ::: "memory");
        unsigned char* ub = a.ws + WS_DNC + (size_t)u * 12800;
        {
            const f32x4 at = *(const LAS f32x4*)(sc + 288 + ti * 16 + 4 * kg);
            u32x2 o; o.x = cvt2(at.x, at.y); o.y = cvt2(at.z, at.w); *(u32x2*)(ub + 12288 + lane * 8) = o;
            if (lane == 15) ((float*)(a.ws + WS_DNG))[u] = __expf(gc);
        }
#pragma unroll
        for (int i = 0; i < 16; ++i) { const float gci = sc[i], bti = sc[16 + i]; x[i] = x[i] * (isw ? bti * __expf(gci) : bti);
#pragma unroll
            for (int j = 0; j < i; ++j) x[i] -= x[j] * sc[32 + i * 16 + j]; }
        const int sW = Lh >> 3, hfW = (Lh >> 2) & 1, kqW = Lh & 3;
        if (isw) {
#pragma unroll
            for (int m = 0; m < 16; ++m) { u32x2 o; o.x = cvt2(x[m].x, x[m].y); o.y = cvt2(x[m].z, x[m].w); *(LAS u32x2*)(stg + ((sW * 64 + kqW * 16 + m) * 8 + hfW * 4) * 2) = o; }
        }
        LDS_WAIT(); asm volatile("" ::: "memory");
#pragma unroll
        for (int q = 0; q < 8; ++q) *(u32x4*)(ub + q * 1024 + lane * 16) = *(const LAS u32x4*)(stg + q * 1024 + lane * 16);
        LDS_WAIT(); asm volatile("" ::: "memory");
        if (!isw) {
#pragma unroll
            for (int g = 0; g < 4; ++g)
#pragma unroll
                for (int q = 0; q < 4; ++q) { const f32x4 o = {x[4 * g][q], x[4 * g + 1][q], x[4 * g + 2][q], x[4 * g + 3][q]}; *(LAS f32x4*)(stg + ((Lh >> 2) * 256 + (g * 16 + 4 * (Lh & 3) + q) * 4) * 4) = o; }
        }
        LDS_WAIT(); asm volatile("" ::: "memory");
        { unsigned char* ud = a.ws + WS_DNU + (size_t)u * 8192;
#pragma unroll
          for (int q = 0; q < 8; ++q) *(u32x4*)(ud + q * 1024 + lane * 16) = *(const LAS u32x4*)(stg + q * 1024 + lane * 16); }
        LDS_WAIT(); asm volatile("" ::: "memory");
        {
            const float ek = __expf(sc[15] - gc);
            LAS bf16_t* kfi = (LAS bf16_t*)stg;
#pragma unroll
            for (int s = 0; s < 4; ++s) { const unsigned w[4] = {kk[s].x, kk[s].y, kk[s].z, kk[s].w};
#pragma unroll
                for (int e2 = 0; e2 < 4; ++e2) { const unsigned pk = cvt2(__builtin_bit_cast(float, w[e2] << 16) * ek, __builtin_bit_cast(float, w[e2] & 0xffff0000u) * ek);
                    const int d0 = 32 * s + 8 * kg + 2 * e2;
                    kfi[(((d0 >> 4) * 64 + (ti >> 2) * 16 + (d0 & 15)) * 4) + (ti & 3)] = (bf16_t)(pk & 0xffffu);
                    kfi[(((d0 >> 4) * 64 + (ti >> 2) * 16 + ((d0 + 1) & 15)) * 4) + (ti & 3)] = (bf16_t)(pk >> 16); } }
        }
        LDS_WAIT(); asm volatile("" ::: "memory");
#pragma unroll
        for (int q = 0; q < 4; ++q) *(u32x4*)(ub + 8192 + q * 1024 + lane * 16) = *(const LAS u32x4*)(stg + q * 1024 + lane * 16);
        LDS_WAIT(); asm volatile("" ::: "memory");
    }
}
__device__ __forceinline__ void phase_mbpre(const Args& a, int lane_, int wave, int bid, int G) {
    const float* MX = (const float*)(a.ws + WS_MXBC);
    for (int u = bid * 8 + wave; u < MB_UNITS; u += G * 8) {
        const int lane = opq(lane_);
        const int bg = u / DN_NSUB, gi = u % DN_NSUB, b = bg >> 1, grp = bg & 1;
        const size_t base = gi < 16 ? (size_t)NL + b * 256 + gi * 16 : (size_t)b * 4096 + (gi - 16) * 16;
        const int tk = lane & 15, kg = lane >> 4;
        unsigned char* ub0 = a.ws + WS_MBC + (size_t)u * 12288; unsigned char* ub = ub0 + lane * 16;
        const float* cp = MX + (base + tk) * 768 + 512 + grp * 128 + 4 * kg; const float* bp = MX + (base + tk) * 768 + 256 + grp * 128 + 4 * kg;
#pragma unroll
        for (int s = 0; s < 4; ++s) { const f32x4 c0 = *(const f32x4*)(cp + 32 * s), c1 = *(const f32x4*)(cp + 32 * s + 16), b0 = *(const f32x4*)(bp + 32 * s), b1 = *(const f32x4*)(bp + 32 * s + 16);
            u32x4 oc, ob; oc.x = cvt2(c0.x, c0.y); oc.y = cvt2(c0.z, c0.w); oc.z = cvt2(c1.x, c1.y); oc.w = cvt2(c1.z, c1.w);
            ob.x = cvt2(b0.x, b0.y); ob.y = cvt2(b0.z, b0.w); ob.z = cvt2(b1.x, b1.y); ob.w = cvt2(b1.z, b1.w);
            *(u32x4*)(ub + s * 1024) = oc; *(u32x4*)(ub + 4096 + s * 1024) = ob; }
        const float* bt = MX + (base + 4 * kg) * 768 + 256 + grp * 128 + tk;
#pragma unroll
        for (int dt = 0; dt < 8; ++dt) { u32x2 o; o.x = cvt2(bt[16 * dt], bt[768 + 16 * dt]); o.y = cvt2(bt[1536 + 16 * dt], bt[2304 + 16 * dt]); *(u32x2*)(ub0 + 8192 + dt * 512 + lane * 8) = o; }
    }
}
constexpr int RING_OFF = 4608, RING_SLOT = 18432, RING_R = 7, RING_NP = 18;
struct RingSync { volatile LAS int* prog; volatile LAS int* lready; };
__device__ __forceinline__ void ring_wait_ready(const RingSync& rs, int c) { unsigned sp = 0; while (rs.lready[c & 3] < c + 1 && ++sp < (1u << 24)) __builtin_amdgcn_s_sleep(1); }
__device__ __forceinline__ void ring_release(const RingSync& rs, int w, int c, int lane) { asm volatile("" ::: "memory"); if (lane == 0) rs.prog[w] = c + 1; asm volatile("" ::: "memory"); }
struct MbBuf { bf16x8 cf[4], bf[4], btf[8]; float la, xr[4]; size_t base; };
__device__ __forceinline__ size_t mb_base(int b, int dir, int c, int& gi) { gi = c < 16 ? (dir ? 15 - c : c) : (dir ? 16 + 255 - (c - 16) : c); return gi < 16 ? (size_t)NL + b * 256 + gi * 16 : (size_t)b * 4096 + (gi - 16) * 16; }
__device__ __forceinline__ void mb_load(MbBuf& B, const LAS unsigned char* slot, int b, int h, int dir, int pt, int c, int lane) {
    const int n = lane & 15, g = lane >> 4; int gi;
    const LAS unsigned char* ub = slot + lane * 16;
#pragma unroll
    for (int s = 0; s < 4; ++s) { B.cf[s] = *(const LAS bf16x8*)(ub + s * 1024); B.bf[s] = *(const LAS bf16x8*)(ub + 4096 + s * 1024); }
#pragma unroll
    for (int dt = 0; dt < 8; ++dt) { const u32x2 v = *(const LAS u32x2*)(slot + 8192 + dt * 512 + lane * 8); const u32x4 f = {v.x, v.y, 0u, 0u}; B.btf[dt] = __builtin_bit_cast(bf16x8, f); }
    const LAS float* xs = (const LAS float*)(slot + 12288); const LAS float* md = (const LAS float*)(slot + 16384);
    B.la = md[n * 16 + 8 + dir * 4 + h];
#pragma unroll
    for (int r = 0; r < 4; ++r) B.xr[r] = xs[(4 * g + r) * 64 + pt * 16 + n] * md[(4 * g + r) * 16 + dir * 4 + h];
    B.base = mb_base(b, dir, c, gi);
}
__device__ __forceinline__ void mb_step(const MbBuf& B, f32x4 (&hT)[8], LAS float* sc, float* YM, int dir, int h, int pt, int lane) {
    const int n = lane & 15, g = lane >> 4;
    float cum = B.la;
    if (dir == 0) { cum += dppz<0x111>(cum); cum += dppz<0x112>(cum); cum += dppz<0x114>(cum); cum += dppz<0x118>(cum); }
    else          { cum += dppz<0x101>(cum); cum += dppz<0x102>(cum); cum += dppz<0x104>(cum); cum += dppz<0x108>(cum); }
    if (lane < 16) sc[lane] = cum;
    LDS_WAIT(); asm volatile("" ::: "memory");
    const f32x4 cj = *(const LAS f32x4*)(sc + 4 * g); const float cend = sc[dir ? 0 : 15];
    u32x4 px, px2; px.x = cvt2(B.xr[0], B.xr[1]); px.y = cvt2(B.xr[2], B.xr[3]); px.z = 0u; px.w = 0u;
    px2.x = cvt2(B.xr[0] * __expf(cend - cj.x), B.xr[1] * __expf(cend - cj.y)); px2.y = cvt2(B.xr[2] * __expf(cend - cj.z), B.xr[3] * __expf(cend - cj.w)); px2.z = 0u; px2.w = 0u;
    const bf16x8 xdf = __builtin_bit_cast(bf16x8, px), xd2f = __builtin_bit_cast(bf16x8, px2);
    f32x4 gt = {0.f, 0.f, 0.f, 0.f}, yo = gt;
#pragma unroll
    for (int s = 0; s < 4; ++s) { gt = __builtin_amdgcn_mfma_f32_16x16x32_bf16(B.bf[s], B.cf[s], gt, 0, 0, 0);
        u32x4 p; p.x = cvt2(hT[2 * s].x, hT[2 * s].y); p.y = cvt2(hT[2 * s].z, hT[2 * s].w); p.z = cvt2(hT[2 * s + 1].x, hT[2 * s + 1].y); p.w = cvt2(hT[2 * s + 1].z, hT[2 * s + 1].w);
        yo = __builtin_amdgcn_mfma_f32_16x16x32_bf16(__builtin_bit_cast(bf16x8, p), B.cf[s], yo, 0, 0, 0); }
    float st[4];
#pragma unroll
    for (int r = 0; r < 4; ++r) { const int j = 4 * g + r; const bool ok = dir ? (j >= n) : (j <= n); st[r] = ok ? gt[r] * __expf(cum - cj[r]) : 0.f; }
    u32x4 ps; ps.x = cvt2(st[0], st[1]); ps.y = cvt2(st[2], st[3]); ps.z = 0u; ps.w = 0u;
    const f32x4 y = __builtin_amdgcn_mfma_f32_16x16x32_bf16(xdf, __builtin_bit_cast(bf16x8, ps), yo * __expf(cum), 0, 0, 0);
    *(f32x4*)(YM + (B.base + n) * 256 + h * 64 + pt * 16 + 4 * g) = y;
    const float dtot = __expf(cend);
#pragma unroll
    for (int dt = 0; dt < 8; ++dt) hT[dt] = __builtin_amdgcn_mfma_f32_16x16x32_bf16(B.btf[dt], xd2f, hT[dt] * dtot, 0, 0, 0);
    LDS_WAIT(); asm volatile("" ::: "memory");
}
__device__ __forceinline__ void scan_mamba_seq(const Args& a, LAS unsigned char* lds, int chain, int pt, int lane, const RingSync& rs) {
    const int dir = chain & 1, h = (chain >> 1) & 3, b = chain >> 3;
    LAS float* sc = (LAS float*)(lds + 1024 + pt * 256);
    float* YM = (float*)(a.ws + WS_YM) + (size_t)dir * MALL * 256;
    f32x4 hT[8];
#pragma unroll
    for (int i = 0; i < 8; ++i) hT[i] = (f32x4){0.f, 0.f, 0.f, 0.f};
    MbBuf A, B;
    ring_wait_ready(rs, 0); mb_load(A, lds + RING_OFF, b, h, dir, pt, 0, lane); ring_release(rs, pt, 0, lane);
    for (int c = 0; c < DN_NSUB; c += 2) {
        ring_wait_ready(rs, c + 1); mb_load(B, lds + RING_OFF + ((c + 1) % RING_R) * RING_SLOT, b, h, dir, pt, c + 1, lane); ring_release(rs, pt, c + 1, lane);
        mb_step(A, hT, sc, YM, dir, h, pt, lane);
        if (c + 2 < DN_NSUB) { ring_wait_ready(rs, c + 2); mb_load(A, lds + RING_OFF + ((c + 2) % RING_R) * RING_SLOT, b, h, dir, pt, c + 2, lane); ring_release(rs, pt, c + 2, lane); }
        mb_step(B, hT, sc, YM, dir, h, pt, lane);
    }
}

template <int CTRL> __device__ __forceinline__ float dpp1(float v) { return __builtin_bit_cast(float, __builtin_amdgcn_update_dpp(0x3f800000, __builtin_bit_cast(int, v), CTRL, 0xF, 0xF, false)); }
__device__ __forceinline__ void phase_rwpre(const Args& a, LAS unsigned char* lds, int lane_, int wave, int bid, int G) {
    const bf16_t* RW = (const bf16_t*)(a.ws + WS_RW); const float* RWW = (const float*)(a.ws + WS_RWW);
    LAS unsigned char* wl = lds + wave * 13312;
    LAS bf16_t* Ab = (LAS bf16_t*)wl; LAS bf16_t* Rb = Ab + 1024; LAS bf16_t* Bb = Rb + 1024; LAS bf16_t* Kb = Bb + 1024;
    LAS float* Lab = (LAS float*)(wl + 8192); LAS float* Lak = Lab + 256; LAS float* Lbr = Lak + 256; LAS float* Lkr = Lbr + 256; LAS float* Nm = Lkr + 256;
    for (int u = bid * 8 + wave; u < DN_UNITS; u += G * 8) {
        const int lane = opq(lane_);
        const int chain = u / DN_NSUB, c = u % DN_NSUB, dir = chain & 1, h = (chain >> 1) & 3, b = chain >> 3;
        const int ti = lane & 15, kg = lane >> 4;
        const size_t rrow = (size_t)seqrow(b, dir, c * 16 + ti);
        const bf16_t* p = RW + rrow * 1280 + h * 64 + 8 * kg; const float* pw = RWW + rrow * 512 + dir * 256 + h * 64 + 8 * kg;
        float av[16], bv[16], kv[16], rv[16], wv[16];
#pragma unroll
        for (int s = 0; s < 2; ++s)
#pragma unroll
            for (int q = 0; q < 2; ++q) { const int o = 32 * s + 4 * q;
                const f32x4 r4 = ldp4(p + o), k4 = ldp4(p + 256 + o), a4 = ldp4(p + 768 + o), b4 = ldp4(p + 1024 + o), w4 = *(const f32x4*)(pw + o);
#pragma unroll
                for (int e = 0; e < 4; ++e) { const int x = 8 * s + 4 * q + e; rv[x] = r4[e]; kv[x] = k4[e]; av[x] = a4[e]; bv[x] = b4[e]; wv[x] = w4[e]; } }
        u32x4 fa[2], fr[2], fb[2], fk[2];
        float p15[16];
#pragma unroll
        for (int x = 0; x < 16; ++x) {
            float P = wv[x]; P *= dpp1<0x111>(P); P *= dpp1<0x112>(P); P *= dpp1<0x114>(P); P *= dpp1<0x118>(P);
            const float Pex = dpp1<0x111>(P), ip = frcp(P);
            av[x] *= Pex; rv[x] *= P; bv[x] *= ip; kv[x] *= ip;
            p15[x] = dppf<0x140>(P);
        }
#pragma unroll
        for (int s = 0; s < 2; ++s) {
            fa[s].x = cvt2(av[8 * s], av[8 * s + 1]); fa[s].y = cvt2(av[8 * s + 2], av[8 * s + 3]); fa[s].z = cvt2(av[8 * s + 4], av[8 * s + 5]); fa[s].w = cvt2(av[8 * s + 6], av[8 * s + 7]);
            fr[s].x = cvt2(rv[8 * s], rv[8 * s + 1]); fr[s].y = cvt2(rv[8 * s + 2], rv[8 * s + 3]); fr[s].z = cvt2(rv[8 * s + 4], rv[8 * s + 5]); fr[s].w = cvt2(rv[8 * s + 6], rv[8 * s + 7]);
            fb[s].x = cvt2(bv[8 * s], bv[8 * s + 1]); fb[s].y = cvt2(bv[8 * s + 2], bv[8 * s + 3]); fb[s].z = cvt2(bv[8 * s + 4], bv[8 * s + 5]); fb[s].w = cvt2(bv[8 * s + 6], bv[8 * s + 7]);
            fk[s].x = cvt2(kv[8 * s], kv[8 * s + 1]); fk[s].y = cvt2(kv[8 * s + 2], kv[8 * s + 3]); fk[s].z = cvt2(kv[8 * s + 4], kv[8 * s + 5]); fk[s].w = cvt2(kv[8 * s + 6], kv[8 * s + 7]);
            *(LAS u32x4*)(Ab + ti * 64 + 32 * s + 8 * kg) = fa[s]; *(LAS u32x4*)(Rb + ti * 64 + 32 * s + 8 * kg) = fr[s];
            *(LAS u32x4*)(Bb + ti * 64 + 32 * s + 8 * kg) = fb[s]; *(LAS u32x4*)(Kb + ti * 64 + 32 * s + 8 * kg) = fk[s];
        }
        unsigned char* ub = a.ws + WS_RWC + (size_t)u * 10496;
        if (ti == 0) {
            float* pp = (float*)(ub + 10240) + 8 * kg;
            *(f32x4*)(pp) = (f32x4){p15[0], p15[1], p15[2], p15[3]}; *(f32x4*)(pp + 4) = (f32x4){p15[4], p15[5], p15[6], p15[7]};
            *(f32x4*)(pp + 32) = (f32x4){p15[8], p15[9], p15[10], p15[11]}; *(f32x4*)(pp + 36) = (f32x4){p15[12], p15[13], p15[14], p15[15]};
        }
        f32x4 dab = {0.f, 0.f, 0.f, 0.f}, dak = dab, dbr = dab, dkr = dab;
#pragma unroll
        for (int s = 0; s < 2; ++s) { const bf16x8 A = __builtin_bit_cast(bf16x8, fa[s]), R = __builtin_bit_cast(bf16x8, fr[s]), B = __builtin_bit_cast(bf16x8, fb[s]), K = __builtin_bit_cast(bf16x8, fk[s]);
            dab = __builtin_amdgcn_mfma_f32_16x16x32_bf16(A, B, dab, 0, 0, 0); dak = __builtin_amdgcn_mfma_f32_16x16x32_bf16(A, K, dak, 0, 0, 0);
            dbr = __builtin_amdgcn_mfma_f32_16x16x32_bf16(R, B, dbr, 0, 0, 0); dkr = __builtin_amdgcn_mfma_f32_16x16x32_bf16(R, K, dkr, 0, 0, 0); }
#pragma unroll
        for (int r = 0; r < 4; ++r) { const int i = 4 * kg + r;
            Lab[i * 16 + ti] = (ti < i) ? dab[r] : 0.f; Lak[i * 16 + ti] = (ti < i) ? dak[r] : 0.f; Lbr[i * 16 + ti] = (ti <= i) ? dbr[r] : 0.f; Lkr[i * 16 + ti] = (ti <= i) ? dkr[r] : 0.f; }
        LDS_WAIT(); asm volatile("" ::: "memory");
        if (lane < 16) {
            float nn[16];
#pragma unroll
            for (int i = 0; i < 16; ++i) { float v = (i == lane) ? 1.f : 0.f;
#pragma unroll
                for (int j = 0; j < i; ++j) v += Lab[i * 16 + j] * nn[j];
                nn[i] = v; Nm[i * 16 + lane] = v; }
        }
        LDS_WAIT(); asm volatile("" ::: "memory");
        {
            const f32x4 m0 = *(const LAS f32x4*)(Lak + ti * 16 + 4 * kg), m1 = *(const LAS f32x4*)(Nm + ti * 16 + 4 * kg), m2 = *(const LAS f32x4*)(Lbr + ti * 16 + 4 * kg), m3 = *(const LAS f32x4*)(Lkr + ti * 16 + 4 * kg);
            u32x2 o;
            o.x = cvt2(m0.x, m0.y); o.y = cvt2(m0.z, m0.w); *(u32x2*)(ub + 4096 + lane * 8) = o;
            o.x = cvt2(m1.x, m1.y); o.y = cvt2(m1.z, m1.w); *(u32x2*)(ub + 4608 + lane * 8) = o;
            o.x = cvt2(m2.x, m2.y); o.y = cvt2(m2.z, m2.w); *(u32x2*)(ub + 5120 + lane * 8) = o;
            o.x = cvt2(m3.x, m3.y); o.y = cvt2(m3.z, m3.w); *(u32x2*)(ub + 5632 + lane * 8) = o;
        }
#pragma unroll
        for (int s = 0; s < 2; ++s) {
            u32x4 o; const u32x2 a0 = *(const LAS u32x2*)(Ab + ti * 64 + 32 * s + 4 * kg), a1 = *(const LAS u32x2*)(Ab + ti * 64 + 32 * s + 16 + 4 * kg);
            o.x = a0.x; o.y = a0.y; o.z = a1.x; o.w = a1.y; *(u32x4*)(ub + s * 1024 + lane * 16) = o;
            const u32x2 r0 = *(const LAS u32x2*)(Rb + ti * 64 + 32 * s + 4 * kg), r1 = *(const LAS u32x2*)(Rb + ti * 64 + 32 * s + 16 + 4 * kg);
            o.x = r0.x; o.y = r0.y; o.z = r1.x; o.w = r1.y; *(u32x4*)(ub + 2048 + s * 1024 + lane * 16) = o;
        }
#pragma unroll
        for (int dt = 0; dt < 4; ++dt) {
            u32x2 o;
            const LAS bf16_t* bp = Bb + (4 * kg) * 64 + 16 * dt + ti; const LAS bf16_t* kp = Kb + (4 * kg) * 64 + 16 * dt + ti;
            o.x = (unsigned)bp[0] | ((unsigned)bp[64] << 16); o.y = (unsigned)bp[128] | ((unsigned)bp[192] << 16); *(u32x2*)(ub + 6144 + dt * 512 + lane * 8) = o;
            o.x = (unsigned)kp[0] | ((unsigned)kp[64] << 16); o.y = (unsigned)kp[128] | ((unsigned)kp[192] << 16); *(u32x2*)(ub + 8192 + dt * 512 + lane * 8) = o;
        }
        LDS_WAIT(); asm volatile("" ::: "memory");
    }
}
struct RwBuf { bf16x8 atf[2], rtf[2], lakf, nf, lbrf, lkrf, bfr[4], kfr[4]; float vr[4]; };
struct RwBuf2 { f32x4 p15[4]; };
__device__ __forceinline__ void rw_load(RwBuf& B, f32x4 (&p15)[4], const LAS unsigned char* slot, int vt, int lane) {
    const int n = lane & 15, g = lane >> 4;
    const LAS unsigned char* ub = slot + lane * 16;
#pragma unroll
    for (int s = 0; s < 2; ++s) { B.atf[s] = *(const LAS bf16x8*)(ub + s * 1024); B.rtf[s] = *(const LAS bf16x8*)(ub + 2048 + s * 1024); }
#define RW_HALF(off) ({ const u32x2 v_ = *(const LAS u32x2*)(slot + (off) + lane * 8); const u32x4 f_ = {v_.x, v_.y, 0u, 0u}; __builtin_bit_cast(bf16x8, f_); })
    B.lakf = RW_HALF(4096); B.nf = RW_HALF(4608); B.lbrf = RW_HALF(5120); B.lkrf = RW_HALF(5632);
#pragma unroll
    for (int dt = 0; dt < 4; ++dt) { B.bfr[dt] = RW_HALF(6144 + dt * 512); B.kfr[dt] = RW_HALF(8192 + dt * 512); p15[dt] = *(const LAS f32x4*)(slot + 10240 + (16 * dt + 4 * g) * 4); }
#undef RW_HALF
    const LAS bf16_t* vs = (const LAS bf16_t*)(slot + 11264);
#pragma unroll
    for (int r = 0; r < 4; ++r) B.vr[r] = __builtin_bit_cast(float, ((unsigned)vs[(4 * g + r) * 64 + vt * 16 + n]) << 16);
}
__device__ __forceinline__ void rw_step(const RwBuf& B, const f32x4 (&p15)[4], f32x4 (&Sd)[4], float* YR, int b, int dir, int h, int vt, int c, int lane) {
    const int n = lane & 15, g = lane >> 4;
    const f32x4 z4 = {0.f, 0.f, 0.f, 0.f};
    u32x4 pv; pv.x = cvt2(B.vr[0], B.vr[1]); pv.y = cvt2(B.vr[2], B.vr[3]); pv.z = 0u; pv.w = 0u;
    const bf16x8 vb = __builtin_bit_cast(bf16x8, pv);
    bf16x8 sb[2];
#pragma unroll
    for (int s = 0; s < 2; ++s) { u32x4 p; p.x = cvt2(Sd[2 * s].x, Sd[2 * s].y); p.y = cvt2(Sd[2 * s].z, Sd[2 * s].w); p.z = cvt2(Sd[2 * s + 1].x, Sd[2 * s + 1].y); p.w = cvt2(Sd[2 * s + 1].z, Sd[2 * s + 1].w); sb[s] = __builtin_bit_cast(bf16x8, p); }
    f32x4 X = __builtin_amdgcn_mfma_f32_16x16x32_bf16(B.atf[0], sb[0], z4, 0, 0, 0);
    X = __builtin_amdgcn_mfma_f32_16x16x32_bf16(B.atf[1], sb[1], X, 0, 0, 0);
    X = __builtin_amdgcn_mfma_f32_16x16x32_bf16(B.lakf, vb, X, 0, 0, 0);
    u32x4 px; px.x = cvt2(X.x, X.y); px.y = cvt2(X.z, X.w); px.z = 0u; px.w = 0u;
    const f32x4 UT = __builtin_amdgcn_mfma_f32_16x16x32_bf16(B.nf, __builtin_bit_cast(bf16x8, px), z4, 0, 0, 0);
    u32x4 pu; pu.x = cvt2(UT.x, UT.y); pu.y = cvt2(UT.z, UT.w); pu.z = 0u; pu.w = 0u;
    const bf16x8 ubf = __builtin_bit_cast(bf16x8, pu);
    f32x4 Y = __builtin_amdgcn_mfma_f32_16x16x32_bf16(B.rtf[0], sb[0], z4, 0, 0, 0);
    Y = __builtin_amdgcn_mfma_f32_16x16x32_bf16(B.rtf[1], sb[1], Y, 0, 0, 0);
    Y = __builtin_amdgcn_mfma_f32_16x16x32_bf16(B.lbrf, ubf, Y, 0, 0, 0);
    Y = __builtin_amdgcn_mfma_f32_16x16x32_bf16(B.lkrf, vb, Y, 0, 0, 0);
#pragma unroll
    for (int r = 0; r < 4; ++r) YR[(size_t)seqrow(b, dir, c * 16 + 4 * g + r) * 256 + h * 64 + vt * 16 + n] = Y[r];
#pragma unroll
    for (int dt = 0; dt < 4; ++dt) { f32x4 t = __builtin_amdgcn_mfma_f32_16x16x32_bf16(B.bfr[dt], ubf, Sd[dt], 0, 0, 0); t = __builtin_amdgcn_mfma_f32_16x16x32_bf16(B.kfr[dt], vb, t, 0, 0, 0); Sd[dt] = t * p15[dt]; }
}
__device__ __forceinline__ void scan_rw_seq(const Args& a, LAS unsigned char* lds, int chain, int vt, int lane, const RingSync& rs) {
    const int dir = chain & 1, h = (chain >> 1) & 3, b = chain >> 3;
    float* YR = (float*)(a.ws + WS_YRW) + (size_t)dir * MALL * 256;
    f32x4 Sd[4];
#pragma unroll
    for (int i = 0; i < 4; ++i) Sd[i] = (f32x4){0.f, 0.f, 0.f, 0.f};
    RwBuf A, B; f32x4 pa[4], pb[4];
    ring_wait_ready(rs, 0); rw_load(A, pa, lds + RING_OFF, vt, lane); ring_release(rs, vt, 0, lane);
    for (int c = 0; c < DN_NSUB; c += 2) {
        ring_wait_ready(rs, c + 1); rw_load(B, pb, lds + RING_OFF + ((c + 1) % RING_R) * RING_SLOT, vt, lane); ring_release(rs, vt, c + 1, lane);
        rw_step(A, pa, Sd, YR, b, dir, h, vt, c, lane);
        if (c + 2 < DN_NSUB) { ring_wait_ready(rs, c + 2); rw_load(A, pa, lds + RING_OFF + ((c + 2) % RING_R) * RING_SLOT, vt, lane); ring_release(rs, vt, c + 2, lane); }
        rw_step(B, pb, Sd, YR, b, dir, h, vt, c + 1, lane);
    }
}

struct DnBuf { bf16x8 wf[4], qf[4], kf[8], af; f32x4 uv; float gam; };
__device__ __forceinline__ void dn_load(DnBuf& B, const LAS unsigned char* slot, int w, int lane) {
    const LAS unsigned char* ub = slot + lane * 16;
#pragma unroll
    for (int s = 0; s < 4; ++s) { B.wf[s] = *(const LAS bf16x8*)(ub + s * 1024); B.qf[s] = *(const LAS bf16x8*)(ub + 4096 + s * 1024); }
#pragma unroll
    for (int dt = 0; dt < 8; ++dt) { const u32x2 v = *(const LAS u32x2*)(slot + 8192 + dt * 512 + lane * 8); const u32x4 f = {v.x, v.y, 0u, 0u}; B.kf[dt] = __builtin_bit_cast(bf16x8, f); }
    { const u32x2 v = *(const LAS u32x2*)(slot + 12288 + lane * 8); const u32x4 f = {v.x, v.y, 0u, 0u}; B.af = __builtin_bit_cast(bf16x8, f); }
    B.uv = *(const LAS f32x4*)(ub + 13312 + w * 1024);
    B.gam = *(const LAS float*)(slot + 17408);
}
__device__ __forceinline__ void dn_step(const DnBuf& B, f32x4 (&Sd)[8], float* OD, int b, int dir, int h, int c, int ct, int n, int g) {
    f32x4 ws = {0.f, 0.f, 0.f, 0.f}, qs = ws;
#pragma unroll
    for (int s = 0; s < 4; ++s) { u32x4 p; p.x = cvt2(Sd[2 * s].x, Sd[2 * s].y); p.y = cvt2(Sd[2 * s].z, Sd[2 * s].w); p.z = cvt2(Sd[2 * s + 1].x, Sd[2 * s + 1].y); p.w = cvt2(Sd[2 * s + 1].z, Sd[2 * s + 1].w);
        const bf16x8 sb = __builtin_bit_cast(bf16x8, p);
        ws = __builtin_amdgcn_mfma_f32_16x16x32_bf16(B.wf[s], sb, ws, 0, 0, 0); qs = __builtin_amdgcn_mfma_f32_16x16x32_bf16(B.qf[s], sb, qs, 0, 0, 0); }
    const f32x4 vn = B.uv - ws;
    u32x4 pv; pv.x = cvt2(vn.x, vn.y); pv.y = cvt2(vn.z, vn.w); pv.z = 0u; pv.w = 0u;
    const bf16x8 vb = __builtin_bit_cast(bf16x8, pv);
    const f32x4 o = __builtin_amdgcn_mfma_f32_16x16x32_bf16(B.af, vb, qs, 0, 0, 0);
#pragma unroll
    for (int dt = 0; dt < 8; ++dt) Sd[dt] = __builtin_amdgcn_mfma_f32_16x16x32_bf16(B.kf[dt], vb, Sd[dt] * B.gam, 0, 0, 0);
#pragma unroll
    for (int r = 0; r < 4; ++r) OD[(size_t)seqrow(b, dir, c * 16 + 4 * g + r) * 512 + h * 128 + ct * 16 + n] = o[r];
}
__device__ __forceinline__ void scan_dn_seq(const Args& a, LAS unsigned char* lds, int chain, int ct, int lane, const RingSync& rs) {
    const int dir = chain & 1, h = (chain >> 1) & 3, b = chain >> 3, w = ct & 3;
    const int n = lane & 15, g = lane >> 4;
    float* OD = (float*)(a.ws + WS_ODN) + (size_t)dir * MALL * 512;
    f32x4 Sd[8];
#pragma unroll
    for (int i = 0; i < 8; ++i) Sd[i] = (f32x4){0.f, 0.f, 0.f, 0.f};
    DnBuf A, B;
    ring_wait_ready(rs, 0); dn_load(A, lds + RING_OFF, w, lane); ring_release(rs, w, 0, lane);
    for (int c = 0; c < DN_NSUB; c += 2) {
        ring_wait_ready(rs, c + 1); dn_load(B, lds + RING_OFF + ((c + 1) % RING_R) * RING_SLOT, w, lane); ring_release(rs, w, c + 1, lane);
        dn_step(A, Sd, OD, b, dir, h, c, ct, n, g);
        if (c + 2 < DN_NSUB) { ring_wait_ready(rs, c + 2); dn_load(A, lds + RING_OFF + ((c + 2) % RING_R) * RING_SLOT, w, lane); ring_release(rs, w, c + 2, lane); }
        dn_step(B, Sd, OD, b, dir, h, c + 1, ct, n, g);
    }
}

__device__ __forceinline__ void ring_issue(const Args& a, LAS unsigned char* lds, int kind, int chain, int half, int c, int lane) {
    const int dir = chain & 1, h = (chain >> 1) & 3, b = chain >> 3, grp = h >> 1;
    LAS unsigned char* slot = lds + RING_OFF + (c % RING_R) * RING_SLOT;
    const size_t u = (size_t)chain * DN_NSUB + c;
    int gi; const size_t mbase = mb_base(b, dir, c, gi);
#pragma unroll
    for (int p = 0; p < RING_NP; ++p) {
        const int off = p * 1024 + lane * 16; const unsigned char* gp = nullptr;
        if (kind == 0) { if (off < 12800) gp = a.ws + WS_DNC + u * 12800 + off; else if (off >= 13312 && off < 17408) gp = a.ws + WS_DNU + u * 8192 + half * 4096 + (off - 13312); else if (off == 17408) gp = a.ws + WS_DNG + u * 4; }
        else if (kind == 1) { if (p < 12) gp = a.ws + WS_MBC + ((size_t)(b * 2 + grp) * DN_NSUB + gi) * 12288 + off;
            else if (p < 16) gp = a.ws + WS_MXBC + ((mbase + (p - 12) * 4 + (lane >> 4)) * 768 + h * 64) * 4 + (lane & 15) * 16;
            else if (p == 16) gp = a.ws + WS_MDT + mbase * 64 + lane * 16; }
        else { if (off < 10496) gp = a.ws + WS_RWC + u * 10496 + off;
            else if (p >= 11 && p < 13) gp = a.ws + WS_RW + ((size_t)seqrow(b, dir, c * 16 + (p - 11) * 8 + (lane >> 3)) * 1280 + 512 + h * 64) * 2 + (lane & 7) * 16; }
        if (gp) __builtin_amdgcn_global_load_lds((const unsigned*)gp, (LAS unsigned*)(slot + p * 1024), 16, 0, 0);
        else asm volatile("s_nop 0");
    }
}
__device__ __forceinline__ void ring_loader(const Args& a, LAS unsigned char* lds, int kind, int chain, int half, int j, int lane, const RingSync& rs) {
    int c = j;
    ring_issue(a, lds, kind, chain, half, c, lane);
    for (; c < DN_NSUB; c += 4) {
        const int cn = c + 4;
        if (cn < DN_NSUB) {
            if (cn >= RING_R) { unsigned sp = 0; while ((rs.prog[0] < cn - RING_R + 1 || rs.prog[1] < cn - RING_R + 1 || rs.prog[2] < cn - RING_R + 1 || rs.prog[3] < cn - RING_R + 1) && ++sp < (1u << 24)) __builtin_amdgcn_s_sleep(1); }
            ring_issue(a, lds, kind, chain, half, cn, lane);
            if (kind == 0) asm volatile("s_waitcnt vmcnt(18)" ::: "memory"); else if (kind == 1) asm volatile("s_waitcnt vmcnt(17)" ::: "memory"); else asm volatile("s_waitcnt vmcnt(13)" ::: "memory");
        } else asm volatile("s_waitcnt vmcnt(0)" ::: "memory");
        if (lane == 0) rs.lready[j] = c + 1;
    }
}
__device__ __forceinline__ void phase_scan(const Args& a, LAS unsigned char* lds, int tid_, int bid, int G) {
    RingSync rs; rs.prog = (volatile LAS int*)(lds + 4096); rs.lready = (volatile LAS int*)(lds + 4096 + 64);
    for (int item = bid; item < 128; item += G) {
        if (tid_ < 8) { if (tid_ < 4) rs.prog[tid_] = 0; else rs.lready[tid_ - 4] = 0; }
        __syncthreads();
        const int tid = opq(tid_), w = tid >> 6, lane = tid & 63;
        if (item < 64) { const int chain = item >> 1, half = item & 1;
            if (w < 4) scan_dn_seq(a, lds, chain, half * 4 + w, lane, rs); else ring_loader(a, lds, 0, chain, half, w - 4, lane, rs); }
        else if (item < 96) { const int chain = item - 64;
            if (w < 4) scan_mamba_seq(a, lds, chain, w, lane, rs); else ring_loader(a, lds, 1, chain, 0, w - 4, lane, rs); }
        else { const int chain = item - 96;
            if (w < 4) scan_rw_seq(a, lds, chain, w, lane, rs); else ring_loader(a, lds, 2, chain, 0, w - 4, lane, rs); }
        __syncthreads();
    }
}

struct FnBuf { f32x4 xs, ym0, ym1, z, od0[2], od1[2], gt[2], yr0, yr1, g; u32x2 rr, kk, vv; };
__device__ __forceinline__ void fn_load(FnBuf& B, const Args& a, int row, int lane) {
    const float* P = (const float*)(a.ws + WS_P);
    const float* MX = (const float*)(a.ws + WS_MXBC); const float* YM = (const float*)(a.ws + WS_YM);
    const float* OD = (const float*)(a.ws + WS_ODN); const float* YR = (const float*)(a.ws + WS_YRW);
    const bf16_t* RW = (const bf16_t*)(a.ws + WS_RW); const float* RG = (const float*)(a.ws + WS_RWG);
    const int c4 = lane * 4;
    B.xs = *(const f32x4*)(MX + (size_t)row * 768 + c4);
    B.ym0 = *(const f32x4*)(YM + (size_t)row * 256 + c4); B.ym1 = *(const f32x4*)(YM + (size_t)(MALL + row) * 256 + c4);
    B.z = *(const f32x4*)(P + (size_t)row * INP + c4);
    int dr = row;
    if (row < NL) { const int b = row >> 12, t = row & 4095; dr = b * 4096 + (t & 63) * 64 + (t >> 6); }
#pragma unroll
    for (int blk = 0; blk < 2; ++blk) { const int ch = blk * 256 + c4;
        B.od0[blk] = *(const f32x4*)(OD + (size_t)dr * 512 + ch); B.od1[blk] = *(const f32x4*)(OD + (size_t)(MALL + dr) * 512 + ch);
        B.gt[blk] = *(const f32x4*)(P + (size_t)row * INP + DN_OFF + 1536 + ch); }
    B.yr0 = *(const f32x4*)(YR + (size_t)row * 256 + c4); B.yr1 = *(const f32x4*)(YR + (size_t)(MALL + row) * 256 + c4);
    const bf16_t* rwp = RW + (size_t)row * 1280 + c4;
    B.rr = *(const u32x2*)rwp; B.kk = *(const u32x2*)(rwp + 256); B.vv = *(const u32x2*)(rwp + 512);
    B.g = *(const f32x4*)(RG + (size_t)row * 256 + c4);
}
__device__ __forceinline__ f32x4 up4(u32x2 v) { return (f32x4){__builtin_bit_cast(float, v.x << 16), __builtin_bit_cast(float, v.x & 0xffff0000u), __builtin_bit_cast(float, v.y << 16), __builtin_bit_cast(float, v.y & 0xffff0000u)}; }
__device__ __forceinline__ void fn_step(const FnBuf& B, const Args& a, int L, int row, int lane) {
    const int c4 = lane * 4;
    bf16_t* yo = (bf16_t*)(a.ws + WS_YMIX) + (size_t)row * D;
    {
        const float dsk = a.in[14][L * 4 + (lane >> 4)];
        f32x4 y = B.xs * dsk + B.ym0 + B.ym1;
#pragma unroll
        for (int i = 0; i < 4; ++i) y[i] *= siluf(B.z[i]);
        const float ss = grp_sum<32>((y.x * y.x + y.y * y.y) + (y.z * y.z + y.w * y.w));
        const float r = frsq(ss * (1.f / 128.f) + 1e-5f);
        const f32x4 nw = *(const f32x4*)(a.in[15] + L * 256 + c4);
        y = y * r * nw;
        u32x2 pk; pk.x = cvt2(y.x, y.y); pk.y = cvt2(y.z, y.w); *(u32x2*)(yo + c4) = pk;
    }
#pragma unroll
    for (int blk = 0; blk < 2; ++blk) {
        const int ch = blk * 256 + c4;
        f32x4 o = B.od0[blk] + B.od1[blk];
        const float ss = grp_sum<32>((o.x * o.x + o.y * o.y) + (o.z * o.z + o.w * o.w));
        const float r = frsq(ss * (1.f / 128.f) + 1e-6f);
        const f32x4 nw = *(const f32x4*)(a.in[19] + L * 128 + (ch & 127));
#pragma unroll
        for (int i = 0; i < 4; ++i) o[i] = o[i] * r * nw[i] * siluf(B.gt[blk][i]);
        u32x2 pk; pk.x = cvt2(o.x, o.y); pk.y = cvt2(o.z, o.w); *(u32x2*)(yo + 256 + ch) = pk;
    }
    {
        f32x4 y = B.yr0 + B.yr1;
        const float mean = grp_sum<16>((y.x + y.y) + (y.z + y.w)) * (1.f / 64.f);
        y = y - mean;
        const float var = grp_sum<16>((y.x * y.x + y.y * y.y) + (y.z * y.z + y.w * y.w)) * (1.f / 64.f);
        const float r = frsq(var + 64e-5f);
        const f32x4 lw = *(const f32x4*)(a.in[29] + L * 256 + c4), lb = *(const f32x4*)(a.in[30] + L * 256 + c4);
        const f32x4 rv = up4(B.rr), kv = up4(B.kk), vv = up4(B.vv);
        const f32x4 rkw = *(const f32x4*)(a.in[28] + L * 256 + c4);
        const float bs = grp_sum<16>((rv.x * kv.x * rkw.x + rv.y * kv.y * rkw.y) + (rv.z * kv.z * rkw.z + rv.w * kv.w * rkw.w));
        f32x4 o = (y * r * lw + lb + vv * bs) * B.g;
        u32x2 pk; pk.x = cvt2(o.x, o.y); pk.y = cvt2(o.z, o.w); *(u32x2*)(yo + 768 + c4) = pk;
    }
}
__device__ __forceinline__ void phase_finish(const Args& a, int L, int nrows, int lane_, int wave, int bid, int G) {
    const int lane = opq(lane_), r0 = bid * 8 + wave, st = G * 8;
    if (r0 >= nrows) return;
    FnBuf A, B; fn_load(A, a, r0, lane);
    for (int row = r0; row < nrows; row += 2 * st) {
        const int r1 = row + st, r2 = row + 2 * st;
        if (r1 < nrows) fn_load(B, a, r1, lane);
        fn_step(A, a, L, row, lane);
        if (r1 < nrows) { if (r2 < nrows) fn_load(A, a, r2, lane); fn_step(B, a, L, r1, lane); }
    }
}

__device__ __forceinline__ void phase_router(const Args& a, int L, int nrows, const float* xm, LAS unsigned char* lds, int tid, int lane, int wave, int bid, int G) {
    LAS float* wr = (LAS float*)lds;
    const float* wsrc = a.in[31] + (size_t)L * 1024 * 32;
    for (int i = tid; i < 8192; i += 512) { const f32x4 v = *(const f32x4*)(wsrc + i * 4); const int k = i >> 3, e = (i & 7) * 4;
        wr[(e + 0) * 1024 + k] = v.x; wr[(e + 1) * 1024 + k] = v.y; wr[(e + 2) * 1024 + k] = v.z; wr[(e + 3) * 1024 + k] = v.w; }
    __syncthreads();
    const float* mod = (const float*)(a.ws + WS_MOD) + (size_t)L * 5 * 6144;
    bf16_t* H2 = (bf16_t*)(a.ws + WS_HN);
    int* tok = (int*)(a.ws + WS_TOK + (size_t)L * TOK_STRIDE);
    LAS unsigned* hist = (LAS unsigned*)(lds + RING_BYTES + 2048);
    if (tid < 32) hist[tid] = 0u;
    __syncthreads();
    const float brt = lane < 32 ? a.in[32][L * 32 + lane] : 0.f;
    for (int row = bid * 8 + wave; row < nrows; row += G * 8) {
        const int bi = row < NL ? (row >> 12) : 4;
        f32x4 v[4];
#pragma unroll
        for (int j = 0; j < 4; ++j) v[j] = *(const f32x4*)(xm + (size_t)row * D + j * 256 + lane * 4);
        norm_mod_store(v, a.in[7] + L * D, mod + (size_t)bi * 6144 + 3 * 1024, mod + (size_t)bi * 6144 + 4 * 1024, H2 + (size_t)row * D, lane);
        float mine = -3.0e38f;
#pragma unroll 4
        for (int e = 0; e < 32; ++e) { float p = 0.f;
#pragma unroll
            for (int j = 0; j < 4; ++j) { const f32x4 w4 = *(const LAS f32x4*)(wr + e * 1024 + j * 256 + lane * 4); p += (v[j].x * w4.x + v[j].y * w4.y) + (v[j].z * w4.z + v[j].w * w4.w); }
            p = wave_sum(p);
            if (lane == e) mine = p + brt; }
        float tl[4]; int te[4];
#pragma unroll
        for (int k = 0; k < 4; ++k) { const float m = wave_max(mine); const unsigned long long bal = __ballot(mine == m); const int idx = __ffsll((long long)bal) - 1;
            tl[k] = m; te[k] = idx; if (lane == idx) mine = -3.0e38f; }
        const float e1 = __expf(tl[1] - tl[0]), e2 = __expf(tl[2] - tl[0]), e3 = __expf(tl[3] - tl[0]); const float inv = 1.f / (1.f + e1 + e2 + e3);
        if (lane < 4) { const int e = lane == 0 ? te[0] : lane == 1 ? te[1] : lane == 2 ? te[2] : te[3];
            const float g = (lane == 0 ? 1.f : lane == 1 ? e1 : lane == 2 ? e2 : e3) * inv;
            const unsigned pos = __hip_atomic_fetch_add(hist + e, 1u, __ATOMIC_RELAXED, __HIP_MEMORY_SCOPE_WORKGROUP);
            tok[TK_E + row * 4 + lane] = e; ((float*)tok)[TK_G + row * 4 + lane] = g; tok[TK_POS + row * 4 + lane] = (int)pos; }
    }
    __syncthreads();
    if (tid < 32) tok[TK_BCNT + bid * 32 + tid] = (int)hist[tid];
}
__device__ __forceinline__ void phase_scatter(const Args& a, int L, int nrows, LAS unsigned char* lds, int tid, int lane, int wave, int bid, int G) {
    LAS int* ps = (LAS int*)lds;
    int* tok = (int*)(a.ws + WS_TOK + (size_t)L * TOK_STRIDE);
    if (tid < 32) { int tot = 0, off = 0; for (int b = 0; b < G; ++b) { const int c = tok[TK_BCNT + b * 32 + tid]; tot += c; off += (b < bid) ? c : 0; } ps[64 + tid] = tot; ps[128 + tid] = off; }
    __syncthreads();
    if (tid == 0) { int acc = 0; for (int e = 0; e < 32; ++e) { ps[e] = acc; acc += (ps[64 + e] + 255) & ~255; } ps[32] = acc; }
    __syncthreads();
    if (tid < 32) ps[128 + tid] += ps[tid];
    if (bid == 0) { const int nblk = ps[32] >> 8;
        for (int m = tid; m < MAXBLK; m += 512) { int e = 0; for (int q = 1; q < 32; ++q) if ((m << 8) >= ps[q]) e = q; tok[TK_BLKE + m] = e; }
        if (tid == 0) tok[TK_NBLK] = nblk; }
    __syncthreads();
    const bf16_t* H2 = (const bf16_t*)(a.ws + WS_HN); bf16_t* HS = (bf16_t*)(a.ws + WS_HS);
    for (int row = bid * 8 + wave; row < nrows; row += G * 8) {
        const u32x4 d0 = *(const u32x4*)(H2 + (size_t)row * D + lane * 8), d1 = *(const u32x4*)(H2 + (size_t)row * D + 512 + lane * 8);
#pragma unroll
        for (int k = 0; k < 4; ++k) { const int e = tok[TK_E + row * 4 + k], pos = tok[TK_POS + row * 4 + k]; const int slot = ps[128 + e] + pos;
            *(u32x4*)(HS + (size_t)slot * D + lane * 8) = d0; *(u32x4*)(HS + (size_t)slot * D + 512 + lane * 8) = d1;
            if (lane == 0) tok[TK_SLOT + row * 4 + k] = slot; }
    }
}
struct CbTok { int slot[4]; float g[4]; };
struct CbBuf { u32x2 y[4][4]; f32x4 x[4]; float g[4]; };
__device__ __forceinline__ void cb_tok(CbTok& T, const int* tok, int row) {
#pragma unroll
    for (int k = 0; k < 4; ++k) { T.slot[k] = tok[TK_SLOT + row * 4 + k]; T.g[k] = ((const float*)tok)[TK_G + row * 4 + k]; }
}
__device__ __forceinline__ void cb_load(CbBuf& B, const CbTok& T, const bf16_t* Y, const float* xm, int row, int lane) {
#pragma unroll
    for (int k = 0; k < 4; ++k) { B.g[k] = T.g[k];
#pragma unroll
        for (int j = 0; j < 4; ++j) B.y[k][j] = *(const u32x2*)(Y + (size_t)T.slot[k] * D + j * 256 + lane * 4); }
#pragma unroll
    for (int j = 0; j < 4; ++j) B.x[j] = *(const f32x4*)(xm + (size_t)row * D + j * 256 + lane * 4);
}
__device__ __forceinline__ void cb_finish(const CbBuf& B, const Args& a, int L, const float* mod, int row, int lane) {
    const int bi = row < NL ? (row >> 12) : 4;
    f32x4 v[4];
#pragma unroll
    for (int j = 0; j < 4; ++j) { f32x4 acc = {0.f, 0.f, 0.f, 0.f};
#pragma unroll
        for (int k = 0; k < 4; ++k) { const u32x2 yv = B.y[k][j];
            acc += (f32x4){__builtin_bit_cast(float, yv.x << 16), __builtin_bit_cast(float, yv.x & 0xffff0000u), __builtin_bit_cast(float, yv.y << 16), __builtin_bit_cast(float, yv.y & 0xffff0000u)} * B.g[k]; }
        v[j] = B.x[j] + *(const f32x4*)(mod + (size_t)bi * 6144 + 5 * 1024 + j * 256 + lane * 4) * acc; }
    if (L == 0) {
        float* xb = (float*)(a.ws + WS_XB) + (size_t)row * D;
#pragma unroll
        for (int j = 0; j < 4; ++j) *(f32x4*)(xb + j * 256 + lane * 4) = v[j];
        const float* mod1 = (const float*)(a.ws + WS_MOD) + (size_t)5 * 6144;
        norm_mod_store(v, a.in[6] + D, mod1 + (size_t)bi * 6144, mod1 + (size_t)bi * 6144 + 1024, (bf16_t*)(a.ws + WS_HN) + (size_t)row * D, lane);
    } else {
        float ss = 0.f;
#pragma unroll
        for (int j = 0; j < 4; ++j) ss += (v[j].x * v[j].x + v[j].y * v[j].y) + (v[j].z * v[j].z + v[j].w * v[j].w);
        const float r = frsq(wave_sum(ss) * (1.f / D) + 1e-6f);
#pragma unroll
        for (int j = 0; j < 4; ++j) { const int c = j * 256 + lane * 4; *(f32x4*)(a.out + (size_t)row * D + c) = v[j] * r * *(const f32x4*)(a.in[37] + c); }
    }
}
__device__ __forceinline__ void phase_combine(const Args& a, int L, int nrows, const float* xm, int lane_, int wave, int bid, int G) {
    const float* mod = (const float*)(a.ws + WS_MOD) + (size_t)L * 5 * 6144;
    const int* tok = (const int*)(a.ws + WS_TOK + (size_t)L * TOK_STRIDE);
    const bf16_t* Y = (const bf16_t*)(a.ws + WS_Y);
    const int lane = opq(lane_), r0 = bid * 8 + wave, st = G * 8;
    if (r0 >= nrows) return;
    CbTok T0, T1; CbBuf A, B;
    cb_tok(T0, tok, r0); cb_load(A, T0, Y, xm, r0, lane);
    if (r0 + st < nrows) cb_tok(T1, tok, r0 + st);
    for (int row = r0; row < nrows; row += 2 * st) {
        const int r1 = row + st, r2 = row + 2 * st, r3 = row + 3 * st;
        if (r1 < nrows) cb_load(B, T1, Y, xm, r1, lane);
        if (r2 < nrows) cb_tok(T0, tok, r2);
        cb_finish(A, a, L, mod, row, lane);
        if (r1 < nrows) {
            if (r2 < nrows) cb_load(A, T0, Y, xm, r2, lane);
            if (r3 < nrows) cb_tok(T1, tok, r3);
            cb_finish(B, a, L, mod, r1, lane);
        }
    }
}

__global__ void __launch_bounds__(512, 2) fwd_kernel(Args a) {
    extern __shared__ __attribute__((aligned(16))) unsigned char lds_raw[];
    LAS unsigned char* lds = (LAS unsigned char*)lds_raw;
    const int wave0 = __builtin_amdgcn_readfirstlane((int)threadIdx.x >> 6), bid = blockIdx.x, G = gridDim.x;
    const int tid0 = threadIdx.x;
    volatile LAS unsigned* MISC = (volatile LAS unsigned*)(lds + MISC_OFF);
    for (int u = tid0; u < (LDS_BYTES - RING_BYTES) / 4; u += 512) ((LAS unsigned*)(lds + RING_BYTES))[u] = 0u;
    __syncthreads();
    const int lo = a.ph_lo, hi = a.ph_hi;
    XcdBarrier bar; bar.bar = (unsigned*)(a.ws + WS_CTL) + CW_BAR; bar.x = 0; bar.st = nullptr;
    if (hi - lo > 1) bar = xcd_barrier_post((unsigned*)(a.ws + WS_CTL) + CW_BAR, MISC + 8);
#define IN(k) (lo <= (k) && (k) < hi)
#define SEAM(k) do { if (IN(k) && IN((k) + 1)) xcd_barrier(bar); } while (0)

#define PH_IDS const int lane = lane_id_v(), wave = wave0, tid = wave0 * 64 + lane
    if (IN(0)) for (int rep_ = 0; rep_ < REPN(0); ++rep_) { PH_IDS; phase_prep(a, lds, tid, lane, wave, bid, G); __syncthreads(); }
    SEAM(0);
    if (IN(1)) { PH_IDS; phase_norm1(a, 0, a.in[0], a.in[2], lane, wave, bid, G); }
    SEAM(1);
    for (int L = 0; L < 2; ++L) {
        const int pb = 2 + L * 10;
        const float* xl = L == 0 ? a.in[0] : (const float*)(a.ws + WS_XB);
        const float* xc = L == 0 ? a.in[2] : (const float*)(a.ws + WS_XB) + (size_t)NL * D;
        const int nrows = L == 0 ? MALL : NL;
        float* xm = (float*)(a.ws + WS_XA);
        int* tok = (int*)(a.ws + WS_TOK + (size_t)L * TOK_STRIDE);
        if (IN(pb + 0)) for (int rep_ = 0; rep_ < REPN(2); ++rep_) {
            pg8::StaticSched S; S.init((const bf16_t*)(a.ws + WS_HN), (const bf16_t*)(a.ws + WS_WIN) + (size_t)L * INP * 1024, MALL, INP, 1024, G, bid);
            EpiP E{(float*)(a.ws + WS_P)};
            pg8::gemm_phase<EpiP, pg8::StaticSched>(lds, 1024, S, E, wave0);
        }
        SEAM(pb + 0);
        if (IN(pb + 1)) for (int rep_ = 0; rep_ < REPN(3); ++rep_) { PH_IDS; phase_mixprep(a, L, lds, lane, wave, bid, G); }
        SEAM(pb + 1);
        if (IN(pb + 2)) for (int rep_ = 0; rep_ < REPN(4); ++rep_) { for (int r2_ = 0; r2_ < 1 + (PROBE_SCAN & 1); ++r2_) { PH_IDS; for (int r3_ = 0; r3_ < 1 + ((PROBE_SCAN >> 2) & 1); ++r3_) phase_dnpre(a, lds, lane, wave, bid, G); for (int r3_ = 0; r3_ < 1 + ((PROBE_SCAN >> 3) & 1); ++r3_) phase_mbpre(a, lane, wave, bid, G); for (int r3_ = 0; r3_ < 1 + ((PROBE_SCAN >> 4) & 1); ++r3_) phase_rwpre(a, lds, lane, wave, bid, G); } if (hi - lo > 1) xcd_barrier(bar); for (int r2_ = 0; r2_ < 1 + ((PROBE_SCAN >> 1) & 1); ++r2_) { PH_IDS; phase_scan(a, lds, tid, bid, G); } }
        SEAM(pb + 2);
        if (IN(pb + 3)) for (int rep_ = 0; rep_ < REPN(5); ++rep_) { PH_IDS; phase_finish(a, L, nrows, lane, wave, bid, G); }
        SEAM(pb + 3);
        if (IN(pb + 4)) for (int rep_ = 0; rep_ < REPN(6); ++rep_) {
            pg8::StaticSched S; S.init((const bf16_t*)(a.ws + WS_YMIX), (const bf16_t*)(a.ws + WS_WOUT) + (size_t)L * 1024 * 1024, nrows, 1024, 1024, G, bid);
            EpiOut E{xl, xc, xm, (const float*)(a.ws + WS_MOD) + (size_t)L * 5 * 6144 + 2 * 1024};
            pg8::gemm_phase<EpiOut, pg8::StaticSched>(lds, 1024, S, E, wave0);
        }
        SEAM(pb + 4);
        if (IN(pb + 5)) { PH_IDS; phase_router(a, L, nrows, xm, lds, tid, lane, wave, bid, G); }
        SEAM(pb + 5);
        if (IN(pb + 6)) for (int rep_ = 0; rep_ < REPN(8); ++rep_) { PH_IDS; phase_scatter(a, L, nrows, lds, tid, lane, wave, bid, G); __syncthreads(); }
        SEAM(pb + 6);
        if (IN(pb + 7)) for (int rep_ = 0; rep_ < REPN(9); ++rep_) {
            pg8::MoeSched S; S.nN = 8; S.nunits = tok[TK_NBLK] * 8; S.G = G; S.c = bid; S.A = (const char*)(a.ws + WS_HS); S.W = (const char*)(a.ws + WS_WGU) + (size_t)L * 32 * 2048 * 1024 * 2;
            S.tstep = (size_t)256 * 1024 * 2; S.estride = (size_t)2048 * 1024 * 2; S.blk_e = tok + TK_BLKE;
            EpiGU E{(bf16_t*)(a.ws + WS_ACT), a.in[34] + (size_t)L * 32 * 2048, tok + TK_BLKE};
            pg8::gemm_phase<EpiGU, pg8::MoeSched>(lds, 1024, S, E, wave0);
        }
        SEAM(pb + 7);
        if (IN(pb + 8)) for (int rep_ = 0; rep_ < REPN(10); ++rep_) {
            pg8::MoeSched S; S.nN = 4; S.nunits = tok[TK_NBLK] * 4; S.G = G; S.c = bid; S.A = (const char*)(a.ws + WS_ACT); S.W = (const char*)(a.ws + WS_WD) + (size_t)L * 32 * 1024 * 1024 * 2;
            S.tstep = (size_t)256 * 1024 * 2; S.estride = (size_t)1024 * 1024 * 2; S.blk_e = tok + TK_BLKE;
            EpiDown E{(bf16_t*)(a.ws + WS_Y), a.in[36] + (size_t)L * 32 * 1024, tok + TK_BLKE};
            pg8::gemm_phase<EpiDown, pg8::MoeSched>(lds, 1024, S, E, wave0);
        }
        SEAM(pb + 8);
        if (IN(pb + 9)) for (int rep_ = 0; rep_ < REPN(11); ++rep_) { PH_IDS; phase_combine(a, L, nrows, xm, lane, wave, bid, G); }
        SEAM(pb + 9);
    }
#undef IN
#undef SEAM
}

extern "C" void kernel_launch(void* const* d_in, const int* in_sizes, int n_in, void* d_out, int out_size, void* d_ws, size_t ws_size, hipStream_t stream) {
    static int grid = 0;
    if (grid == 0) {
        if (n_in != 38 || ws_size < WS_END) { fprintf(stderr, "kernel_launch: unexpected n_in %d / ws %zu\n", n_in, ws_size); grid = -1; return; }
        int dev = 0, cus = 0, per_cu = 0;
        if (hipGetDevice(&dev) != hipSuccess || hipDeviceGetAttribute(&cus, hipDeviceAttributeMultiprocessorCount, dev) != hipSuccess) { grid = -1; return; }
        if (hipFuncSetAttribute((const void*)fwd_kernel, hipFuncAttributeMaxDynamicSharedMemorySize, LDS_BYTES) != hipSuccess) { fprintf(stderr, "kernel_launch: hipFuncSetAttribute failed\n"); grid = -1; return; }
        if (hipOccupancyMaxActiveBlocksPerMultiprocessor(&per_cu, (const void*)fwd_kernel, 512, LDS_BYTES) != hipSuccess || per_cu < 1) { fprintf(stderr, "kernel_launch: occupancy query says %d\n", per_cu); }
        (void)hipGetLastError();
        grid = cus;
    }
    if (grid < 0) return;
    (void)hipMemsetAsync((char*)d_ws + WS_CTL, 0, CTL_BYTES, stream);
    Args a{};
    for (int i = 0; i < 38; ++i) a.in[i] = (const float*)d_in[i];
    a.out = (float*)d_out; a.ws = (unsigned char*)d_ws;
#if MK_PER_PHASE
    for (int p = 0; p < NPHASE; ++p) { a.ph_lo = p; a.ph_hi = p + 1; hipLaunchKernelGGL(fwd_kernel, dim3(grid), dim3(512), LDS_BYTES, stream, a); }
#else
    a.ph_lo = 0; a.ph_hi = NPHASE;
    hipLaunchKernelGGL(fwd_kernel, dim3(grid), dim3(512), LDS_BYTES, stream, a);
#endif
}
```

```cpp
#include <hip/hip_runtime.h>
#include <cstdio>
#include <cstdint>

#ifndef PROBE_REP
#define PROBE_REP 0
#endif
#define REPN(k) ((((PROBE_REP) >> (k)) & 1) + 1)
#ifndef PROBE_SCAN
#define PROBE_SCAN 0
#endif
#ifndef PROBE_MIX
#define PROBE_MIX 0
#endif
#ifndef MIXPARTS
#define MIXPARTS 7
#endif
#ifndef MK_PER_PHASE
#define MK_PER_PHASE 0
#endif

#define GAS __attribute__((address_space(1)))
#define LAS __attribute__((address_space(3)))
typedef unsigned short bf16_t;
typedef short bf16x8 __attribute__((ext_vector_type(8)));
typedef float f32x4 __attribute__((ext_vector_type(4)));
typedef unsigned u32x4 __attribute__((ext_vector_type(4)));
typedef unsigned u32x2 __attribute__((ext_vector_type(2)));

constexpr int D = 1024, NB = 4, SEQ = 4096, CTXL = 256;
constexpr int NL = NB * SEQ, NC = NB * CTXL, MALL = NL + NC;
constexpr int INC = 4184, INP = 4352;
constexpr int DN_OFF = 1032, RW_OFF = 3096;
constexpr int NE = 32, DFF = 1024;
constexpr int MAXBLK = 304, MAXSLOT = MAXBLK * 256;
constexpr int NPHASE = 22;

constexpr size_t MiB = 1u << 20;
constexpr size_t WS_CTL = 0, CTL_BYTES = 1 * MiB;
constexpr size_t WS_MOD = 1 * MiB;
constexpr size_t WS_LORA = 1 * MiB + 512 * 1024;
constexpr size_t WS_TOK = 1332 * MiB, TOK_STRIDE = 2 * MiB;
constexpr size_t WS_WIN = 4 * MiB, WS_WOUT = 21 * MiB, WS_WGU = 25 * MiB, WS_WD = 281 * MiB;
constexpr size_t WS_XA = 409 * MiB, WS_XB = 477 * MiB, WS_HN = 545 * MiB, WS_YMIX = 579 * MiB;
constexpr size_t WS_P = 613 * MiB, WS_MXBC = 902 * MiB, WS_MDT = 953 * MiB, WS_DNQKV = 955 * MiB, WS_DNGB = 1057 * MiB;
constexpr size_t WS_RWW = 1108 * MiB;
constexpr size_t WS_RW = 1060 * MiB, WS_RWG = 1179 * MiB, WS_YM = 1196 * MiB, WS_ODN = 1230 * MiB, WS_YRW = 1298 * MiB;
constexpr size_t WS_DNC = 1336 * MiB, WS_DNU = 1482 * MiB, WS_DNG = 1550 * MiB, WS_MBC = 1551 * MiB, WS_RWC = 1585 * MiB, WS_END = 1724 * MiB;
constexpr int DN_NSUB = (CTXL + SEQ) / 16, DN_UNITS = 32 * DN_NSUB, MB_UNITS = 8 * DN_NSUB;
constexpr int DN_UNITS_DUMMY = 0;
constexpr size_t WS_HS = WS_P, WS_ACT = 765 * MiB, WS_Y = 917 * MiB;
constexpr int CW_CNT = 64;
constexpr int CW_BAR = 4096;
constexpr int TK_E = 0, TK_G = MALL * 4, TK_POS = MALL * 8, TK_SLOT = MALL * 12, TK_BLKE = MALL * 16, TK_NBLK = MALL * 16 + 512, TK_BCNT = MALL * 16 + 1024;

constexpr int RING_BYTES = 131072, LDS_BYTES = 147456, MISC_OFF = LDS_BYTES - 256;

struct Args { const float* in[38]; float* out; unsigned char* ws; int ph_lo, ph_hi; };

__device__ __forceinline__ unsigned f2bf(float f) { unsigned u = __builtin_bit_cast(unsigned, f); return (u + 0x7fffu + ((u >> 16) & 1u)) >> 16; }
__device__ __forceinline__ unsigned pk2(float lo, float hi) { return f2bf(lo) | (f2bf(hi) << 16); }
__device__ __forceinline__ f32x4 ldp4(const bf16_t* p) { const u32x2 v = *(const u32x2*)p; return (f32x4){__builtin_bit_cast(float, v.x << 16), __builtin_bit_cast(float, v.x & 0xffff0000u), __builtin_bit_cast(float, v.y << 16), __builtin_bit_cast(float, v.y & 0xffff0000u)}; }
__device__ __forceinline__ float frcp(float x) { return __builtin_amdgcn_rcpf(x); }
__device__ __forceinline__ float frsq(float x) { return __builtin_amdgcn_rsqf(x); }
typedef __bf16 bf16x2_t __attribute__((ext_vector_type(2)));
typedef float f32x2_ __attribute__((ext_vector_type(2)));
__device__ __forceinline__ unsigned cvt2(float lo, float hi) { const f32x2_ v = {lo, hi}; return __builtin_bit_cast(unsigned, __builtin_convertvector(v, bf16x2_t)); }
__device__ __forceinline__ float siluf(float x) { return x * frcp(1.f + __expf(-x)); }
__device__ __forceinline__ float sigm(float x) { return frcp(1.f + __expf(-x)); }
__device__ __forceinline__ float softplusf(float x) { return fmaxf(x, 0.f) + __logf(1.f + __expf(-fabsf(x))); }
__device__ __forceinline__ float tanh_fast(float x) { return 1.f - 2.f * frcp(__expf(2.f * x) + 1.f); }
template <int CTRL> __device__ __forceinline__ float dppf(float v) { return __builtin_bit_cast(float, __builtin_amdgcn_update_dpp(0, __builtin_bit_cast(int, v), CTRL, 0xF, 0xF, true)); }
__device__ __forceinline__ void pswap16(float& a, float& b) { asm("s_nop 1\n\tv_permlane16_swap_b32 %0, %1" : "+v"(a), "+v"(b)); }
__device__ __forceinline__ void pswap32(float& a, float& b) { asm("s_nop 1\n\tv_permlane32_swap_b32 %0, %1" : "+v"(a), "+v"(b)); }
template <int W> __device__ __forceinline__ float grp_sum(float v) {
    v += dppf<0xB1>(v); v += dppf<0x4E>(v); v += dppf<0x141>(v); v += dppf<0x140>(v);
    if (W >= 32) { float a = v, b = v; pswap16(a, b); v = a + b; }
    if (W >= 64) { float a = v, b = v; pswap32(a, b); v = a + b; }
    return v;
}
__device__ __forceinline__ float wave_sum(float v) { return grp_sum<64>(v); }
__device__ __forceinline__ float wave_max(float v) {
    v = fmaxf(v, dppf<0xB1>(v)); v = fmaxf(v, dppf<0x4E>(v)); v = fmaxf(v, dppf<0x141>(v)); v = fmaxf(v, dppf<0x140>(v));
    { float a = v, b = v; pswap16(a, b); v = fmaxf(a, b); }
    { float a = v, b = v; pswap32(a, b); v = fmaxf(a, b); }
    return v;
}
#define LDS_WAIT() asm volatile("s_waitcnt lgkmcnt(0)" ::: "memory")
__device__ __forceinline__ int lane_id_v() { int l; asm volatile("v_mbcnt_lo_u32_b32 %0, -1, 0\n\tv_mbcnt_hi_u32_b32 %0, -1, %0" : "=v"(l)); return l; }
__device__ __forceinline__ int opq(int v) { asm volatile("" : "+v"(v)); return v; }

#define XB_TMO      128
#define XB_XCNT(j)  (256  + 64 * (j))
#define XB_XSUB(j)  (1280 + 64 * (j))
#define XB_XGEN(j)  (2304 + 64 * (j))
#define XB_TOP      3328
#define XB_TOPGEN   3392
#define XCD_BAR_WORDS 3456
#define XB_SPIN_CAP (1u << 18)
__device__ __forceinline__ unsigned xb_ld(unsigned* p)              { return __hip_atomic_load(p, __ATOMIC_RELAXED, __HIP_MEMORY_SCOPE_AGENT); }
__device__ __forceinline__ unsigned xb_add(unsigned* p, unsigned v) { return __hip_atomic_fetch_add(p, v, __ATOMIC_RELAXED, __HIP_MEMORY_SCOPE_AGENT); }
__device__ __forceinline__ unsigned xb_xcc_id() { return (unsigned)__builtin_amdgcn_s_getreg((3 << 11) | 20) & 0xFu; }
#define XB_SPIN(cond, bar) do { unsigned _sp = 0; while (cond) { __builtin_amdgcn_s_sleep(1); \
    if ((++_sp & 255u) == 0u) { if (xb_ld(&(bar)[XB_TMO])) break; if (_sp > XB_SPIN_CAP) { atomicAdd(&(bar)[XB_TMO], 1u); break; } } } } while (0)
struct XcdBarrier { unsigned* bar; unsigned x; volatile LAS unsigned* st; };
__device__ __forceinline__ XcdBarrier xcd_barrier_post(unsigned* bar, volatile LAS unsigned* st) {
    XcdBarrier b; b.bar = bar; b.x = xb_xcc_id(); b.st = st;
    if (threadIdx.x == 0) (void)xb_add(&bar[XB_XCNT(b.x)], 1u);
    return b;
}
__device__ __forceinline__ void xcd_barrier_complete(unsigned* bar, unsigned x, unsigned& nloc, unsigned& nx) {
    const unsigned G = gridDim.x * gridDim.y * gridDim.z;
    unsigned sum, cnt, mine, sp = 0u;
    for (;;) {
        sum = 0u; cnt = 0u; mine = 0u;
#pragma unroll
        for (unsigned j = 0; j < 16; ++j) { const unsigned c = xb_ld(&bar[XB_XCNT(j)]); sum += c; cnt += (c > 0u) ? 1u : 0u; mine = (j == x) ? c : mine; }
        if (sum == G) break;
        __builtin_amdgcn_s_sleep(1);
        if ((++sp & 255u) == 0u) { if (xb_ld(&bar[XB_TMO])) break; if (sp > XB_SPIN_CAP) { atomicAdd(&bar[XB_TMO], 1u); break; } }
    }
    nloc = mine > 0u ? mine : 1u; nx = cnt > 0u ? cnt : 1u;
}
__device__ __forceinline__ void xcd_barrier(const XcdBarrier& b) {
    asm volatile("s_waitcnt vmcnt(0)" ::: "memory");
    __syncthreads();
    if (threadIdx.x == 0) {
        unsigned* bar = b.bar;
        __builtin_amdgcn_s_waitcnt(0);
        unsigned nloc = b.st[0], nx = b.st[1];
        if (nloc == 0u) { xcd_barrier_complete(bar, b.x, nloc, nx); b.st[0] = nloc; b.st[1] = nx; }
        const unsigned old = xb_add(&bar[XB_XSUB(b.x)], 1u);
        const unsigned gen = old / nloc;
        if (old + 1u == (gen + 1u) * nloc) {
            __builtin_amdgcn_fence(__ATOMIC_RELEASE, "agent");
            asm volatile("s_waitcnt vmcnt(0)" ::: "memory");
            const unsigned og = xb_add(&bar[XB_TOP], 1u);
            const unsigned tg = og / nx;
            if (og + 1u == (tg + 1u) * nx) xb_add(&bar[XB_TOPGEN], 1u);
            else XB_SPIN(xb_ld(&bar[XB_TOPGEN]) == tg, bar);
            __builtin_amdgcn_fence(__ATOMIC_ACQUIRE, "agent");
            xb_add(&bar[XB_XGEN(b.x)], 1u);
            asm volatile("s_waitcnt vmcnt(0)" ::: "memory");
        } else {
            XB_SPIN(xb_ld(&bar[XB_XGEN(b.x)]) == gen, bar);
            __builtin_amdgcn_fence(__ATOMIC_ACQUIRE, "agent");
            asm volatile("s_waitcnt vmcnt(0)" ::: "memory");
        }
    }
    __syncthreads();
}

namespace pg8 {
constexpr int BM = 256, BK = 64, HALF = 128, HTB = HALF * BK * 2, STAGE_BYTES = 8 * HTB, NXCD = 8, WGM = 8;
__host__ __device__ __forceinline__ int lds_byte(int r, int c) { const int st = (r >> 4) * 2 + (c >> 5), rr = r & 15, cc = c & 31, ob = rr * 64 + cc * 2; return st * 1024 + (ob ^ (((ob >> 9) & 1) << 5)); }
__host__ __device__ __forceinline__ void stage_rc(int b, int& R, int& C) { const int st = b / 1024, sb = b % 1024, swz = sb ^ (((sb >> 9) & 1) << 5); R = (st >> 1) * 16 + swz / 64; C = (st & 1) * 32 + (swz % 64) / 2; }
struct Unit { int pm, pn; };

struct StaticSched {
    int nM, nN, nwg, G, c; const char* A; const char* Bt; size_t tstep;
    __device__ void init(const bf16_t* A_, const bf16_t* Bt_, int M, int N, int K, int G_, int c_) { nM = M / BM; nN = N / BM; nwg = nM * nN; G = G_; c = c_; A = (const char*)A_; Bt = (const char*)Bt_; tstep = (size_t)BM * K * 2; }
    __device__ bool next(int i, Unit& u) const {
        const long L = (long)i * G + c; if (L >= nwg) return false;
        int wgid = (int)L; { const int q = nwg / NXCD, r = nwg % NXCD, xcd = wgid % NXCD, off = wgid / NXCD; wgid = (xcd < r ? xcd * (q + 1) : r * (q + 1) + (xcd - r) * q) + off; }
        const int nig = WGM * nN, gid = wgid / nig, fm = gid * WGM, gsz = (nM - fm) < WGM ? (nM - fm) : WGM;
        u.pm = fm + ((wgid % nig) % gsz); u.pn = (wgid % nig) / gsz; return true;
    }
    __device__ __forceinline__ const char* a_base(const Unit& u) const { return A + (size_t)u.pm * tstep; }
    __device__ __forceinline__ const char* b_base(const Unit& u) const { return Bt + (size_t)u.pn * tstep; }
};
struct MoeSched {
    int nunits, nN, G, c; const char* A; const char* W; size_t tstep, estride; const int* blk_e;
    __device__ bool next(int i, Unit& u) const {
        long L;
        if ((G & 7) == 0) { const int per = (nunits + 7) >> 3, v = i * (G >> 3) + (c >> 3); if (v >= per) return false; L = (long)(c & 7) * per + v; }
        else L = (long)i * G + c;
        if (L >= nunits) return false; u.pm = (int)(L / nN); u.pn = (int)(L % nN); return true; }
    __device__ __forceinline__ const char* a_base(const Unit& u) const { return A + (size_t)u.pm * tstep; }
    __device__ __forceinline__ const char* b_base(const Unit& u) const { return W + (size_t)blk_e[u.pm] * estride + (size_t)u.pn * tstep; }
};

template <class Epi, class Sched>
__device__ __forceinline__ void gemm_phase(LAS unsigned char* lds, const int K, const Sched& S, const Epi& E, const int wave0) {
    const int lane = lane_id_v(), wid = wave0, tid = wid * 64 + lane, wr = wid >> 2, wc = wid & 3, fr = lane & 15, fq = lane >> 4;
    const int nt = K / BK;
    unsigned voffA[2], voffB[2];
#pragma unroll
    for (int i = 0; i < 2; ++i) { int R, C; stage_rc(tid * 16 + i * 8192, R, C); voffA[i] = (unsigned)(R * K + C) * 2u; voffB[i] = voffA[i]; }
    asm volatile("" : "+v"(voffA[0]), "+v"(voffA[1]), "+v"(voffB[0]), "+v"(voffB[1]));
    const size_t kstep = (size_t)(BK * 2);
    const size_t hstep = (size_t)HALF * K * 2;
    const unsigned ldsw = (unsigned)wid * 1024u;
    const int aoff = lds_byte(wr * 64 + fr, fq * 8), boff = lds_byte(wc * 32 + fr, fq * 8);
#define PG8_SA(b, h) (((b) * 2 + (h)) * HTB)
#define PG8_SB(b, h) ((4 + (b) * 2 + (h)) * HTB)
#define PG8_STAGE(bufoff, gbase, voff) do { _Pragma("unroll") for (int _i = 0; _i < 2; ++_i) \
        __builtin_amdgcn_global_load_lds((const unsigned*)((const char*)(gbase) + (voff)[_i]), (LAS unsigned*)(lds + (bufoff) + ldsw + _i * 8192), 16, 0, 0); } while (0)
#define PG8_LDA(dst, b, h) do { _Pragma("unroll") for (int m = 0; m < 4; ++m) _Pragma("unroll") for (int k = 0; k < 2; ++k) dst[m][k] = *(const LAS bf16x8*)(lds + PG8_SA(b, h) + aoff + m * 2048 + k * 1024); } while (0)
#define PG8_LDB(dst, b, h) do { _Pragma("unroll") for (int n = 0; n < 2; ++n) _Pragma("unroll") for (int k = 0; k < 2; ++k) dst[n][k] = *(const LAS bf16x8*)(lds + PG8_SB(b, h) + boff + n * 2048 + k * 1024); } while (0)
#define PG8_MMA(ai, bj, At, Bt) do { __builtin_amdgcn_s_setprio(1); _Pragma("unroll") for (int m = 0; m < 4; ++m) _Pragma("unroll") for (int n = 0; n < 2; ++n) _Pragma("unroll") for (int k = 0; k < 2; ++k) \
        acc[ai][bj][m][n] = __builtin_amdgcn_mfma_f32_16x16x32_bf16(Bt[n][k], At[m][k], acc[ai][bj][m][n], 0, 0, 0); __builtin_amdgcn_s_setprio(0); } while (0)
#define PG8_WAIT_V(n) asm volatile("s_waitcnt vmcnt(" #n ")" ::: "memory")
#define PG8_WAIT_L(n) asm volatile("s_waitcnt lgkmcnt(" #n ")" ::: "memory")
#define PG8_BAR __builtin_amdgcn_s_barrier()
#define PG8_SCHED __builtin_amdgcn_sched_barrier(0)
    Unit cur, nxt; int ui = 0;
    if (!S.next(0, cur)) return;
    f32x4 acc[2][2][4][2];
#pragma unroll
    for (int a = 0; a < 2; ++a)
#pragma unroll
        for (int b = 0; b < 2; ++b)
#pragma unroll
            for (int m = 0; m < 4; ++m)
#pragma unroll
                for (int n = 0; n < 2; ++n) acc[a][b][m][n] = (f32x4){0.f, 0.f, 0.f, 0.f};
    bf16x8 At[4][2], B0[2][2], B1[2][2];
    const char* cA = S.a_base(cur); const char* cB = S.b_base(cur);
    PG8_STAGE(PG8_SB(0, 0), cB, voffB); PG8_STAGE(PG8_SA(0, 0), cA, voffA); PG8_STAGE(PG8_SB(0, 1), cB + hstep, voffB); PG8_STAGE(PG8_SA(0, 1), cA + hstep, voffA);
    if (wr == 1) PG8_BAR;
    PG8_WAIT_V(4); PG8_BAR;
    PG8_STAGE(PG8_SB(1, 0), cB + kstep, voffB); PG8_STAGE(PG8_SA(1, 0), cA + kstep, voffA); PG8_STAGE(PG8_SB(1, 1), cB + hstep + kstep, voffB);
    PG8_WAIT_V(6); PG8_BAR;
    for (;;) {
        const bool has_next = S.next(ui + 1, nxt);
        const char* nA = has_next ? S.a_base(nxt) : cA; const char* nB = has_next ? S.b_base(nxt) : cB;
        for (int t = 0; t < nt; t += 2) {
            const bool last = (t == nt - 2);
            const char* a1 = cA + (size_t)(t + 1) * kstep;
            const char* a2 = last ? nA : cA + (size_t)(t + 2) * kstep; const char* b2 = last ? nB : cB + (size_t)(t + 2) * kstep;
            const char* a3 = a2 + kstep; const char* b3 = b2 + kstep;
            PG8_LDB(B0, 0, 0); PG8_SCHED; PG8_LDA(At, 0, 0); PG8_STAGE(PG8_SA(1, 1), a1 + hstep, voffA);
            PG8_WAIT_L(8); PG8_BAR; PG8_WAIT_L(0); PG8_MMA(0, 0, At, B0); PG8_BAR; PG8_SCHED;
            PG8_LDB(B1, 0, 1); PG8_STAGE(PG8_SB(0, 0), b2, voffB);
            PG8_BAR; PG8_WAIT_L(0); PG8_MMA(0, 1, At, B1); PG8_BAR;
            PG8_LDA(At, 0, 1); PG8_STAGE(PG8_SA(0, 0), a2, voffA);
            PG8_BAR; PG8_WAIT_L(0); PG8_MMA(1, 0, At, B0); PG8_BAR; PG8_SCHED;
            PG8_STAGE(PG8_SB(0, 1), b2 + hstep, voffB);
            PG8_WAIT_V(6); PG8_BAR; PG8_MMA(1, 1, At, B1); PG8_BAR;
            PG8_LDB(B0, 1, 0); PG8_SCHED; PG8_LDA(At, 1, 0); PG8_STAGE(PG8_SA(0, 1), a2 + hstep, voffA);
            PG8_WAIT_L(8); PG8_BAR; PG8_WAIT_L(0); PG8_MMA(0, 0, At, B0); PG8_BAR; PG8_SCHED;
            PG8_LDB(B1, 1, 1); PG8_STAGE(PG8_SB(1, 0), b3, voffB);
            PG8_BAR; PG8_WAIT_L(0); PG8_MMA(0, 1, At, B1); PG8_BAR;
            PG8_LDA(At, 1, 1); PG8_STAGE(PG8_SA(1, 0), a3, voffA);
            PG8_BAR; PG8_WAIT_L(0); PG8_MMA(1, 0, At, B0); PG8_BAR; PG8_SCHED;
            PG8_STAGE(PG8_SB(1, 1), b3 + hstep, voffB);
            PG8_WAIT_V(6); PG8_BAR; PG8_MMA(1, 1, At, B1); PG8_BAR;
        }
        E(acc, cur, wr, wc, fr, fq);
        if (!has_next) break;
#pragma unroll
        for (int a = 0; a < 2; ++a)
#pragma unroll
            for (int b = 0; b < 2; ++b)
#pragma unroll
                for (int m = 0; m < 4; ++m)
#pragma unroll
                    for (int n = 0; n < 2; ++n) acc[a][b][m][n] = (f32x4){0.f, 0.f, 0.f, 0.f};
        cur = nxt; cA = nA; cB = nB; ++ui;
    }
    PG8_WAIT_V(0);
    if (wr == 0) PG8_BAR;
    PG8_BAR;
#undef PG8_SA
#undef PG8_SB
#undef PG8_STAGE
#undef PG8_LDA
#undef PG8_LDB
#undef PG8_MMA
#undef PG8_WAIT_V
#undef PG8_WAIT_L
#undef PG8_BAR
#undef PG8_SCHED
}
}

struct EpiP {
    float* C;
    __device__ __forceinline__ void operator()(const f32x4 (&acc)[2][2][4][2], const pg8::Unit& u, int wr, int wc, int fr, int fq) const {
        const int row0 = u.pm * 256 + wr * 64 + fr, col0 = u.pn * 256 + wc * 32 + 4 * fq;
#pragma unroll
        for (int ai = 0; ai < 2; ++ai)
#pragma unroll
            for (int m = 0; m < 4; ++m) { float* rowp = C + (size_t)(row0 + ai * 128 + m * 16) * INP + col0;
#pragma unroll
                for (int bj = 0; bj < 2; ++bj)
#pragma unroll
                    for (int n = 0; n < 2; ++n) *(f32x4*)(rowp + bj * 128 + n * 16) = acc[ai][bj][m][n]; }
    }
};
struct EpiOut {
    const float* xl; const float* xc; float* xo; const float* gate;
    __device__ __forceinline__ void operator()(const f32x4 (&acc)[2][2][4][2], const pg8::Unit& u, int wr, int wc, int fr, int fq) const {
        const bool lat = u.pm < 64; const int bi = lat ? (u.pm >> 4) : 4;
        const float* xin = lat ? xl + (size_t)u.pm * 256 * D : xc + (size_t)(u.pm - 64) * 256 * D;
        float* xop = xo + (size_t)u.pm * 256 * D;
        const int r0 = wr * 64 + fr, c0 = u.pn * 256 + wc * 32 + 4 * fq;
        f32x4 gv[2][2];
#pragma unroll
        for (int bj = 0; bj < 2; ++bj)
#pragma unroll
            for (int n = 0; n < 2; ++n) gv[bj][n] = *(const f32x4*)(gate + (size_t)bi * 6144 + c0 + bj * 128 + n * 16);
#pragma unroll
        for (int ai = 0; ai < 2; ++ai)
#pragma unroll
            for (int m = 0; m < 4; ++m) { const size_t ro = (size_t)(r0 + ai * 128 + m * 16) * D + c0;
#pragma unroll
                for (int bj = 0; bj < 2; ++bj)
#pragma unroll
                    for (int n = 0; n < 2; ++n) { const f32x4 xv = *(const f32x4*)(xin + ro + bj * 128 + n * 16);
                        *(f32x4*)(xop + ro + bj * 128 + n * 16) = xv + gv[bj][n] * acc[ai][bj][m][n]; } }
    }
};
struct EpiGU {
    bf16_t* act; const float* bias; const int* blk_e;
    __device__ __forceinline__ void operator()(const f32x4 (&acc)[2][2][4][2], const pg8::Unit& u, int wr, int wc, int fr, int fq) const {
        const int e = blk_e[u.pm];
        const float* bg = bias + (size_t)e * 2048 + u.pn * 128 + wc * 32 + 4 * fq;
        f32x4 bgv[2], buv[2];
#pragma unroll
        for (int n = 0; n < 2; ++n) { bgv[n] = *(const f32x4*)(bg + n * 16); buv[n] = *(const f32x4*)(bg + 1024 + n * 16); }
#pragma unroll
        for (int ai = 0; ai < 2; ++ai)
#pragma unroll
            for (int m = 0; m < 4; ++m) { bf16_t* rowp = act + (size_t)(u.pm * 256 + ai * 128 + wr * 64 + m * 16 + fr) * DFF + u.pn * 128 + wc * 32 + 4 * fq;
#pragma unroll
                for (int n = 0; n < 2; ++n) { const f32x4 g = acc[ai][0][m][n] + bgv[n], uu = acc[ai][1][m][n] + buv[n]; float o[4];
#pragma unroll
                    for (int i = 0; i < 4; ++i) { const float g_ = fminf(g[i], 7.f), u_ = fminf(fmaxf(uu[i], -7.f), 7.f); o[i] = g_ * sigm(1.702f * g_) * (u_ + 1.f); }
                    u32x2 pk; pk.x = pk2(o[0], o[1]); pk.y = pk2(o[2], o[3]); *(u32x2*)(rowp + n * 16) = pk; } }
    }
};
struct EpiDown {
    bf16_t* Y; const float* bias; const int* blk_e;
    __device__ __forceinline__ void operator()(const f32x4 (&acc)[2][2][4][2], const pg8::Unit& u, int wr, int wc, int fr, int fq) const {
        const int e = blk_e[u.pm];
        const int row0 = u.pm * 256 + wr * 64 + fr, col0 = u.pn * 256 + wc * 32 + 4 * fq;
        f32x4 bv[2][2];
#pragma unroll
        for (int bj = 0; bj < 2; ++bj)
#pragma unroll
            for (int n = 0; n < 2; ++n) bv[bj][n] = *(const f32x4*)(bias + (size_t)e * D + col0 + bj * 128 + n * 16);
#pragma unroll
        for (int ai = 0; ai < 2; ++ai)
#pragma unroll
            for (int m = 0; m < 4; ++m) { bf16_t* rowp = Y + (size_t)(row0 + ai * 128 + m * 16) * D + col0;
#pragma unroll
                for (int bj = 0; bj < 2; ++bj)
#pragma unroll
                    for (int n = 0; n < 2; ++n) { const f32x4 v = acc[ai][bj][m][n] + bv[bj][n]; u32x2 pk; pk.x = pk2(v.x, v.y); pk.y = pk2(v.z, v.w); *(u32x2*)(rowp + bj * 128 + n * 16) = pk; } }
    }
};

template <int MODE>
__device__ __forceinline__ void transpose_item(const float* W, int ldn, int nvalid, bf16_t* WT, LAS float* scr, int kb, int nb, int lane) {
    const int k0 = 64 * kb, n0 = 32 * nb;
    const int nn = n0 + (lane & 31); const bool ok = nn < nvalid;
#pragma unroll 8
    for (int i = 0; i < 32; ++i) { const int kk = 2 * i + (lane >> 5); scr[kk * 33 + (lane & 31)] = ok ? __builtin_nontemporal_load(W + (size_t)(k0 + kk) * ldn + nn) : 0.f; }
    LDS_WAIT(); asm volatile("" ::: "memory");
    const int c = lane & 7;
#pragma unroll
    for (int j = 0; j < 4; ++j) { const int n = (lane >> 3) + 8 * j; const LAS float* s = scr + (8 * c) * 33 + n;
        u32x4 o; o.x = pk2(s[0 * 33], s[1 * 33]); o.y = pk2(s[2 * 33], s[3 * 33]); o.z = pk2(s[4 * 33], s[5 * 33]); o.w = pk2(s[6 * 33], s[7 * 33]);
        int gn = n0 + n, drow = gn;
        if (MODE == 1) drow = (gn < 1024) ? ((gn >> 7) * 256 + (gn & 127)) : (((gn - 1024) >> 7) * 256 + 128 + ((gn - 1024) & 127));
        *(u32x4*)(WT + (size_t)drow * 1024 + k0 + 8 * c) = o; }
    LDS_WAIT(); asm volatile("" ::: "memory");
}
__device__ __forceinline__ void phase_prep(const Args& a, LAS unsigned char* lds, int tid, int lane, int wave, int bid, int G) {
    LAS float* scr = (LAS float*)(lds + wave * 16384);
    const int gw = bid * 8 + wave, NGW = G * 8;
    constexpr int I_IN = 16 * 136, I_OUT = 16 * 32, I_GU = 16 * 64, I_D = 16 * 32;
    constexpr int N_IN = 2 * I_IN, N_OUT = 2 * I_OUT, N_GU = 64 * I_GU, N_D = 64 * I_D, NITEMS = N_IN + N_OUT + N_GU + N_D;
    bf16_t* WinT = (bf16_t*)(a.ws + WS_WIN); bf16_t* WoutT = (bf16_t*)(a.ws + WS_WOUT); bf16_t* WguT = (bf16_t*)(a.ws + WS_WGU); bf16_t* WdT = (bf16_t*)(a.ws + WS_WD);
    for (int it = gw; it < NITEMS; it += NGW) {
        int r = it;
        if (r < N_IN) { const int l = r / I_IN, q = r % I_IN; transpose_item<0>(a.in[8] + (size_t)l * 1024 * INC, INC, INC, WinT + (size_t)l * INP * 1024, scr, q / 136, q % 136, lane); continue; } r -= N_IN;
        if (r < N_OUT) { const int l = r / I_OUT, q = r % I_OUT; transpose_item<0>(a.in[9] + (size_t)l * 1024 * 1024, 1024, 1024, WoutT + (size_t)l * 1024 * 1024, scr, q / 32, q % 32, lane); continue; } r -= N_OUT;
        if (r < N_GU) { const int le = r / I_GU, q = r % I_GU; transpose_item<1>(a.in[33] + (size_t)le * 1024 * 2048, 2048, 2048, WguT + (size_t)le * 2048 * 1024, scr, q / 64, q % 64, lane); continue; } r -= N_GU;
        { const int le = r / I_D, q = r % I_D; transpose_item<0>(a.in[35] + (size_t)le * 1024 * 1024, 1024, 1024, WdT + (size_t)le * 1024 * 1024, scr, q / 32, q % 32, lane); }
    }
    __syncthreads();
    LAS float* sv = (LAS float*)lds; LAS float* red = sv + 5 * 1024;
    for (int i = tid; i < 5 * 1024; i += 512) { const int r = i >> 10, k = i & 1023; const float cv = (r < 4) ? a.in[1][r * 1024 + k] : a.in[3][k]; sv[i] = siluf(cv); }
    __syncthreads();
    float* mod = (float*)(a.ws + WS_MOD);
    for (int grp = bid; grp < 768; grp += G) {
        const int l = grp / 384, j0 = (grp % 384) * 16, col = tid & 15, ks = tid >> 4;
        const float* w = a.in[4] + (size_t)l * 1024 * 6144 + j0 + col;
        float a0 = 0.f, a1 = 0.f, a2 = 0.f, a3 = 0.f, a4 = 0.f;
#pragma unroll 8
        for (int kk = 0; kk < 32; ++kk) { const int k = ks * 32 + kk; const float wv = w[(size_t)k * 6144];
            a0 += sv[k] * wv; a1 += sv[1024 + k] * wv; a2 += sv[2048 + k] * wv; a3 += sv[3072 + k] * wv; a4 += sv[4096 + k] * wv; }
        LAS float* rp = red + (ks * 16 + col) * 5; rp[0] = a0; rp[1] = a1; rp[2] = a2; rp[3] = a3; rp[4] = a4;
        __syncthreads();
        if (tid < 80) { const int c = tid / 5, r = tid % 5; float s = 0.f;
            for (int q = 0; q < 32; ++q) s += red[(q * 16 + c) * 5 + r];
            mod[(size_t)(l * 5 + r) * 6144 + j0 + c] = s + a.in[5][l * 6144 + j0 + c]; }
        __syncthreads();
    }
    bf16_t* LW = (bf16_t*)(a.ws + WS_LORA);
    for (int i = bid * 512 + tid; i < 2 * 81920; i += G * 512) {
        const int l = i / 81920, r = i % 81920;
        if (r < 16384) { const int q = r >> 8, c = r & 255; LW[(size_t)l * 81920 + c * 64 + q] = (bf16_t)f2bf(a.in[24][(size_t)l * 16384 + r]); }
        else if (r < 49152) { const int r2 = r - 16384, dj = r2 >> 14, q = (r2 >> 8) & 63, c = r2 & 255; LW[(size_t)l * 81920 + 16384 + dj * 16384 + c * 64 + q] = (bf16_t)f2bf(a.in[22][(size_t)l * 32768 + r2]); }
        else { const int r2 = r - 49152, q = r2 >> 8, c = r2 & 255; LW[(size_t)l * 81920 + 49152 + c * 128 + q] = (bf16_t)f2bf(a.in[25][(size_t)l * 32768 + r2]); }
    }
}

__device__ __forceinline__ void norm_mod_store(f32x4 (&v)[4], const float* nw, const float* shift, const float* scale, bf16_t* hrow, int lane) {
    float ss = 0.f;
#pragma unroll
    for (int j = 0; j < 4; ++j) ss += (v[j].x * v[j].x + v[j].y * v[j].y) + (v[j].z * v[j].z + v[j].w * v[j].w);
    const float r = frsq(wave_sum(ss) * (1.f / D) + 1e-6f);
#pragma unroll
    for (int j = 0; j < 4; ++j) { const int c = j * 256 + lane * 4;
        const f32x4 w4 = *(const f32x4*)(nw + c), sh = *(const f32x4*)(shift + c), sc = *(const f32x4*)(scale + c);
        v[j] = (v[j] * r * w4) * (sc + 1.f) + sh;
        u32x2 pk; pk.x = pk2(v[j].x, v[j].y); pk.y = pk2(v[j].z, v[j].w); *(u32x2*)(hrow + c) = pk; }
}
__device__ __forceinline__ void phase_norm1(const Args& a, int L, const float* xl, const float* xc, int lane, int wave, int bid, int G) {
    const float* mod = (const float*)(a.ws + WS_MOD) + (size_t)L * 5 * 6144;
    bf16_t* Hn = (bf16_t*)(a.ws + WS_HN);
    for (int row = bid * 8 + wave; row < MALL; row += G * 8) {
        const float* xr = row < NL ? xl + (size_t)row * D : xc + (size_t)(row - NL) * D;
        const int bi = row < NL ? (row >> 12) : 4;
        f32x4 v[4];
#pragma unroll
        for (int j = 0; j < 4; ++j) v[j] = *(const f32x4*)(xr + j * 256 + lane * 4);
        norm_mod_store(v, a.in[6] + L * D, mod + (size_t)bi * 6144, mod + (size_t)bi * 6144 + 1024, Hn + (size_t)row * D, lane);
    }
}

__device__ __forceinline__ void phase_mixprep(const Args& a, int L, LAS unsigned char* lds, int lane_, int wave, int bid, int G) {
    const float* P = (const float*)(a.ws + WS_P);
    const int gw = bid * 8 + wave, NGW = G * 8;
    for (int rp_ = 0; rp_ < 1 + ((PROBE_MIX >> 0) & 1); ++rp_) if (MIXPARTS & 1) {
        float* MX = (float*)(a.ws + WS_MXBC); float* MD = (float*)(a.ws + WS_MDT);
        const float* cw = a.in[10] + (size_t)L * 3 * 768; const float* cb = a.in[11] + (size_t)L * 768;
        float w0[12], w1[12], w2[12], wb[12];
#pragma unroll
        for (int j = 0; j < 12; ++j) { const int c = j * 64 + lane_; w0[j] = cw[c]; w1[j] = cw[768 + c]; w2[j] = cw[1536 + c]; wb[j] = cb[c]; }
        const float dtb = lane_ < 8 ? a.in[12][L * 8 + lane_] : 0.f, aneg = lane_ < 8 ? -__expf(a.in[13][L * 8 + lane_]) : 0.f;
        for (int row = gw; row < MALL; row += NGW) {
            const int lane = opq(lane_);
            int t, len; if (row < NL) { t = row & 4095; len = 4096; } else { t = (row - NL) & 255; len = 256; }
            const bool hp = t > 0, hn = t < len - 1;
            const float* p1 = P + (size_t)row * INP + 256 + lane;
            float x0[12], x1[12], x2[12];
#pragma unroll
            for (int j = 0; j < 12; ++j) { x0[j] = hp ? p1[j * 64 - INP] : 0.f; x1[j] = p1[j * 64]; x2[j] = hn ? p1[j * 64 + INP] : 0.f; }
            const float draw = lane < 8 ? P[(size_t)row * INP + 1024 + lane] : 0.f;
#pragma unroll
            for (int j = 0; j < 12; ++j) MX[(size_t)row * 768 + j * 64 + lane] = siluf(w0[j] * x0[j] + w1[j] * x1[j] + w2[j] * x2[j] + wb[j]);
            if (lane < 8) { const float dt = softplusf(draw + dtb); MD[(size_t)row * 16 + lane] = dt; MD[(size_t)row * 16 + 8 + lane] = dt * aneg; }
        }
    }
    for (int rp_ = 0; rp_ < 1 + ((PROBE_MIX >> 1) & 1); ++rp_) if (MIXPARTS & 2) {
        bf16_t* DQ = (bf16_t*)(a.ws + WS_DNQKV); float* DG = (float*)(a.ws + WS_DNGB);
        const float* cw = a.in[16] + (size_t)L * 3 * 1536;
#define DN_ROWS(dr) size_t r0, r1, r2; bool hp, hn; \
            if (dr < NL) { const int b = dr >> 12, pos = dr & 4095; hp = pos > 0; hn = pos < 4095; const int pp = pos - 1, pn = pos + 1; \
                r1 = (size_t)b * 4096 + ((pos & 63) * 64 + (pos >> 6)); r0 = (size_t)b * 4096 + ((pp & 63) * 64 + ((pp >> 6) & 63)); r2 = (size_t)b * 4096 + ((pn & 63) * 64 + ((pn >> 6) & 63)); } \
            else { const int t = (dr - NL) & 255; hp = t > 0; hn = t < 255; r1 = dr; r0 = dr - 1; r2 = dr + 1; }
        {
            float w0[16], w1[16], w2[16];
#pragma unroll
            for (int j = 0; j < 16; ++j) { const int c = j * 64 + lane_; w0[j] = cw[c]; w1[j] = cw[1536 + c]; w2[j] = cw[3072 + c]; }
            const float dtb = lane_ < 8 ? a.in[17][L * 8 + lane_] : 0.f, apos = lane_ < 8 ? __expf(a.in[18][L * 8 + lane_]) : 0.f;
            for (int dr = gw; dr < MALL; dr += NGW) {
                const int lane = opq(lane_);
                DN_ROWS(dr)
                const float* q0 = P + r0 * INP + DN_OFF + lane; const float* q1 = P + r1 * INP + DN_OFF + lane; const float* q2 = P + r2 * INP + DN_OFF + lane;
                float x0[16], x1[16], x2[16];
#pragma unroll
                for (int j = 0; j < 16; ++j) { x0[j] = hp ? q0[j * 64] : 0.f; x1[j] = q1[j * 64]; x2[j] = hn ? q2[j * 64] : 0.f; }
                const float braw = lane < 8 ? q1[2048] : 0.f, araw = lane < 8 ? q1[2056] : 0.f;
                float v[16];
#pragma unroll
                for (int j = 0; j < 16; ++j) v[j] = siluf(w0[j] * x0[j] + w1[j] * x1[j] + w2[j] * x2[j]);
                float qk[4];
#pragma unroll
                for (int h = 0; h < 4; ++h) {
                    const float sq = wave_sum(v[2 * h] * v[2 * h] + v[2 * h + 1] * v[2 * h + 1]);
                    const float sk = wave_sum(v[8 + 2 * h] * v[8 + 2 * h] + v[8 + 2 * h + 1] * v[8 + 2 * h + 1]);
                    const float rq = frsq(sq + 1e-6f) * 0.08838834764831845f, rk = frsq(sk + 1e-6f);
                    v[2 * h] *= rq; v[2 * h + 1] *= rq; v[8 + 2 * h] *= rk; v[8 + 2 * h + 1] *= rk;
                    qk[h] = wave_sum(v[2 * h] * v[8 + 2 * h] + v[2 * h + 1] * v[8 + 2 * h + 1]);
                }
#pragma unroll
                for (int j = 0; j < 16; ++j) DQ[(size_t)dr * 1536 + j * 64 + lane] = (bf16_t)f2bf(v[j]);
                if (lane < 8) { const float beta = sigm(braw); const float g = -apos * softplusf(araw + dtb);
                    DG[(size_t)dr * 32 + lane] = beta; DG[(size_t)dr * 32 + 8 + lane] = __expf(g); DG[(size_t)dr * 32 + 16 + lane] = g; }
                if (lane < 4) { const float s = lane == 0 ? qk[0] : lane == 1 ? qk[1] : lane == 2 ? qk[2] : qk[3]; DG[(size_t)dr * 32 + 24 + lane] = s; }
            }
        }
        {
            float w0[8], w1[8], w2[8];
#pragma unroll
            for (int j = 0; j < 8; ++j) { const int c = 1024 + j * 64 + lane_; w0[j] = cw[c]; w1[j] = cw[1536 + c]; w2[j] = cw[3072 + c]; }
            for (int dr = gw; dr < MALL; dr += NGW) {
                const int lane = opq(lane_);
                DN_ROWS(dr)
                const float* q0 = P + r0 * INP + DN_OFF + 1024 + lane; const float* q1 = P + r1 * INP + DN_OFF + 1024 + lane; const float* q2 = P + r2 * INP + DN_OFF + 1024 + lane;
                float x0[8], x1[8], x2[8];
#pragma unroll
                for (int j = 0; j < 8; ++j) { x0[j] = hp ? q0[j * 64] : 0.f; x1[j] = q1[j * 64]; x2[j] = hn ? q2[j * 64] : 0.f; }
#pragma unroll
                for (int j = 0; j < 8; ++j) DQ[(size_t)dr * 1536 + 1024 + j * 64 + lane] = (bf16_t)f2bf(siluf(w0[j] * x0[j] + w1[j] * x1[j] + w2[j] * x2[j]));
            }
        }
#undef DN_ROWS
    }
    for (int rp_ = 0; rp_ < 1 + ((PROBE_MIX >> 2) & 1); ++rp_) if (MIXPARTS & 4) {
        bf16_t* RW = (bf16_t*)(a.ws + WS_RW); float* RWW = (float*)(a.ws + WS_RWW); float* RG = (float*)(a.ws + WS_RWG);
        const bf16_t* LW = (const bf16_t*)(a.ws + WS_LORA) + (size_t)L * 81920;
        LAS float* KS = (LAS float*)lds;
        LAS bf16_t* INB = (LAS bf16_t*)(lds + 16640);
        const int hh = wave >> 1, half = wave & 1, tokn = lane_ & 15, g4 = lane_ >> 4;
        float mu[17];
#pragma unroll
        for (int j = 0; j < 17; ++j) mu[j] = a.in[20][(size_t)L * 1088 + j * 64 + lane_];
        bf16x8 fa[4][2], fb[4][4];
        {
            const bf16_t* m0 = half == 0 ? LW : LW + 16384 + 16384;
#pragma unroll
            for (int ct = 0; ct < 4; ++ct)
#pragma unroll
                for (int kb = 0; kb < 2; ++kb) fa[ct][kb] = *(const bf16x8*)(m0 + (size_t)(hh * 64 + ct * 16 + tokn) * 64 + kb * 32 + g4 * 8);
            if (half == 0) {
#pragma unroll
                for (int ct = 0; ct < 4; ++ct)
#pragma unroll
                    for (int kb = 0; kb < 4; ++kb) fb[ct][kb] = *(const bf16x8*)(LW + 16384 + (size_t)(hh * 64 + ct * 16 + tokn) * 64 + (kb & 1) * 32 + g4 * 8);
            } else {
#pragma unroll
                for (int ct = 0; ct < 4; ++ct)
#pragma unroll
                    for (int kb = 0; kb < 4; ++kb) fb[ct][kb] = *(const bf16x8*)(LW + 49152 + (size_t)(hh * 64 + ct * 16 + tokn) * 128 + kb * 32 + g4 * 8);
            }
        }
        __syncthreads();
        for (int ti = bid; ti < MALL / 16; ti += G) {
            const int lane = opq(lane_);
#pragma unroll
            for (int t2 = 0; t2 < 2; ++t2) {
                const int tk = wave * 2 + t2, row = ti * 16 + tk; int nb; bool ok;
                if (row < NL) { const int t = row & 4095, gr = t >> 6, gc = t & 63, sel = lane & 3;
                    nb = sel == 0 ? -1 : sel == 1 ? 1 : sel == 2 ? -64 : 64; ok = sel == 0 ? gc > 0 : sel == 1 ? gc < 63 : sel == 2 ? gr > 0 : gr < 63; }
                else { const int t = (row - NL) & 255; nb = (lane & 1) ? 1 : -1; ok = (lane & 1) ? t < 255 : t > 0; }
                const float* p = P + (size_t)row * INP + RW_OFF + lane; const float* ps = p + (long)nb * INP;
                bf16_t* o = RW + (size_t)row * 1280 + lane;
                float xv[17], sv[17];
#pragma unroll
                for (int j = 0; j < 17; ++j) { xv[j] = p[j * 64]; sv[j] = ok ? ps[j * 64] : 0.f; }
#pragma unroll
                for (int j = 0; j < 17; ++j) { const float m = xv[j] + (sv[j] - xv[j]) * mu[j];
                    if (j < 4) o[j * 64] = (bf16_t)f2bf(m); else if (j < 8) KS[tk * 260 + (j - 4) * 64 + lane] = m; else if (j < 12) o[j * 64] = (bf16_t)f2bf(m);
                    else if (j < 14) INB[tk * 328 + (j - 12) * 64 + lane] = (bf16_t)f2bf(tanh_fast(m)); else if (j < 15) INB[tk * 328 + 128 + lane] = (bf16_t)f2bf(m);
                    else INB[tk * 328 + 192 + (j - 15) * 64 + lane] = (bf16_t)f2bf(sigm(m)); }
            }
            __syncthreads();
            {
                const size_t row = (size_t)ti * 16 + tokn;
                const int ch0 = hh * 64 + g4 * 4;
                const LAS bf16_t* ib = INB + tokn * 328 + g4 * 8;
                f32x4 accA[4], accB[4];
#pragma unroll
                for (int ct = 0; ct < 4; ++ct) { accA[ct] = (f32x4){0.f, 0.f, 0.f, 0.f}; accB[ct] = accA[ct]; }
                if (half == 0) {
                    bf16x8 bi[2], bw[2];
#pragma unroll
                    for (int kb = 0; kb < 2; ++kb) { bi[kb] = *(const LAS bf16x8*)(ib + 128 + kb * 32); bw[kb] = *(const LAS bf16x8*)(ib + kb * 32); }
#pragma unroll
                    for (int ct = 0; ct < 4; ++ct)
#pragma unroll
                        for (int kb = 0; kb < 2; ++kb) { accA[ct] = __builtin_amdgcn_mfma_f32_16x16x32_bf16(fa[ct][kb], bi[kb], accA[ct], 0, 0, 0); accB[ct] = __builtin_amdgcn_mfma_f32_16x16x32_bf16(fb[ct][kb], bw[kb], accB[ct], 0, 0, 0); }
                    f32x4 kx[4], kn[4]; float ss = 0.f;
#pragma unroll
                    for (int ct = 0; ct < 4; ++ct) { kx[ct] = *(const LAS f32x4*)(KS + tokn * 260 + ch0 + ct * 16);
                        kn[ct] = kx[ct] * *(const f32x4*)(a.in[26] + L * 256 + ch0 + ct * 16); ss += (kn[ct].x * kn[ct].x + kn[ct].y * kn[ct].y) + (kn[ct].z * kn[ct].z + kn[ct].w * kn[ct].w); }
                    { float u = ss, v = ss; pswap16(u, v); ss = u + v; u = ss; v = ss; pswap32(u, v); ss = u + v; }
                    const float rn = frsq(ss + 1e-6f);
                    bf16_t* o = RW + row * 1280 + ch0; float* ow = RWW + row * 512 + ch0;
#pragma unroll
                    for (int ct = 0; ct < 4; ++ct) { const f32x4 a0v = *(const f32x4*)(a.in[23] + L * 256 + ch0 + ct * 16), kav = *(const f32x4*)(a.in[27] + L * 256 + ch0 + ct * 16), w0v = *(const f32x4*)(a.in[21] + L * 512 + ch0 + ct * 16);
                        f32x4 av, km, wv;
#pragma unroll
                        for (int i = 0; i < 4; ++i) { av[i] = sigm(a0v[i] + accA[ct][i]); km[i] = kx[ct][i] * (1.f + (av[i] - 1.f) * kav[i]); wv[i] = __expf(-__expf(-softplusf(-(w0v[i] + accB[ct][i])) - 0.5f)); }
                        const f32x4 knn = kn[ct] * rn;
                        const f32x4 bb = knn * av; u32x2 pk;
                        pk.x = cvt2(km.x, km.y); pk.y = cvt2(km.z, km.w); *(u32x2*)(o + 256 + ct * 16) = pk;
                        pk.x = cvt2(-knn.x, -knn.y); pk.y = cvt2(-knn.z, -knn.w); *(u32x2*)(o + 768 + ct * 16) = pk;
                        pk.x = cvt2(bb.x, bb.y); pk.y = cvt2(bb.z, bb.w); *(u32x2*)(o + 1024 + ct * 16) = pk;
                        *(f32x4*)(ow + ct * 16) = wv; }
                } else {
                    bf16x8 bw[2], bg[4];
#pragma unroll
                    for (int kb = 0; kb < 2; ++kb) bw[kb] = *(const LAS bf16x8*)(ib + 64 + kb * 32);
#pragma unroll
                    for (int kb = 0; kb < 4; ++kb) bg[kb] = *(const LAS bf16x8*)(ib + 192 + kb * 32);
#pragma unroll
                    for (int ct = 0; ct < 4; ++ct) {
#pragma unroll
                        for (int kb = 0; kb < 2; ++kb) accA[ct] = __builtin_amdgcn_mfma_f32_16x16x32_bf16(fa[ct][kb], bw[kb], accA[ct], 0, 0, 0);
#pragma unroll
                        for (int kb = 0; kb < 4; ++kb) accB[ct] = __builtin_amdgcn_mfma_f32_16x16x32_bf16(fb[ct][kb], bg[kb], accB[ct], 0, 0, 0); }
                    float* o = RWW + row * 512 + 256 + ch0; float* og = RG + row * 256 + ch0;
#pragma unroll
                    for (int ct = 0; ct < 4; ++ct) { const f32x4 w0v = *(const f32x4*)(a.in[21] + L * 512 + 256 + ch0 + ct * 16); f32x4 wv;
#pragma unroll
                        for (int i = 0; i < 4; ++i) wv[i] = __expf(-__expf(-softplusf(-(w0v[i] + accA[ct][i])) - 0.5f));
                        *(f32x4*)(o + ct * 16) = wv; *(f32x4*)(og + ct * 16) = accB[ct]; }
                }
            }
            __syncthreads();
        }
    }
}

__device__ __forceinline__ int seqrow(int b, int dir, int s) {
    if (s < 256) return NL + b * 256 + (dir ? 255 - s : s);
    const int p = s - 256; return b * 4096 + (dir ? 4095 - p : p);
}
template <int CTRL> __device__ __forceinline__ float dppz(float v) { return __builtin_bit_cast(float, __builtin_amdgcn_update_dpp(0, __builtin_bit_cast(int, v), CTRL, 0xF, 0xF, true)); }
__device__ __forceinline__ void phase_dnpre(const Args& a, LAS unsigned char* lds, int lane_, int wave, int bid, int G) {
    const bf16_t* DQ = (const bf16_t*)(a.ws + WS_DNQKV); const float* DG = (const float*)(a.ws + WS_DNGB);
    LAS float* sc = (LAS float*)(lds + wave * 13312);
    LAS unsigned char* stg = (LAS unsigned char*)(sc + 576);
    for (int u = bid * 8 + wave; u < DN_UNITS; u += G * 8) {
        const int lane = opq(lane_);
        const int chain = u / DN_NSUB, c = u % DN_NSUB, dir = chain & 1, h = (chain >> 1) & 3, b = chain >> 3;
        const int ti = lane & 15, kg = lane >> 4;
        const int Lh = lane & 31; const bool isw = lane >= 32;
        const size_t rowi = (size_t)seqrow(b, dir, c * 16 + ti);
        const float gi = DG[rowi * 32 + 16 + dir * 4 + h], bi = DG[rowi * 32 + dir * 4 + h];
        u32x4 kk[4], qq[4];
#pragma unroll
        for (int s = 0; s < 4; ++s) { kk[s] = *(const u32x4*)(DQ + rowi * 1536 + 512 + h * 128 + 32 * s + 8 * kg); qq[s] = *(const u32x4*)(DQ + rowi * 1536 + h * 128 + 32 * s + 8 * kg); }
        const bf16_t* src = DQ + (isw ? 512 : 1024) + h * 128 + 4 * Lh;
        f32x4 x[16];
#pragma unroll
        for (int i = 0; i < 16; ++i) { const size_t row = (size_t)seqrow(b, dir, c * 16 + i); x[i] = ldp4(src + row * 1536); }
        float gc = gi; gc += dppz<0x111>(gc); gc += dppz<0x112>(gc); gc += dppz<0x114>(gc); gc += dppz<0x118>(gc);
        if (lane < 16) { sc[lane] = gc; sc[16 + lane] = bi; }
        f32x4 KKd = {0.f, 0.f, 0.f, 0.f}, QKd = KKd;
#pragma unroll
        for (int s = 0; s < 4; ++s) { const bf16x8 kf = __builtin_bit_cast(bf16x8, kk[s]);
            KKd = __builtin_amdgcn_mfma_f32_16x16x32_bf16(kf, kf, KKd, 0, 0, 0); QKd = __builtin_amdgcn_mfma_f32_16x16x32_bf16(__builtin_bit_cast(bf16x8, qq[s]), kf, QKd, 0, 0, 0); }
        LDS_WAIT(); asm volatile("" ::: "memory");
        {
            const f32x4 gci = *(const LAS f32x4*)(sc + 4 * kg), bti = *(const LAS f32x4*)(sc + 16 + 4 * kg);
#pragma unroll
            for (int r = 0; r < 4; ++r) { const int i = 4 * kg + r; const float dec = __expf(gci[r] - gc);
                sc[32 + i * 16 + ti] = (i > ti) ? bti[r] * KKd[r] * dec : 0.f; sc[288 + i * 16 + ti] = (i >= ti) ? QKd[r] * dec : 0.f; }
        }
        {
            const float eq = __expf(gc);
#pragma unroll
            for (int s = 0; s < 4; ++s) { const unsigned w0 = qq[s].x, w1 = qq[s].y, w2 = qq[s].z, w3 = qq[s].w;
                u32x2 lo, hi2;
                lo.x = cvt2(__builtin_bit_cast(float, w0 << 16) * eq, __builtin_bit_cast(float, w0 & 0xffff0000u) * eq); lo.y = cvt2(__builtin_bit_cast(float, w1 << 16) * eq, __builtin_bit_cast(float, w1 & 0xffff0000u) * eq);
                hi2.x = cvt2(__builtin_bit_cast(float, w2 << 16) * eq, __builtin_bit_cast(float, w2 & 0xffff0000u) * eq); hi2.y = cvt2(__builtin_bit_cast(float, w3 << 16) * eq, __builtin_bit_cast(float, w3 & 0xffff0000u) * eq);
                const int kq0 = 2 * (kg & 1), hf = kg >> 1;
                *(LAS u32x2*)(stg + 4096 + ((s * 64 + kq0 * 16 + ti) * 8 + hf * 4) * 2) = lo; *(LAS u32x2*)(stg + 4096 + ((s * 64 + (kq0 + 1) * 16 + ti) * 8 + hf * 4) * 2) = hi2; }
        }
        LDS_WAIT(); asm volatile("" ::: "memory");
        unsigned char* ub = a.ws + WS_DNC + (size_t)u * 12800;
        {
            const f32x4 at = *(const LAS f32x4*)(sc + 288 + ti * 16 + 4 * kg);
            u32x2 o; o.x = cvt2(at.x, at.y); o.y = cvt2(at.z, at.w); *(u32x2*)(ub + 12288 + lane * 8) = o;
            if (lane == 15) ((float*)(a.ws + WS_DNG))[u] = __expf(gc);
        }
#pragma unroll
        for (int i = 0; i < 16; ++i) { const float gci = sc[i], bti = sc[16 + i]; x[i] = x[i] * (isw ? bti * __expf(gci) : bti);
#pragma unroll
            for (int j = 0; j < i; ++j) x[i] -= x[j] * sc[32 + i * 16 + j]; }
        const int sW = Lh >> 3, hfW = (Lh >> 2) & 1, kqW = Lh & 3;
        if (isw) {
#pragma unroll
            for (int m = 0; m < 16; ++m) { u32x2 o; o.x = cvt2(x[m].x, x[m].y); o.y = cvt2(x[m].z, x[m].w); *(LAS u32x2*)(stg + ((sW * 64 + kqW * 16 + m) * 8 + hfW * 4) * 2) = o; }
        }
        LDS_WAIT(); asm volatile("" ::: "memory");
#pragma unroll
        for (int q = 0; q < 8; ++q) *(u32x4*)(ub + q * 1024 + lane * 16) = *(const LAS u32x4*)(stg + q * 1024 + lane * 16);
        LDS_WAIT(); asm volatile("" ::: "memory");
        if (!isw) {
#pragma unroll
            for (int g = 0; g < 4; ++g)
#pragma unroll
                for (int q = 0; q < 4; ++q) { const f32x4 o = {x[4 * g][q], x[4 * g + 1][q], x[4 * g + 2][q], x[4 * g + 3][q]}; *(LAS f32x4*)(stg + ((Lh >> 2) * 256 + (g * 16 + 4 * (Lh & 3) + q) * 4) * 4) = o; }
        }
        LDS_WAIT(); asm volatile("" ::: "memory");
        { unsigned char* ud = a.ws + WS_DNU + (size_t)u * 8192;
#pragma unroll
          for (int q = 0; q < 8; ++q) *(u32x4*)(ud + q * 1024 + lane * 16) = *(const LAS u32x4*)(stg + q * 1024 + lane * 16); }
        LDS_WAIT(); asm volatile("" ::: "memory");
        {
            const float ek = __expf(sc[15] - gc);
            LAS bf16_t* kfi = (LAS bf16_t*)stg;
#pragma unroll
            for (int s = 0; s < 4; ++s) { const unsigned w[4] = {kk[s].x, kk[s].y, kk[s].z, kk[s].w};
#pragma unroll
                for (int e2 = 0; e2 < 4; ++e2) { const unsigned pk = cvt2(__builtin_bit_cast(float, w[e2] << 16) * ek, __builtin_bit_cast(float, w[e2] & 0xffff0000u) * ek);
                    const int d0 = 32 * s + 8 * kg + 2 * e2;
                    kfi[(((d0 >> 4) * 64 + (ti >> 2) * 16 + (d0 & 15)) * 4) + (ti & 3)] = (bf16_t)(pk & 0xffffu);
                    kfi[(((d0 >> 4) * 64 + (ti >> 2) * 16 + ((d0 + 1) & 15)) * 4) + (ti & 3)] = (bf16_t)(pk >> 16); } }
        }
        LDS_WAIT(); asm volatile("" ::: "memory");
#pragma unroll
        for (int q = 0; q < 4; ++q) *(u32x4*)(ub + 8192 + q * 1024 + lane * 16) = *(const LAS u32x4*)(stg + q * 1024 + lane * 16);
        LDS_WAIT(); asm volatile("" ::: "memory");
    }
}
__device__ __forceinline__ void phase_mbpre(const Args& a, int lane_, int wave, int bid, int G) {
    const float* MX = (const float*)(a.ws + WS_MXBC);
    for (int u = bid * 8 + wave; u < MB_UNITS; u += G * 8) {
        const int lane = opq(lane_);
        const int bg = u / DN_NSUB, gi = u % DN_NSUB, b = bg >> 1, grp = bg & 1;
        const size_t base = gi < 16 ? (size_t)NL + b * 256 + gi * 16 : (size_t)b * 4096 + (gi - 16) * 16;
        const int tk = lane & 15, kg = lane >> 4;
        unsigned char* ub0 = a.ws + WS_MBC + (size_t)u * 12288; unsigned char* ub = ub0 + lane * 16;
        const float* cp = MX + (base + tk) * 768 + 512 + grp * 128 + 4 * kg; const float* bp = MX + (base + tk) * 768 + 256 + grp * 128 + 4 * kg;
#pragma unroll
        for (int s = 0; s < 4; ++s) { const f32x4 c0 = *(const f32x4*)(cp + 32 * s), c1 = *(const f32x4*)(cp + 32 * s + 16), b0 = *(const f32x4*)(bp + 32 * s), b1 = *(const f32x4*)(bp + 32 * s + 16);
            u32x4 oc, ob; oc.x = cvt2(c0.x, c0.y); oc.y = cvt2(c0.z, c0.w); oc.z = cvt2(c1.x, c1.y); oc.w = cvt2(c1.z, c1.w);
            ob.x = cvt2(b0.x, b0.y); ob.y = cvt2(b0.z, b0.w); ob.z = cvt2(b1.x, b1.y); ob.w = cvt2(b1.z, b1.w);
            *(u32x4*)(ub + s * 1024) = oc; *(u32x4*)(ub + 4096 + s * 1024) = ob; }
        const float* bt = MX + (base + 4 * kg) * 768 + 256 + grp * 128 + tk;
#pragma unroll
        for (int dt = 0; dt < 8; ++dt) { u32x2 o; o.x = cvt2(bt[16 * dt], bt[768 + 16 * dt]); o.y = cvt2(bt[1536 + 16 * dt], bt[2304 + 16 * dt]); *(u32x2*)(ub0 + 8192 + dt * 512 + lane * 8) = o; }
    }
}
constexpr int RING_OFF = 4608, RING_SLOT = 18432, RING_R = 7, RING_NP = 18;
struct RingSync { volatile LAS int* prog; volatile LAS int* lready; };
__device__ __forceinline__ void ring_wait_ready(const RingSync& rs, int c) { unsigned sp = 0; while (rs.lready[c & 3] < c + 1 && ++sp < (1u << 24)) __builtin_amdgcn_s_sleep(1); }
__device__ __forceinline__ void ring_release(const RingSync& rs, int w, int c, int lane) { asm volatile("" ::: "memory"); if (lane == 0) rs.prog[w] = c + 1; asm volatile("" ::: "memory"); }
struct MbBuf { bf16x8 cf[4], bf[4], btf[8]; float la, xr[4]; size_t base; };
__device__ __forceinline__ size_t mb_base(int b, int dir, int c, int& gi) { gi = c < 16 ? (dir ? 15 - c : c) : (dir ? 16 + 255 - (c - 16) : c); return gi < 16 ? (size_t)NL + b * 256 + gi * 16 : (size_t)b * 4096 + (gi - 16) * 16; }
__device__ __forceinline__ void mb_load(MbBuf& B, const LAS unsigned char* slot, int b, int h, int dir, int pt, int c, int lane) {
    const int n = lane & 15, g = lane >> 4; int gi;
    const LAS unsigned char* ub = slot + lane * 16;
#pragma unroll
    for (int s = 0; s < 4; ++s) { B.cf[s] = *(const LAS bf16x8*)(ub + s * 1024); B.bf[s] = *(const LAS bf16x8*)(ub + 4096 + s * 1024); }
#pragma unroll
    for (int dt = 0; dt < 8; ++dt) { const u32x2 v = *(const LAS u32x2*)(slot + 8192 + dt * 512 + lane * 8); const u32x4 f = {v.x, v.y, 0u, 0u}; B.btf[dt] = __builtin_bit_cast(bf16x8, f); }
    const LAS float* xs = (const LAS float*)(slot + 12288); const LAS float* md = (const LAS float*)(slot + 16384);
    B.la = md[n * 16 + 8 + dir * 4 + h];
#pragma unroll
    for (int r = 0; r < 4; ++r) B.xr[r] = xs[(4 * g + r) * 64 + pt * 16 + n] * md[(4 * g + r) * 16 + dir * 4 + h];
    B.base = mb_base(b, dir, c, gi);
}
__device__ __forceinline__ void mb_step(const MbBuf& B, f32x4 (&hT)[8], LAS float* sc, float* YM, int dir, int h, int pt, int lane) {
    const int n = lane & 15, g = lane >> 4;
    float cum = B.la;
    if (dir == 0) { cum += dppz<0x111>(cum); cum += dppz<0x112>(cum); cum += dppz<0x114>(cum); cum += dppz<0x118>(cum); }
    else          { cum += dppz<0x101>(cum); cum += dppz<0x102>(cum); cum += dppz<0x104>(cum); cum += dppz<0x108>(cum); }
    if (lane < 16) sc[lane] = cum;
    LDS_WAIT(); asm volatile("" ::: "memory");
    const f32x4 cj = *(const LAS f32x4*)(sc + 4 * g); const float cend = sc[dir ? 0 : 15];
    u32x4 px, px2; px.x = cvt2(B.xr[0], B.xr[1]); px.y = cvt2(B.xr[2], B.xr[3]); px.z = 0u; px.w = 0u;
    px2.x = cvt2(B.xr[0] * __expf(cend - cj.x), B.xr[1] * __expf(cend - cj.y)); px2.y = cvt2(B.xr[2] * __expf(cend - cj.z), B.xr[3] * __expf(cend - cj.w)); px2.z = 0u; px2.w = 0u;
    const bf16x8 xdf = __builtin_bit_cast(bf16x8, px), xd2f = __builtin_bit_cast(bf16x8, px2);
    f32x4 gt = {0.f, 0.f, 0.f, 0.f}, yo = gt;
#pragma unroll
    for (int s = 0; s < 4; ++s) { gt = __builtin_amdgcn_mfma_f32_16x16x32_bf16(B.bf[s], B.cf[s], gt, 0, 0, 0);
        u32x4 p; p.x = cvt2(hT[2 * s].x, hT[2 * s].y); p.y = cvt2(hT[2 * s].z, hT[2 * s].w); p.z = cvt2(hT[2 * s + 1].x, hT[2 * s + 1].y); p.w = cvt2(hT[2 * s + 1].z, hT[2 * s + 1].w);
        yo = __builtin_amdgcn_mfma_f32_16x16x32_bf16(__builtin_bit_cast(bf16x8, p), B.cf[s], yo, 0, 0, 0); }
    float st[4];
#pragma unroll
    for (int r = 0; r < 4; ++r) { const int j = 4 * g + r; const bool ok = dir ? (j >= n) : (j <= n); st[r] = ok ? gt[r] * __expf(cum - cj[r]) : 0.f; }
    u32x4 ps; ps.x = cvt2(st[0], st[1]); ps.y = cvt2(st[2], st[3]); ps.z = 0u; ps.w = 0u;
    const f32x4 y = __builtin_amdgcn_mfma_f32_16x16x32_bf16(xdf, __builtin_bit_cast(bf16x8, ps), yo * __expf(cum), 0, 0, 0);
    *(f32x4*)(YM + (B.base + n) * 256 + h * 64 + pt * 16 + 4 * g) = y;
    const float dtot = __expf(cend);
#pragma unroll
    for (int dt = 0; dt < 8; ++dt) hT[dt] = __builtin_amdgcn_mfma_f32_16x16x32_bf16(B.btf[dt], xd2f, hT[dt] * dtot, 0, 0, 0);
    LDS_WAIT(); asm volatile("" ::: "memory");
}
__device__ __forceinline__ void scan_mamba_seq(const Args& a, LAS unsigned char* lds, int chain, int pt, int lane, const RingSync& rs) {
    const int dir = chain & 1, h = (chain >> 1) & 3, b = chain >> 3;
    LAS float* sc = (LAS float*)(lds + 1024 + pt * 256);
    float* YM = (float*)(a.ws + WS_YM) + (size_t)dir * MALL * 256;
    f32x4 hT[8];
#pragma unroll
    for (int i = 0; i < 8; ++i) hT[i] = (f32x4){0.f, 0.f, 0.f, 0.f};
    MbBuf A, B;
    ring_wait_ready(rs, 0); mb_load(A, lds + RING_OFF, b, h, dir, pt, 0, lane); ring_release(rs, pt, 0, lane);
    for (int c = 0; c < DN_NSUB; c += 2) {
        ring_wait_ready(rs, c + 1); mb_load(B, lds + RING_OFF + ((c + 1) % RING_R) * RING_SLOT, b, h, dir, pt, c + 1, lane); ring_release(rs, pt, c + 1, lane);
        mb_step(A, hT, sc, YM, dir, h, pt, lane);
        if (c + 2 < DN_NSUB) { ring_wait_ready(rs, c + 2); mb_load(A, lds + RING_OFF + ((c + 2) % RING_R) * RING_SLOT, b, h, dir, pt, c + 2, lane); ring_release(rs, pt, c + 2, lane); }
        mb_step(B, hT, sc, YM, dir, h, pt, lane);
    }
}

template <int CTRL> __device__ __forceinline__ float dpp1(float v) { return __builtin_bit_cast(float, __builtin_amdgcn_update_dpp(0x3f800000, __builtin_bit_cast(int, v), CTRL, 0xF, 0xF, false)); }
__device__ __forceinline__ void phase_rwpre(const Args& a, LAS unsigned char* lds, int lane_, int wave, int bid, int G) {
    const bf16_t* RW = (const bf16_t*)(a.ws + WS_RW); const float* RWW = (const float*)(a.ws + WS_RWW);
    LAS unsigned char* wl = lds + wave * 13312;
    LAS bf16_t* Ab = (LAS bf16_t*)wl; LAS bf16_t* Rb = Ab + 1024; LAS bf16_t* Bb = Rb + 1024; LAS bf16_t* Kb = Bb + 1024;
    LAS float* Lab = (LAS float*)(wl + 8192); LAS float* Lak = Lab + 256; LAS float* Lbr = Lak + 256; LAS float* Lkr = Lbr + 256; LAS float* Nm = Lkr + 256;
    for (int u = bid * 8 + wave; u < DN_UNITS; u += G * 8) {
        const int lane = opq(lane_);
        const int chain = u / DN_NSUB, c = u % DN_NSUB, dir = chain & 1, h = (chain >> 1) & 3, b = chain >> 3;
        const int ti = lane & 15, kg = lane >> 4;
        const size_t rrow = (size_t)seqrow(b, dir, c * 16 + ti);
        const bf16_t* p = RW + rrow * 1280 + h * 64 + 8 * kg; const float* pw = RWW + rrow * 512 + dir * 256 + h * 64 + 8 * kg;
        float av[16], bv[16], kv[16], rv[16], wv[16];
#pragma unroll
        for (int s = 0; s < 2; ++s)
#pragma unroll
            for (int q = 0; q < 2; ++q) { const int o = 32 * s + 4 * q;
                const f32x4 r4 = ldp4(p + o), k4 = ldp4(p + 256 + o), a4 = ldp4(p + 768 + o), b4 = ldp4(p + 1024 + o), w4 = *(const f32x4*)(pw + o);
#pragma unroll
                for (int e = 0; e < 4; ++e) { const int x = 8 * s + 4 * q + e; rv[x] = r4[e]; kv[x] = k4[e]; av[x] = a4[e]; bv[x] = b4[e]; wv[x] = w4[e]; } }
        u32x4 fa[2], fr[2], fb[2], fk[2];
        float p15[16];
#pragma unroll
        for (int x = 0; x < 16; ++x) {
            float P = wv[x]; P *= dpp1<0x111>(P); P *= dpp1<0x112>(P); P *= dpp1<0x114>(P); P *= dpp1<0x118>(P);
            const float Pex = dpp1<0x111>(P), ip = frcp(P);
            av[x] *= Pex; rv[x] *= P; bv[x] *= ip; kv[x] *= ip;
            p15[x] = dppf<0x140>(P);
        }
#pragma unroll
        for (int s = 0; s < 2; ++s) {
            fa[s].x = cvt2(av[8 * s], av[8 * s + 1]); fa[s].y = cvt2(av[8 * s + 2], av[8 * s + 3]); fa[s].z = cvt2(av[8 * s + 4], av[8 * s + 5]); fa[s].w = cvt2(av[8 * s + 6], av[8 * s + 7]);
            fr[s].x = cvt2(rv[8 * s], rv[8 * s + 1]); fr[s].y = cvt2(rv[8 * s + 2], rv[8 * s + 3]); fr[s].z = cvt2(rv[8 * s + 4], rv[8 * s + 5]); fr[s].w = cvt2(rv[8 * s + 6], rv[8 * s + 7]);
            fb[s].x = cvt2(bv[8 * s], bv[8 * s + 1]); fb[s].y = cvt2(bv[8 * s + 2], bv[8 * s + 3]); fb[s].z = cvt2(bv[8 * s + 4], bv[8 * s + 5]); fb[s].w = cvt2(bv[8 * s + 6], bv[8 * s + 7]);
            fk[s].x = cvt2(kv[8 * s], kv[8 * s + 1]); fk[s].y = cvt2(kv[8 * s + 2], kv[8 * s + 3]); fk[s].z = cvt2(kv[8 * s + 4], kv[8 * s + 5]); fk[s].w = cvt2(kv[8 * s + 6], kv[8 * s + 7]);
            *(LAS u32x4*)(Ab + ti * 64 + 32 * s + 8 * kg) = fa[s]; *(LAS u32x4*)(Rb + ti * 64 + 32 * s + 8 * kg) = fr[s];
            *(LAS u32x4*)(Bb + ti * 64 + 32 * s + 8 * kg) = fb[s]; *(LAS u32x4*)(Kb + ti * 64 + 32 * s + 8 * kg) = fk[s];
        }
        unsigned char* ub = a.ws + WS_RWC + (size_t)u * 10496;
        if (ti == 0) {
            float* pp = (float*)(ub + 10240) + 8 * kg;
            *(f32x4*)(pp) = (f32x4){p15[0], p15[1], p15[2], p15[3]}; *(f32x4*)(pp + 4) = (f32x4){p15[4], p15[5], p15[6], p15[7]};
            *(f32x4*)(pp + 32) = (f32x4){p15[8], p15[9], p15[10], p15[11]}; *(f32x4*)(pp + 36) = (f32x4){p15[12], p15[13], p15[14], p15[15]};
        }
        f32x4 dab = {0.f, 0.f, 0.f, 0.f}, dak = dab, dbr = dab, dkr = dab;
#pragma unroll
        for (int s = 0; s < 2; ++s) { const bf16x8 A = __builtin_bit_cast(bf16x8, fa[s]), R = __builtin_bit_cast(bf16x8, fr[s]), B = __builtin_bit_cast(bf16x8, fb[s]), K = __builtin_bit_cast(bf16x8, fk[s]);
            dab = __builtin_amdgcn_mfma_f32_16x16x32_bf16(A, B, dab, 0, 0, 0); dak = __builtin_amdgcn_mfma_f32_16x16x32_bf16(A, K, dak, 0, 0, 0);
            dbr = __builtin_amdgcn_mfma_f32_16x16x32_bf16(R, B, dbr, 0, 0, 0); dkr = __builtin_amdgcn_mfma_f32_16x16x32_bf16(R, K, dkr, 0, 0, 0); }
#pragma unroll
        for (int r = 0; r < 4; ++r) { const int i = 4 * kg + r;
            Lab[i * 16 + ti] = (ti < i) ? dab[r] : 0.f; Lak[i * 16 + ti] = (ti < i) ? dak[r] : 0.f; Lbr[i * 16 + ti] = (ti <= i) ? dbr[r] : 0.f; Lkr[i * 16 + ti] = (ti <= i) ? dkr[r] : 0.f; }
        LDS_WAIT(); asm volatile("" ::: "memory");
        if (lane < 16) {
            float nn[16];
#pragma unroll
            for (int i = 0; i < 16; ++i) { float v = (i == lane) ? 1.f : 0.f;
#pragma unroll
                for (int j = 0; j < i; ++j) v += Lab[i * 16 + j] * nn[j];
                nn[i] = v; Nm[i * 16 + lane] = v; }
        }
        LDS_WAIT(); asm volatile("" ::: "memory");
        {
            const f32x4 m0 = *(const LAS f32x4*)(Lak + ti * 16 + 4 * kg), m1 = *(const LAS f32x4*)(Nm + ti * 16 + 4 * kg), m2 = *(const LAS f32x4*)(Lbr + ti * 16 + 4 * kg), m3 = *(const LAS f32x4*)(Lkr + ti * 16 + 4 * kg);
            u32x2 o;
            o.x = cvt2(m0.x, m0.y); o.y = cvt2(m0.z, m0.w); *(u32x2*)(ub + 4096 + lane * 8) = o;
            o.x = cvt2(m1.x, m1.y); o.y = cvt2(m1.z, m1.w); *(u32x2*)(ub + 4608 + lane * 8) = o;
            o.x = cvt2(m2.x, m2.y); o.y = cvt2(m2.z, m2.w); *(u32x2*)(ub + 5120 + lane * 8) = o;
            o.x = cvt2(m3.x, m3.y); o.y = cvt2(m3.z, m3.w); *(u32x2*)(ub + 5632 + lane * 8) = o;
        }
#pragma unroll
        for (int s = 0; s < 2; ++s) {
            u32x4 o; const u32x2 a0 = *(const LAS u32x2*)(Ab + ti * 64 + 32 * s + 4 * kg), a1 = *(const LAS u32x2*)(Ab + ti * 64 + 32 * s + 16 + 4 * kg);
            o.x = a0.x; o.y = a0.y; o.z = a1.x; o.w = a1.y; *(u32x4*)(ub + s * 1024 + lane * 16) = o;
            const u32x2 r0 = *(const LAS u32x2*)(Rb + ti * 64 + 32 * s + 4 * kg), r1 = *(const LAS u32x2*)(Rb + ti * 64 + 32 * s + 16 + 4 * kg);
            o.x = r0.x; o.y = r0.y; o.z = r1.x; o.w = r1.y; *(u32x4*)(ub + 2048 + s * 1024 + lane * 16) = o;
        }
#pragma unroll
        for (int dt = 0; dt < 4; ++dt) {
            u32x2 o;
            const LAS bf16_t* bp = Bb + (4 * kg) * 64 + 16 * dt + ti; const LAS bf16_t* kp = Kb + (4 * kg) * 64 + 16 * dt + ti;
            o.x = (unsigned)bp[0] | ((unsigned)bp[64] << 16); o.y = (unsigned)bp[128] | ((unsigned)bp[192] << 16); *(u32x2*)(ub + 6144 + dt * 512 + lane * 8) = o;
            o.x = (unsigned)kp[0] | ((unsigned)kp[64] << 16); o.y = (unsigned)kp[128] | ((unsigned)kp[192] << 16); *(u32x2*)(ub + 8192 + dt * 512 + lane * 8) = o;
        }
        LDS_WAIT(); asm volatile("" ::: "memory");
    }
}
struct RwBuf { bf16x8 atf[2], rtf[2], lakf, nf, lbrf, lkrf, bfr[4], kfr[4]; float vr[4]; };
struct RwBuf2 { f32x4 p15[4]; };
__device__ __forceinline__ void rw_load(RwBuf& B, f32x4 (&p15)[4], const LAS unsigned char* slot, int vt, int lane) {
    const int n = lane & 15, g = lane >> 4;
    const LAS unsigned char* ub = slot + lane * 16;
#pragma unroll
    for (int s = 0; s < 2; ++s) { B.atf[s] = *(const LAS bf16x8*)(ub + s * 1024); B.rtf[s] = *(const LAS bf16x8*)(ub + 2048 + s * 1024); }
#define RW_HALF(off) ({ const u32x2 v_ = *(const LAS u32x2*)(slot + (off) + lane * 8); const u32x4 f_ = {v_.x, v_.y, 0u, 0u}; __builtin_bit_cast(bf16x8, f_); })
    B.lakf = RW_HALF(4096); B.nf = RW_HALF(4608); B.lbrf = RW_HALF(5120); B.lkrf = RW_HALF(5632);
#pragma unroll
    for (int dt = 0; dt < 4; ++dt) { B.bfr[dt] = RW_HALF(6144 + dt * 512); B.kfr[dt] = RW_HALF(8192 + dt * 512); p15[dt] = *(const LAS f32x4*)(slot + 10240 + (16 * dt + 4 * g) * 4); }
#undef RW_HALF
    const LAS bf16_t* vs = (const LAS bf16_t*)(slot + 11264);
#pragma unroll
    for (int r = 0; r < 4; ++r) B.vr[r] = __builtin_bit_cast(float, ((unsigned)vs[(4 * g + r) * 64 + vt * 16 + n]) << 16);
}
__device__ __forceinline__ void rw_step(const RwBuf& B, const f32x4 (&p15)[4], f32x4 (&Sd)[4], float* YR, int b, int dir, int h, int vt, int c, int lane) {
    const int n = lane & 15, g = lane >> 4;
    const f32x4 z4 = {0.f, 0.f, 0.f, 0.f};
    u32x4 pv; pv.x = cvt2(B.vr[0], B.vr[1]); pv.y = cvt2(B.vr[2], B.vr[3]); pv.z = 0u; pv.w = 0u;
    const bf16x8 vb = __builtin_bit_cast(bf16x8, pv);
    bf16x8 sb[2];
#pragma unroll
    for (int s = 0; s < 2; ++s) { u32x4 p; p.x = cvt2(Sd[2 * s].x, Sd[2 * s].y); p.y = cvt2(Sd[2 * s].z, Sd[2 * s].w); p.z = cvt2(Sd[2 * s + 1].x, Sd[2 * s + 1].y); p.w = cvt2(Sd[2 * s + 1].z, Sd[2 * s + 1].w); sb[s] = __builtin_bit_cast(bf16x8, p); }
    f32x4 X = __builtin_amdgcn_mfma_f32_16x16x32_bf16(B.atf[0], sb[0], z4, 0, 0, 0);
    X = __builtin_amdgcn_mfma_f32_16x16x32_bf16(B.atf[1], sb[1], X, 0, 0, 0);
    X = __builtin_amdgcn_mfma_f32_16x16x32_bf16(B.lakf, vb, X, 0, 0, 0);
    u32x4 px; px.x = cvt2(X.x, X.y); px.y = cvt2(X.z, X.w); px.z = 0u; px.w = 0u;
    const f32x4 UT = __builtin_amdgcn_mfma_f32_16x16x32_bf16(B.nf, __builtin_bit_cast(bf16x8, px), z4, 0, 0, 0);
    u32x4 pu; pu.x = cvt2(UT.x, UT.y); pu.y = cvt2(UT.z, UT.w); pu.z = 0u; pu.w = 0u;
    const bf16x8 ubf = __builtin_bit_cast(bf16x8, pu);
    f32x4 Y = __builtin_amdgcn_mfma_f32_16x16x32_bf16(B.rtf[0], sb[0], z4, 0, 0, 0);
    Y = __builtin_amdgcn_mfma_f32_16x16x32_bf16(B.rtf[1], sb[1], Y, 0, 0, 0);
    Y = __builtin_amdgcn_mfma_f32_16x16x32_bf16(B.lbrf, ubf, Y, 0, 0, 0);
    Y = __builtin_amdgcn_mfma_f32_16x16x32_bf16(B.lkrf, vb, Y, 0, 0, 0);
#pragma unroll
    for (int r = 0; r < 4; ++r) YR[(size_t)seqrow(b, dir, c * 16 + 4 * g + r) * 256 + h * 64 + vt * 16 + n] = Y[r];
#pragma unroll
    for (int dt = 0; dt < 4; ++dt) { f32x4 t = __builtin_amdgcn_mfma_f32_16x16x32_bf16(B.bfr[dt], ubf, Sd[dt], 0, 0, 0); t = __builtin_amdgcn_mfma_f32_16x16x32_bf16(B.kfr[dt], vb, t, 0, 0, 0); Sd[dt] = t * p15[dt]; }
}
__device__ __forceinline__ void scan_rw_seq(const Args& a, LAS unsigned char* lds, int chain, int vt, int lane, const RingSync& rs) {
    const int dir = chain & 1, h = (chain >> 1) & 3, b = chain >> 3;
    float* YR = (float*)(a.ws + WS_YRW) + (size_t)dir * MALL * 256;
    f32x4 Sd[4];
#pragma unroll
    for (int i = 0; i < 4; ++i) Sd[i] = (f32x4){0.f, 0.f, 0.f, 0.f};
    RwBuf A, B; f32x4 pa[4], pb[4];
    ring_wait_ready(rs, 0); rw_load(A, pa, lds + RING_OFF, vt, lane); ring_release(rs, vt, 0, lane);
    for (int c = 0; c < DN_NSUB; c += 2) {
        ring_wait_ready(rs, c + 1); rw_load(B, pb, lds + RING_OFF + ((c + 1) % RING_R) * RING_SLOT, vt, lane); ring_release(rs, vt, c + 1, lane);
        rw_step(A, pa, Sd, YR, b, dir, h, vt, c, lane);
        if (c + 2 < DN_NSUB) { ring_wait_ready(rs, c + 2); rw_load(A, pa, lds + RING_OFF + ((c + 2) % RING_R) * RING_SLOT, vt, lane); ring_release(rs, vt, c + 2, lane); }
        rw_step(B, pb, Sd, YR, b, dir, h, vt, c + 1, lane);
    }
}

struct DnBuf { bf16x8 wf[4], qf[4], kf[8], af; f32x4 uv; float gam; };
__device__ __forceinline__ void dn_load(DnBuf& B, const LAS unsigned char* slot, int w, int lane) {
    const LAS unsigned char* ub = slot + lane * 16;
#pragma unroll
    for (int s = 0; s < 4; ++s) { B.wf[s] = *(const LAS bf16x8*)(ub + s * 1024); B.qf[s] = *(const LAS bf16x8*)(ub + 4096 + s * 1024); }
#pragma unroll
    for (int dt = 0; dt < 8; ++dt) { const u32x2 v = *(const LAS u32x2*)(slot + 8192 + dt * 512 + lane * 8); const u32x4 f = {v.x, v.y, 0u, 0u}; B.kf[dt] = __builtin_bit_cast(bf16x8, f); }
    { const u32x2 v = *(const LAS u32x2*)(slot + 12288 + lane * 8); const u32x4 f = {v.x, v.y, 0u, 0u}; B.af = __builtin_bit_cast(bf16x8, f); }
    B.uv = *(const LAS f32x4*)(ub + 13312 + w * 1024);
    B.gam = *(const LAS float*)(slot + 17408);
}
__device__ __forceinline__ void dn_step(const DnBuf& B, f32x4 (&Sd)[8], float* OD, int b, int dir, int h, int c, int ct, int n, int g) {
    f32x4 ws = {0.f, 0.f, 0.f, 0.f}, qs = ws;
#pragma unroll
    for (int s = 0; s < 4; ++s) { u32x4 p; p.x = cvt2(Sd[2 * s].x, Sd[2 * s].y); p.y = cvt2(Sd[2 * s].z, Sd[2 * s].w); p.z = cvt2(Sd[2 * s + 1].x, Sd[2 * s + 1].y); p.w = cvt2(Sd[2 * s + 1].z, Sd[2 * s + 1].w);
        const bf16x8 sb = __builtin_bit_cast(bf16x8, p);
        ws = __builtin_amdgcn_mfma_f32_16x16x32_bf16(B.wf[s], sb, ws, 0, 0, 0); qs = __builtin_amdgcn_mfma_f32_16x16x32_bf16(B.qf[s], sb, qs, 0, 0, 0); }
    const f32x4 vn = B.uv - ws;
    u32x4 pv; pv.x = cvt2(vn.x, vn.y); pv.y = cvt2(vn.z, vn.w); pv.z = 0u; pv.w = 0u;
    const bf16x8 vb = __builtin_bit_cast(bf16x8, pv);
    const f32x4 o = __builtin_amdgcn_mfma_f32_16x16x32_bf16(B.af, vb, qs, 0, 0, 0);
#pragma unroll
    for (int dt = 0; dt < 8; ++dt) Sd[dt] = __builtin_amdgcn_mfma_f32_16x16x32_bf16(B.kf[dt], vb, Sd[dt] * B.gam, 0, 0, 0);
#pragma unroll
    for (int r = 0; r < 4; ++r) OD[(size_t)seqrow(b, dir, c * 16 + 4 * g + r) * 512 + h * 128 + ct * 16 + n] = o[r];
}
__device__ __forceinline__ void scan_dn_seq(const Args& a, LAS unsigned char* lds, int chain, int ct, int lane, const RingSync& rs) {
    const int dir = chain & 1, h = (chain >> 1) & 3, b = chain >> 3, w = ct & 3;
    const int n = lane & 15, g = lane >> 4;
    float* OD = (float*)(a.ws + WS_ODN) + (size_t)dir * MALL * 512;
    f32x4 Sd[8];
#pragma unroll
    for (int i = 0; i < 8; ++i) Sd[i] = (f32x4){0.f, 0.f, 0.f, 0.f};
    DnBuf A, B;
    ring_wait_ready(rs, 0); dn_load(A, lds + RING_OFF, w, lane); ring_release(rs, w, 0, lane);
    for (int c = 0; c < DN_NSUB; c += 2) {
        ring_wait_ready(rs, c + 1); dn_load(B, lds + RING_OFF + ((c + 1) % RING_R) * RING_SLOT, w, lane); ring_release(rs, w, c + 1, lane);
        dn_step(A, Sd, OD, b, dir, h, c, ct, n, g);
        if (c + 2 < DN_NSUB) { ring_wait_ready(rs, c + 2); dn_load(A, lds + RING_OFF + ((c + 2) % RING_R) * RING_SLOT, w, lane); ring_release(rs, w, c + 2, lane); }
        dn_step(B, Sd, OD, b, dir, h, c + 1, ct, n, g);
    }
}

__device__ __forceinline__ void ring_issue(const Args& a, LAS unsigned char* lds, int kind, int chain, int half, int c, int lane) {
    const int dir = chain & 1, h = (chain >> 1) & 3, b = chain >> 3, grp = h >> 1;
    LAS unsigned char* slot = lds + RING_OFF + (c % RING_R) * RING_SLOT;
    const size_t u = (size_t)chain * DN_NSUB + c;
    int gi; const size_t mbase = mb_base(b, dir, c, gi);
#pragma unroll
    for (int p = 0; p < RING_NP; ++p) {
        const int off = p * 1024 + lane * 16; const unsigned char* gp = nullptr;
        if (kind == 0) { if (off < 12800) gp = a.ws + WS_DNC + u * 12800 + off; else if (off >= 13312 && off < 17408) gp = a.ws + WS_DNU + u * 8192 + half * 4096 + (off - 13312); else if (off == 17408) gp = a.ws + WS_DNG + u * 4; }
        else if (kind == 1) { if (p < 12) gp = a.ws + WS_MBC + ((size_t)(b * 2 + grp) * DN_NSUB + gi) * 12288 + off;
            else if (p < 16) gp = a.ws + WS_MXBC + ((mbase + (p - 12) * 4 + (lane >> 4)) * 768 + h * 64) * 4 + (lane & 15) * 16;
            else if (p == 16) gp = a.ws + WS_MDT + mbase * 64 + lane * 16; }
        else { if (off < 10496) gp = a.ws + WS_RWC + u * 10496 + off;
            else if (p >= 11 && p < 13) gp = a.ws + WS_RW + ((size_t)seqrow(b, dir, c * 16 + (p - 11) * 8 + (lane >> 3)) * 1280 + 512 + h * 64) * 2 + (lane & 7) * 16; }
        if (gp) __builtin_amdgcn_global_load_lds((const unsigned*)gp, (LAS unsigned*)(slot + p * 1024), 16, 0, 0);
        else asm volatile("s_nop 0");
    }
}
__device__ __forceinline__ void ring_loader(const Args& a, LAS unsigned char* lds, int kind, int chain, int half, int j, int lane, const RingSync& rs) {
    int c = j;
    ring_issue(a, lds, kind, chain, half, c, lane);
    for (; c < DN_NSUB; c += 4) {
        const int cn = c + 4;
        if (cn < DN_NSUB) {
            if (cn >= RING_R) { unsigned sp = 0; while ((rs.prog[0] < cn - RING_R + 1 || rs.prog[1] < cn - RING_R + 1 || rs.prog[2] < cn - RING_R + 1 || rs.prog[3] < cn - RING_R + 1) && ++sp < (1u << 24)) __builtin_amdgcn_s_sleep(1); }
            ring_issue(a, lds, kind, chain, half, cn, lane);
            if (kind == 0) asm volatile("s_waitcnt vmcnt(18)" ::: "memory"); else if (kind == 1) asm volatile("s_waitcnt vmcnt(17)" ::: "memory"); else asm volatile("s_waitcnt vmcnt(13)" ::: "memory");
        } else asm volatile("s_waitcnt vmcnt(0)" ::: "memory");
        if (lane == 0) rs.lready[j] = c + 1;
    }
}
__device__ __forceinline__ void phase_scan(const Args& a, LAS unsigned char* lds, int tid_, int bid, int G) {
    RingSync rs; rs.prog = (volatile LAS int*)(lds + 4096); rs.lready = (volatile LAS int*)(lds + 4096 + 64);
    for (int item = bid; item < 128; item += G) {
        if (tid_ < 8) { if (tid_ < 4) rs.prog[tid_] = 0; else rs.lready[tid_ - 4] = 0; }
        __syncthreads();
        const int tid = opq(tid_), w = tid >> 6, lane = tid & 63;
        if (item < 64) { const int chain = item >> 1, half = item & 1;
            if (w < 4) scan_dn_seq(a, lds, chain, half * 4 + w, lane, rs); else ring_loader(a, lds, 0, chain, half, w - 4, lane, rs); }
        else if (item < 96) { const int chain = item - 64;
            if (w < 4) scan_mamba_seq(a, lds, chain, w, lane, rs); else ring_loader(a, lds, 1, chain, 0, w - 4, lane, rs); }
        else { const int chain = item - 96;
            if (w < 4) scan_rw_seq(a, lds, chain, w, lane, rs); else ring_loader(a, lds, 2, chain, 0, w - 4, lane, rs); }
        __syncthreads();
    }
}

struct FnBuf { f32x4 xs, ym0, ym1, z, od0[2], od1[2], gt[2], yr0, yr1, g; u32x2 rr, kk, vv; };
__device__ __forceinline__ void fn_load(FnBuf& B, const Args& a, int row, int lane) {
    const float* P = (const float*)(a.ws + WS_P);
    const float* MX = (const float*)(a.ws + WS_MXBC); const float* YM = (const float*)(a.ws + WS_YM);
    const float* OD = (const float*)(a.ws + WS_ODN); const float* YR = (const float*)(a.ws + WS_YRW);
    const bf16_t* RW = (const bf16_t*)(a.ws + WS_RW); const float* RG = (const float*)(a.ws + WS_RWG);
    const int c4 = lane * 4;
    B.xs = *(const f32x4*)(MX + (size_t)row * 768 + c4);
    B.ym0 = *(const f32x4*)(YM + (size_t)row * 256 + c4); B.ym1 = *(const f32x4*)(YM + (size_t)(MALL + row) * 256 + c4);
    B.z = *(const f32x4*)(P + (size_t)row * INP + c4);
    int dr = row;
    if (row < NL) { const int b = row >> 12, t = row & 4095; dr = b * 4096 + (t & 63) * 64 + (t >> 6); }
#pragma unroll
    for (int blk = 0; blk < 2; ++blk) { const int ch = blk * 256 + c4;
        B.od0[blk] = *(const f32x4*)(OD + (size_t)dr * 512 + ch); B.od1[blk] = *(const f32x4*)(OD + (size_t)(MALL + dr) * 512 + ch);
        B.gt[blk] = *(const f32x4*)(P + (size_t)row * INP + DN_OFF + 1536 + ch); }
    B.yr0 = *(const f32x4*)(YR + (size_t)row * 256 + c4); B.yr1 = *(const f32x4*)(YR + (size_t)(MALL + row) * 256 + c4);
    const bf16_t* rwp = RW + (size_t)row * 1280 + c4;
    B.rr = *(const u32x2*)rwp; B.kk = *(const u32x2*)(rwp + 256); B.vv = *(const u32x2*)(rwp + 512);
    B.g = *(const f32x4*)(RG + (size_t)row * 256 + c4);
}
__device__ __forceinline__ f32x4 up4(u32x2 v) { return (f32x4){__builtin_bit_cast(float, v.x << 16), __builtin_bit_cast(float, v.x & 0xffff0000u), __builtin_bit_cast(float, v.y << 16), __builtin_bit_cast(float, v.y & 0xffff0000u)}; }
__device__ __forceinline__ void fn_step(const FnBuf& B, const Args& a, int L, int row, int lane) {
    const int c4 = lane * 4;
    bf16_t* yo = (bf16_t*)(a.ws + WS_YMIX) + (size_t)row * D;
    {
        const float dsk = a.in[14][L * 4 + (lane >> 4)];
        f32x4 y = B.xs * dsk + B.ym0 + B.ym1;
#pragma unroll
        for (int i = 0; i < 4; ++i) y[i] *= siluf(B.z[i]);
        const float ss = grp_sum<32>((y.x * y.x + y.y * y.y) + (y.z * y.z + y.w * y.w));
        const float r = frsq(ss * (1.f / 128.f) + 1e-5f);
        const f32x4 nw = *(const f32x4*)(a.in[15] + L * 256 + c4);
        y = y * r * nw;
        u32x2 pk; pk.x = cvt2(y.x, y.y); pk.y = cvt2(y.z, y.w); *(u32x2*)(yo + c4) = pk;
    }
#pragma unroll
    for (int blk = 0; blk < 2; ++blk) {
        const int ch = blk * 256 + c4;
        f32x4 o = B.od0[blk] + B.od1[blk];
        const float ss = grp_sum<32>((o.x * o.x + o.y * o.y) + (o.z * o.z + o.w * o.w));
        const float r = frsq(ss * (1.f / 128.f) + 1e-6f);
        const f32x4 nw = *(const f32x4*)(a.in[19] + L * 128 + (ch & 127));
#pragma unroll
        for (int i = 0; i < 4; ++i) o[i] = o[i] * r * nw[i] * siluf(B.gt[blk][i]);
        u32x2 pk; pk.x = cvt2(o.x, o.y); pk.y = cvt2(o.z, o.w); *(u32x2*)(yo + 256 + ch) = pk;
    }
    {
        f32x4 y = B.yr0 + B.yr1;
        const float mean = grp_sum<16>((y.x + y.y) + (y.z + y.w)) * (1.f / 64.f);
        y = y - mean;
        const float var = grp_sum<16>((y.x * y.x + y.y * y.y) + (y.z * y.z + y.w * y.w)) * (1.f / 64.f);
        const float r = frsq(var + 64e-5f);
        const f32x4 lw = *(const f32x4*)(a.in[29] + L * 256 + c4), lb = *(const f32x4*)(a.in[30] + L * 256 + c4);
        const f32x4 rv = up4(B.rr), kv = up4(B.kk), vv = up4(B.vv);
        const f32x4 rkw = *(const f32x4*)(a.in[28] + L * 256 + c4);
        const float bs = grp_sum<16>((rv.x * kv.x * rkw.x + rv.y * kv.y * rkw.y) + (rv.z * kv.z * rkw.z + rv.w * kv.w * rkw.w));
        f32x4 o = (y * r * lw + lb + vv * bs) * B.g;
        u32x2 pk; pk.x = cvt2(o.x, o.y); pk.y = cvt2(o.z, o.w); *(u32x2*)(yo + 768 + c4) = pk;
    }
}
__device__ __forceinline__ void phase_finish(const Args& a, int L, int nrows, int lane_, int wave, int bid, int G) {
    const int lane = opq(lane_), r0 = bid * 8 + wave, st = G * 8;
    if (r0 >= nrows) return;
    FnBuf A, B; fn_load(A, a, r0, lane);
    for (int row = r0; row < nrows; row += 2 * st) {
        const int r1 = row + st, r2 = row + 2 * st;
        if (r1 < nrows) fn_load(B, a, r1, lane);
        fn_step(A, a, L, row, lane);
        if (r1 < nrows) { if (r2 < nrows) fn_load(A, a, r2, lane); fn_step(B, a, L, r1, lane); }
    }
}

__device__ __forceinline__ void phase_router(const Args& a, int L, int nrows, const float* xm, LAS unsigned char* lds, int tid, int lane, int wave, int bid, int G) {
    LAS float* wr = (LAS float*)lds;
    const float* wsrc = a.in[31] + (size_t)L * 1024 * 32;
    for (int i = tid; i < 8192; i += 512) { const f32x4 v = *(const f32x4*)(wsrc + i * 4); const int k = i >> 3, e = (i & 7) * 4;
        wr[(e + 0) * 1024 + k] = v.x; wr[(e + 1) * 1024 + k] = v.y; wr[(e + 2) * 1024 + k] = v.z; wr[(e + 3) * 1024 + k] = v.w; }
    __syncthreads();
    const float* mod = (const float*)(a.ws + WS_MOD) + (size_t)L * 5 * 6144;
    bf16_t* H2 = (bf16_t*)(a.ws + WS_HN);
    int* tok = (int*)(a.ws + WS_TOK + (size_t)L * TOK_STRIDE);
    LAS unsigned* hist = (LAS unsigned*)(lds + RING_BYTES + 2048);
    if (tid < 32) hist[tid] = 0u;
    __syncthreads();
    const float brt = lane < 32 ? a.in[32][L * 32 + lane] : 0.f;
    for (int row = bid * 8 + wave; row < nrows; row += G * 8) {
        const int bi = row < NL ? (row >> 12) : 4;
        f32x4 v[4];
#pragma unroll
        for (int j = 0; j < 4; ++j) v[j] = *(const f32x4*)(xm + (size_t)row * D + j * 256 + lane * 4);
        norm_mod_store(v, a.in[7] + L * D, mod + (size_t)bi * 6144 + 3 * 1024, mod + (size_t)bi * 6144 + 4 * 1024, H2 + (size_t)row * D, lane);
        float mine = -3.0e38f;
#pragma unroll 4
        for (int e = 0; e < 32; ++e) { float p = 0.f;
#pragma unroll
            for (int j = 0; j < 4; ++j) { const f32x4 w4 = *(const LAS f32x4*)(wr + e * 1024 + j * 256 + lane * 4); p += (v[j].x * w4.x + v[j].y * w4.y) + (v[j].z * w4.z + v[j].w * w4.w); }
            p = wave_sum(p);
            if (lane == e) mine = p + brt; }
        float tl[4]; int te[4];
#pragma unroll
        for (int k = 0; k < 4; ++k) { const float m = wave_max(mine); const unsigned long long bal = __ballot(mine == m); const int idx = __ffsll((long long)bal) - 1;
            tl[k] = m; te[k] = idx; if (lane == idx) mine = -3.0e38f; }
        const float e1 = __expf(tl[1] - tl[0]), e2 = __expf(tl[2] - tl[0]), e3 = __expf(tl[3] - tl[0]); const float inv = 1.f / (1.f + e1 + e2 + e3);
        if (lane < 4) { const int e = lane == 0 ? te[0] : lane == 1 ? te[1] : lane == 2 ? te[2] : te[3];
            const float g = (lane == 0 ? 1.f : lane == 1 ? e1 : lane == 2 ? e2 : e3) * inv;
            const unsigned pos = __hip_atomic_fetch_add(hist + e, 1u, __ATOMIC_RELAXED, __HIP_MEMORY_SCOPE_WORKGROUP);
            tok[TK_E + row * 4 + lane] = e; ((float*)tok)[TK_G + row * 4 + lane] = g; tok[TK_POS + row * 4 + lane] = (int)pos; }
    }
    __syncthreads();
    if (tid < 32) tok[TK_BCNT + bid * 32 + tid] = (int)hist[tid];
}
__device__ __forceinline__ void phase_scatter(const Args& a, int L, int nrows, LAS unsigned char* lds, int tid, int lane, int wave, int bid, int G) {
    LAS int* ps = (LAS int*)lds;
    int* tok = (int*)(a.ws + WS_TOK + (size_t)L * TOK_STRIDE);
    if (tid < 32) { int tot = 0, off = 0; for (int b = 0; b < G; ++b) { const int c = tok[TK_BCNT + b * 32 + tid]; tot += c; off += (b < bid) ? c : 0; } ps[64 + tid] = tot; ps[128 + tid] = off; }
    __syncthreads();
    if (tid == 0) { int acc = 0; for (int e = 0; e < 32; ++e) { ps[e] = acc; acc += (ps[64 + e] + 255) & ~255; } ps[32] = acc; }
    __syncthreads();
    if (tid < 32) ps[128 + tid] += ps[tid];
    if (bid == 0) { const int nblk = ps[32] >> 8;
        for (int m = tid; m < MAXBLK; m += 512) { int e = 0; for (int q = 1; q < 32; ++q) if ((m << 8) >= ps[q]) e = q; tok[TK_BLKE + m] = e; }
        if (tid == 0) tok[TK_NBLK] = nblk; }
    __syncthreads();
    const bf16_t* H2 = (const bf16_t*)(a.ws + WS_HN); bf16_t* HS = (bf16_t*)(a.ws + WS_HS);
    for (int row = bid * 8 + wave; row < nrows; row += G * 8) {
        const u32x4 d0 = *(const u32x4*)(H2 + (size_t)row * D + lane * 8), d1 = *(const u32x4*)(H2 + (size_t)row * D + 512 + lane * 8);
#pragma unroll
        for (int k = 0; k < 4; ++k) { const int e = tok[TK_E + row * 4 + k], pos = tok[TK_POS + row * 4 + k]; const int slot = ps[128 + e] + pos;
            *(u32x4*)(HS + (size_t)slot * D + lane * 8) = d0; *(u32x4*)(HS + (size_t)slot * D + 512 + lane * 8) = d1;
            if (lane == 0) tok[TK_SLOT + row * 4 + k] = slot; }
    }
}
struct CbTok { int slot[4]; float g[4]; };
struct CbBuf { u32x2 y[4][4]; f32x4 x[4]; float g[4]; };
__device__ __forceinline__ void cb_tok(CbTok& T, const int* tok, int row) {
#pragma unroll
    for (int k = 0; k < 4; ++k) { T.slot[k] = tok[TK_SLOT + row * 4 + k]; T.g[k] = ((const float*)tok)[TK_G + row * 4 + k]; }
}
__device__ __forceinline__ void cb_load(CbBuf& B, const CbTok& T, const bf16_t* Y, const float* xm, int row, int lane) {
#pragma unroll
    for (int k = 0; k < 4; ++k) { B.g[k] = T.g[k];
#pragma unroll
        for (int j = 0; j < 4; ++j) B.y[k][j] = *(const u32x2*)(Y + (size_t)T.slot[k] * D + j * 256 + lane * 4); }
#pragma unroll
    for (int j = 0; j < 4; ++j) B.x[j] = *(const f32x4*)(xm + (size_t)row * D + j * 256 + lane * 4);
}
__device__ __forceinline__ void cb_finish(const CbBuf& B, const Args& a, int L, const float* mod, int row, int lane) {
    const int bi = row < NL ? (row >> 12) : 4;
    f32x4 v[4];
#pragma unroll
    for (int j = 0; j < 4; ++j) { f32x4 acc = {0.f, 0.f, 0.f, 0.f};
#pragma unroll
        for (int k = 0; k < 4; ++k) { const u32x2 yv = B.y[k][j];
            acc += (f32x4){__builtin_bit_cast(float, yv.x << 16), __builtin_bit_cast(float, yv.x & 0xffff0000u), __builtin_bit_cast(float, yv.y << 16), __builtin_bit_cast(float, yv.y & 0xffff0000u)} * B.g[k]; }
        v[j] = B.x[j] + *(const f32x4*)(mod + (size_t)bi * 6144 + 5 * 1024 + j * 256 + lane * 4) * acc; }
    if (L == 0) {
        float* xb = (float*)(a.ws + WS_XB) + (size_t)row * D;
#pragma unroll
        for (int j = 0; j < 4; ++j) *(f32x4*)(xb + j * 256 + lane * 4) = v[j];
        const float* mod1 = (const float*)(a.ws + WS_MOD) + (size_t)5 * 6144;
        norm_mod_store(v, a.in[6] + D, mod1 + (size_t)bi * 6144, mod1 + (size_t)bi * 6144 + 1024, (bf16_t*)(a.ws + WS_HN) + (size_t)row * D, lane);
    } else {
        float ss = 0.f;
#pragma unroll
        for (int j = 0; j < 4; ++j) ss += (v[j].x * v[j].x + v[j].y * v[j].y) + (v[j].z * v[j].z + v[j].w * v[j].w);
        const float r = frsq(wave_sum(ss) * (1.f / D) + 1e-6f);
#pragma unroll
        for (int j = 0; j < 4; ++j) { const int c = j * 256 + lane * 4; *(f32x4*)(a.out + (size_t)row * D + c) = v[j] * r * *(const f32x4*)(a.in[37] + c); }
    }
}
__device__ __forceinline__ void phase_combine(const Args& a, int L, int nrows, const float* xm, int lane_, int wave, int bid, int G) {
    const float* mod = (const float*)(a.ws + WS_MOD) + (size_t)L * 5 * 6144;
    const int* tok = (const int*)(a.ws + WS_TOK + (size_t)L * TOK_STRIDE);
    const bf16_t* Y = (const bf16_t*)(a.ws + WS_Y);
    const int lane = opq(lane_), r0 = bid * 8 + wave, st = G * 8;
    if (r0 >= nrows) return;
    CbTok T0, T1; CbBuf A, B;
    cb_tok(T0, tok, r0); cb_load(A, T0, Y, xm, r0, lane);
    if (r0 + st < nrows) cb_tok(T1, tok, r0 + st);
    for (int row = r0; row < nrows; row += 2 * st) {
        const int r1 = row + st, r2 = row + 2 * st, r3 = row + 3 * st;
        if (r1 < nrows) cb_load(B, T1, Y, xm, r1, lane);
        if (r2 < nrows) cb_tok(T0, tok, r2);
        cb_finish(A, a, L, mod, row, lane);
        if (r1 < nrows) {
            if (r2 < nrows) cb_load(A, T0, Y, xm, r2, lane);
            if (r3 < nrows) cb_tok(T1, tok, r3);
            cb_finish(B, a, L, mod, r1, lane);
        }
    }
}

__global__ void __launch_bounds__(512, 2) fwd_kernel(Args a) {
    extern __shared__ __attribute__((aligned(16))) unsigned char lds_raw[];
    LAS unsigned char* lds = (LAS unsigned char*)lds_raw;
    const int wave0 = __builtin_amdgcn_readfirstlane((int)threadIdx.x >> 6), bid = blockIdx.x, G = gridDim.x;
    const int tid0 = threadIdx.x;
    volatile LAS unsigned* MISC = (volatile LAS unsigned*)(lds + MISC_OFF);
    for (int u = tid0; u < (LDS_BYTES - RING_BYTES) / 4; u += 512) ((LAS unsigned*)(lds + RING_BYTES))[u] = 0u;
    __syncthreads();
    const int lo = a.ph_lo, hi = a.ph_hi;
    XcdBarrier bar; bar.bar = (unsigned*)(a.ws + WS_CTL) + CW_BAR; bar.x = 0; bar.st = nullptr;
    if (hi - lo > 1) bar = xcd_barrier_post((unsigned*)(a.ws + WS_CTL) + CW_BAR, MISC + 8);
#define IN(k) (lo <= (k) && (k) < hi)
#define SEAM(k) do { if (IN(k) && IN((k) + 1)) xcd_barrier(bar); } while (0)

#define PH_IDS const int lane = lane_id_v(), wave = wave0, tid = wave0 * 64 + lane
    if (IN(0)) for (int rep_ = 0; rep_ < REPN(0); ++rep_) { PH_IDS; phase_prep(a, lds, tid, lane, wave, bid, G); __syncthreads(); }
    SEAM(0);
    if (IN(1)) { PH_IDS; phase_norm1(a, 0, a.in[0], a.in[2], lane, wave, bid, G); }
    SEAM(1);
    for (int L = 0; L < 2; ++L) {
        const int pb = 2 + L * 10;
        const float* xl = L == 0 ? a.in[0] : (const float*)(a.ws + WS_XB);
        const float* xc = L == 0 ? a.in[2] : (const float*)(a.ws + WS_XB) + (size_t)NL * D;
        const int nrows = L == 0 ? MALL : NL;
        float* xm = (float*)(a.ws + WS_XA);
        int* tok = (int*)(a.ws + WS_TOK + (size_t)L * TOK_STRIDE);
        if (IN(pb + 0)) for (int rep_ = 0; rep_ < REPN(2); ++rep_) {
            pg8::StaticSched S; S.init((const bf16_t*)(a.ws + WS_HN), (const bf16_t*)(a.ws + WS_WIN) + (size_t)L * INP * 1024, MALL, INP, 1024, G, bid);
            EpiP E{(float*)(a.ws + WS_P)};
            pg8::gemm_phase<EpiP, pg8::StaticSched>(lds, 1024, S, E, wave0);
        }
        SEAM(pb + 0);
        if (IN(pb + 1)) for (int rep_ = 0; rep_ < REPN(3); ++rep_) { PH_IDS; phase_mixprep(a, L, lds, lane, wave, bid, G); }
        SEAM(pb + 1);
        if (IN(pb + 2)) for (int rep_ = 0; rep_ < REPN(4); ++rep_) { for (int r2_ = 0; r2_ < 1 + (PROBE_SCAN & 1); ++r2_) { PH_IDS; for (int r3_ = 0; r3_ < 1 + ((PROBE_SCAN >> 2) & 1); ++r3_) phase_dnpre(a, lds, lane, wave, bid, G); for (int r3_ = 0; r3_ < 1 + ((PROBE_SCAN >> 3) & 1); ++r3_) phase_mbpre(a, lane, wave, bid, G); for (int r3_ = 0; r3_ < 1 + ((PROBE_SCAN >> 4) & 1); ++r3_) phase_rwpre(a, lds, lane, wave, bid, G); } if (hi - lo > 1) xcd_barrier(bar); for (int r2_ = 0; r2_ < 1 + ((PROBE_SCAN >> 1) & 1); ++r2_) { PH_IDS; phase_scan(a, lds, tid, bid, G); } }
        SEAM(pb + 2);
        if (IN(pb + 3)) for (int rep_ = 0; rep_ < REPN(5); ++rep_) { PH_IDS; phase_finish(a, L, nrows, lane, wave, bid, G); }
        SEAM(pb + 3);
        if (IN(pb + 4)) for (int rep_ = 0; rep_ < REPN(6); ++rep_) {
            pg8::StaticSched S; S.init((const bf16_t*)(a.ws + WS_YMIX), (const bf16_t*)(a.ws + WS_WOUT) + (size_t)L * 1024 * 1024, nrows, 1024, 1024, G, bid);
            EpiOut E{xl, xc, xm, (const float*)(a.ws + WS_MOD) + (size_t)L * 5 * 6144 + 2 * 1024};
            pg8::gemm_phase<EpiOut, pg8::StaticSched>(lds, 1024, S, E, wave0);
        }
        SEAM(pb + 4);
        if (IN(pb + 5)) { PH_IDS; phase_router(a, L, nrows, xm, lds, tid, lane, wave, bid, G); }
        SEAM(pb + 5);
        if (IN(pb + 6)) for (int rep_ = 0; rep_ < REPN(8); ++rep_) { PH_IDS; phase_scatter(a, L, nrows, lds, tid, lane, wave, bid, G); __syncthreads(); }
        SEAM(pb + 6);
        if (IN(pb + 7)) for (int rep_ = 0; rep_ < REPN(9); ++rep_) {
            pg8::MoeSched S; S.nN = 8; S.nunits = tok[TK_NBLK] * 8; S.G = G; S.c = bid; S.A = (const char*)(a.ws + WS_HS); S.W = (const char*)(a.ws + WS_WGU) + (size_t)L * 32 * 2048 * 1024 * 2;
            S.tstep = (size_t)256 * 1024 * 2; S.estride = (size_t)2048 * 1024 * 2; S.blk_e = tok + TK_BLKE;
            EpiGU E{(bf16_t*)(a.ws + WS_ACT), a.in[34] + (size_t)L * 32 * 2048, tok + TK_BLKE};
            pg8::gemm_phase<EpiGU, pg8::MoeSched>(lds, 1024, S, E, wave0);
        }
        SEAM(pb + 7);
        if (IN(pb + 8)) for (int rep_ = 0; rep_ < REPN(10); ++rep_) {
            pg8::MoeSched S; S.nN = 4; S.nunits = tok[TK_NBLK] * 4; S.G = G; S.c = bid; S.A = (const char*)(a.ws + WS_ACT); S.W = (const char*)(a.ws + WS_WD) + (size_t)L * 32 * 1024 * 1024 * 2;
            S.tstep = (size_t)256 * 1024 * 2; S.estride = (size_t)1024 * 1024 * 2; S.blk_e = tok + TK_BLKE;
            EpiDown E{(bf16_t*)(a.ws + WS_Y), a.in[36] + (size_t)L * 32 * 1024, tok + TK_BLKE};
            pg8::gemm_phase<EpiDown, pg8::MoeSched>(lds, 1024, S, E, wave0);
        }
        SEAM(pb + 8);
        if (IN(pb + 9)) for (int rep_ = 0; rep_ < REPN(11); ++rep_) { PH_IDS; phase_combine(a, L, nrows, xm, lane, wave, bid, G); }
        SEAM(pb + 9);
    }
#undef IN
#undef SEAM
}

extern "C" void kernel_launch(void* const* d_in, const int* in_sizes, int n_in, void* d_out, int out_size, void* d_ws, size_t ws_size, hipStream_t stream) {
    static int grid = 0;
    if (grid == 0) {
        if (n_in != 38 || ws_size < WS_END) { fprintf(stderr, "kernel_launch: unexpected n_in %d / ws %zu\n", n_in, ws_size); grid = -1; return; }
        int dev = 0, cus = 0, per_cu = 0;
        if (hipGetDevice(&dev) != hipSuccess || hipDeviceGetAttribute(&cus, hipDeviceAttributeMultiprocessorCount, dev) != hipSuccess) { grid = -1; return; }
        if (hipFuncSetAttribute((const void*)fwd_kernel, hipFuncAttributeMaxDynamicSharedMemorySize, LDS_BYTES) != hipSuccess) { fprintf(stderr, "kernel_launch: hipFuncSetAttribute failed\n"); grid = -1; return; }
        if (hipOccupancyMaxActiveBlocksPerMultiprocessor(&per_cu, (const void*)fwd_kernel, 512, LDS_BYTES) != hipSuccess || per_cu < 1) { fprintf(stderr, "kernel_launch: occupancy query says %d\n", per_cu); }
        (void)hipGetLastError();
        grid = cus;
    }
    if (grid < 0) return;
    (void)hipMemsetAsync((char*)d_ws + WS_CTL, 0, CTL_BYTES, stream);
    Args a{};
    for (int i = 0; i < 38; ++i) a.in[i] = (const float*)d_in[i];
    a.out = (float*)d_out; a.ws = (unsigned char*)d_ws;
#if MK_PER_PHASE
    for (int p = 0; p < NPHASE; ++p) { a.ph_lo = p; a.ph_hi = p + 1; hipLaunchKernelGGL(fwd_kernel, dim3(grid), dim3(512), LDS_BYTES, stream, a); }
#else
    a.ph_lo = 0; a.ph_hi = NPHASE;
    hipLaunchKernelGGL(fwd_kernel, dim3(grid), dim3(512), LDS_BYTES, stream, a);
#endif
}
```

```cpp
#include <hip/hip_runtime.h>
#include <cstdio>
#include <cstdint>

#ifndef PROBE_REP
#define PROBE_REP 0
#endif
#define REPN(k) ((((PROBE_REP) >> (k)) & 1) + 1)
#ifndef PROBE_SCAN
#define PROBE_SCAN 0
#endif
#ifndef PROBE_MIX
#define PROBE_MIX 0
#endif
#ifndef MIXPARTS
#define MIXPARTS 7
#endif
#ifndef MK_PER_PHASE
#define MK_PER_PHASE 0
#endif

#define GAS __attribute__((address_space(1)))
#define LAS __attribute__((address_space(3)))
typedef unsigned short bf16_t;
typedef short bf16x8 __attribute__((ext_vector_type(8)));
typedef float f32x4 __attribute__((ext_vector_type(4)));
typedef unsigned u32x4 __attribute__((ext_vector_type(4)));
typedef unsigned u32x2 __attribute__((ext_vector_type(2)));

constexpr int D = 1024, NB = 4, SEQ = 4096, CTXL = 256;
constexpr int NL = NB * SEQ, NC = NB * CTXL, MALL = NL + NC;
constexpr int INC = 4184, INP = 4352;
constexpr int DN_OFF = 1032, RW_OFF = 3096;
constexpr int NE = 32, DFF = 1024;
constexpr int MAXBLK = 304, MAXSLOT = MAXBLK * 256;
constexpr int NPHASE = 22;

constexpr size_t MiB = 1u << 20;
constexpr size_t WS_CTL = 0, CTL_BYTES = 1 * MiB;
constexpr size_t WS_MOD = 1 * MiB;
constexpr size_t WS_LORA = 1 * MiB + 512 * 1024;
constexpr size_t WS_TOK = 1332 * MiB, TOK_STRIDE = 2 * MiB;
constexpr size_t WS_WIN = 4 * MiB, WS_WOUT = 21 * MiB, WS_WGU = 25 * MiB, WS_WD = 281 * MiB;
constexpr size_t WS_XA = 409 * MiB, WS_XB = 477 * MiB, WS_HN = 545 * MiB, WS_YMIX = 579 * MiB;
constexpr size_t WS_P = 613 * MiB, WS_MXBC = 902 * MiB, WS_MDT = 953 * MiB, WS_DNQKV = 955 * MiB, WS_DNGB = 1057 * MiB;
constexpr size_t WS_RWW = 1108 * MiB;
constexpr size_t WS_RW = 1060 * MiB, WS_RWG = 1179 * MiB, WS_YM = 1196 * MiB, WS_ODN = 1230 * MiB, WS_YRW = 1298 * MiB;
constexpr size_t WS_DNC = 1336 * MiB, WS_DNU = 1482 * MiB, WS_DNG = 1550 * MiB, WS_MBC = 1551 * MiB, WS_RWC = 1585 * MiB, WS_END = 1724 * MiB;
constexpr int DN_NSUB = (CTXL + SEQ) / 16, DN_UNITS = 32 * DN_NSUB, MB_UNITS = 8 * DN_NSUB;
constexpr int DN_UNITS_DUMMY = 0;
constexpr size_t WS_HS = WS_P, WS_ACT = 765 * MiB, WS_Y = 917 * MiB;
constexpr int CW_CNT = 64;
constexpr int CW_BAR = 4096;
constexpr int TK_E = 0, TK_G = MALL * 4, TK_POS = MALL * 8, TK_SLOT = MALL * 12, TK_BLKE = MALL * 16, TK_NBLK = MALL * 16 + 512, TK_BCNT = MALL * 16 + 1024;

constexpr int RING_BYTES = 131072, LDS_BYTES = 147456, MISC_OFF = LDS_BYTES - 256;

struct Args { const float* in[38]; float* out; unsigned char* ws; int ph_lo, ph_hi; };

__device__ __forceinline__ unsigned f2bf(float f) { unsigned u = __builtin_bit_cast(unsigned, f); return (u + 0x7fffu + ((u >> 16) & 1u)) >> 16; }
__device__ __forceinline__ unsigned pk2(float lo, float hi) { return f2bf(lo) | (f2bf(hi) << 16); }
__device__ __forceinline__ f32x4 ldp4(const bf16_t* p) { const u32x2 v = *(const u32x2*)p; return (f32x4){__builtin_bit_cast(float, v.x << 16), __builtin_bit_cast(float, v.x & 0xffff0000u), __builtin_bit_cast(float, v.y << 16), __builtin_bit_cast(float, v.y & 0xffff0000u)}; }
__device__ __forceinline__ float frcp(float x) { return __builtin_amdgcn_rcpf(x); }
__device__ __forceinline__ float frsq(float x) { return __builtin_amdgcn_rsqf(x); }
typedef __bf16 bf16x2_t __attribute__((ext_vector_type(2)));
typedef float f32x2_ __attribute__((ext_vector_type(2)));
__device__ __forceinline__ unsigned cvt2(float lo, float hi) { const f32x2_ v = {lo, hi}; return __builtin_bit_cast(unsigned, __builtin_convertvector(v, bf16x2_t)); }
typedef int i32x4_ __attribute__((ext_vector_type(4)));
typedef int i32x8_ __attribute__((ext_vector_type(8)));
__device__ __forceinline__ float sat8(float x) { return __builtin_amdgcn_fmed3f(x, -448.f, 448.f); }
__device__ __forceinline__ unsigned pk8(float a, float b, float c, float d) {
    int r = __builtin_amdgcn_cvt_pk_fp8_f32(sat8(a), sat8(b), 0, false); r = __builtin_amdgcn_cvt_pk_fp8_f32(sat8(c), sat8(d), r, true); return (unsigned)r; }
__device__ __forceinline__ i32x8_ cat8(bf16x8 lo, bf16x8 hi) { const i32x4_ a = __builtin_bit_cast(i32x4_, lo), b = __builtin_bit_cast(i32x4_, hi); return __builtin_shufflevector(a, b, 0, 1, 2, 3, 4, 5, 6, 7); }
__device__ __forceinline__ float siluf(float x) { return x * frcp(1.f + __expf(-x)); }
__device__ __forceinline__ float sigm(float x) { return frcp(1.f + __expf(-x)); }
__device__ __forceinline__ float softplusf(float x) { return fmaxf(x, 0.f) + __logf(1.f + __expf(-fabsf(x))); }
__device__ __forceinline__ float tanh_fast(float x) { return 1.f - 2.f * frcp(__expf(2.f * x) + 1.f); }
template <int CTRL> __device__ __forceinline__ float dppf(float v) { return __builtin_bit_cast(float, __builtin_amdgcn_update_dpp(0, __builtin_bit_cast(int, v), CTRL, 0xF, 0xF, true)); }
__device__ __forceinline__ void pswap16(float& a, float& b) { asm("s_nop 1\n\tv_permlane16_swap_b32 %0, %1" : "+v"(a), "+v"(b)); }
__device__ __forceinline__ void pswap32(float& a, float& b) { asm("s_nop 1\n\tv_permlane32_swap_b32 %0, %1" : "+v"(a), "+v"(b)); }
template <int W> __device__ __forceinline__ float grp_sum(float v) {
    v += dppf<0xB1>(v); v += dppf<0x4E>(v); v += dppf<0x141>(v); v += dppf<0x140>(v);
    if (W >= 32) { float a = v, b = v; pswap16(a, b); v = a + b; }
    if (W >= 64) { float a = v, b = v; pswap32(a, b); v = a + b; }
    return v;
}
__device__ __forceinline__ float wave_sum(float v) { return grp_sum<64>(v); }
__device__ __forceinline__ float wave_max(float v) {
    v = fmaxf(v, dppf<0xB1>(v)); v = fmaxf(v, dppf<0x4E>(v)); v = fmaxf(v, dppf<0x141>(v)); v = fmaxf(v, dppf<0x140>(v));
    { float a = v, b = v; pswap16(a, b); v = fmaxf(a, b); }
    { float a = v, b = v; pswap32(a, b); v = fmaxf(a, b); }
    return v;
}
#define LDS_WAIT() asm volatile("s_waitcnt lgkmcnt(0)" ::: "memory")
__device__ __forceinline__ int lane_id_v() { int l; asm volatile("v_mbcnt_lo_u32_b32 %0, -1, 0\n\tv_mbcnt_hi_u32_b32 %0, -1, %0" : "=v"(l)); return l; }
__device__ __forceinline__ int opq(int v) { asm volatile("" : "+v"(v)); return v; }

#define XB_TMO      128
#define XB_XCNT(j)  (256  + 64 * (j))
#define XB_XSUB(j)  (1280 + 64 * (j))
#define XB_XGEN(j)  (2304 + 64 * (j))
#define XB_TOP      3328
#define XB_TOPGEN   3392
#define XCD_BAR_WORDS 3456
#define XB_SPIN_CAP (1u << 18)
__device__ __forceinline__ unsigned xb_ld(unsigned* p)              { return __hip_atomic_load(p, __ATOMIC_RELAXED, __HIP_MEMORY_SCOPE_AGENT); }
__device__ __forceinline__ unsigned xb_add(unsigned* p, unsigned v) { return __hip_atomic_fetch_add(p, v, __ATOMIC_RELAXED, __HIP_MEMORY_SCOPE_AGENT); }
__device__ __forceinline__ unsigned xb_xcc_id() { return (unsigned)__builtin_amdgcn_s_getreg((3 << 11) | 20) & 0xFu; }
#define XB_SPIN(cond, bar) do { unsigned _sp = 0; while (cond) { __builtin_amdgcn_s_sleep(1); \
    if ((++_sp & 255u) == 0u) { if (xb_ld(&(bar)[XB_TMO])) break; if (_sp > XB_SPIN_CAP) { atomicAdd(&(bar)[XB_TMO], 1u); break; } } } } while (0)
struct XcdBarrier { unsigned* bar; unsigned x; volatile LAS unsigned* st; };
__device__ __forceinline__ XcdBarrier xcd_barrier_post(unsigned* bar, volatile LAS unsigned* st) {
    XcdBarrier b; b.bar = bar; b.x = xb_xcc_id(); b.st = st;
    if (threadIdx.x == 0) (void)xb_add(&bar[XB_XCNT(b.x)], 1u);
    return b;
}
__device__ __forceinline__ void xcd_barrier_complete(unsigned* bar, unsigned x, unsigned& nloc, unsigned& nx) {
    const unsigned G = gridDim.x * gridDim.y * gridDim.z;
    unsigned sum, cnt, mine, sp = 0u;
    for (;;) {
        sum = 0u; cnt = 0u; mine = 0u;
#pragma unroll
        for (unsigned j = 0; j < 16; ++j) { const unsigned c = xb_ld(&bar[XB_XCNT(j)]); sum += c; cnt += (c > 0u) ? 1u : 0u; mine = (j == x) ? c : mine; }
        if (sum == G) break;
        __builtin_amdgcn_s_sleep(1);
        if ((++sp & 255u) == 0u) { if (xb_ld(&bar[XB_TMO])) break; if (sp > XB_SPIN_CAP) { atomicAdd(&bar[XB_TMO], 1u); break; } }
    }
    nloc = mine > 0u ? mine : 1u; nx = cnt > 0u ? cnt : 1u;
}
__device__ __forceinline__ void xcd_barrier(const XcdBarrier& b) {
    asm volatile("s_waitcnt vmcnt(0)" ::: "memory");
    __syncthreads();
    if (threadIdx.x == 0) {
        unsigned* bar = b.bar;
        __builtin_amdgcn_s_waitcnt(0);
        unsigned nloc = b.st[0], nx = b.st[1];
        if (nloc == 0u) { xcd_barrier_complete(bar, b.x, nloc, nx); b.st[0] = nloc; b.st[1] = nx; }
        const unsigned old = xb_add(&bar[XB_XSUB(b.x)], 1u);
        const unsigned gen = old / nloc;
        if (old + 1u == (gen + 1u) * nloc) {
            __builtin_amdgcn_fence(__ATOMIC_RELEASE, "agent");
            asm volatile("s_waitcnt vmcnt(0)" ::: "memory");
            const unsigned og = xb_add(&bar[XB_TOP], 1u);
            const unsigned tg = og / nx;
            if (og + 1u == (tg + 1u) * nx) xb_add(&bar[XB_TOPGEN], 1u);
            else XB_SPIN(xb_ld(&bar[XB_TOPGEN]) == tg, bar);
            __builtin_amdgcn_fence(__ATOMIC_ACQUIRE, "agent");
            xb_add(&bar[XB_XGEN(b.x)], 1u);
            asm volatile("s_waitcnt vmcnt(0)" ::: "memory");
        } else {
            XB_SPIN(xb_ld(&bar[XB_XGEN(b.x)]) == gen, bar);
            __builtin_amdgcn_fence(__ATOMIC_ACQUIRE, "agent");
            asm volatile("s_waitcnt vmcnt(0)" ::: "memory");
        }
    }
    __syncthreads();
}

namespace pg8 {
constexpr int BM = 256, BK = 64, HALF = 128, HTB = HALF * BK * 2, STAGE_BYTES = 8 * HTB, NXCD = 8, WGM = 8;
__host__ __device__ __forceinline__ int lds_byte(int r, int c) { const int st = (r >> 4) * 2 + (c >> 5), rr = r & 15, cc = c & 31, ob = rr * 64 + cc * 2; return st * 1024 + (ob ^ (((ob >> 9) & 1) << 5)); }
__host__ __device__ __forceinline__ void stage_rc(int b, int& R, int& C) { const int st = b / 1024, sb = b % 1024, swz = sb ^ (((sb >> 9) & 1) << 5); R = (st >> 1) * 16 + swz / 64; C = (st & 1) * 32 + (swz % 64) / 2; }
struct Unit { int pm, pn; };

struct StaticSched {
    int nM, nN, nwg, G, c; const char* A; const char* Bt; size_t tstep;
    __device__ void init(const bf16_t* A_, const bf16_t* Bt_, int M, int N, int K, int G_, int c_) { nM = M / BM; nN = N / BM; nwg = nM * nN; G = G_; c = c_; A = (const char*)A_; Bt = (const char*)Bt_; tstep = (size_t)BM * K * 2; }
    __device__ bool next(int i, Unit& u) const {
        const long L = (long)i * G + c; if (L >= nwg) return false;
        int wgid = (int)L; { const int q = nwg / NXCD, r = nwg % NXCD, xcd = wgid % NXCD, off = wgid / NXCD; wgid = (xcd < r ? xcd * (q + 1) : r * (q + 1) + (xcd - r) * q) + off; }
        const int nig = WGM * nN, gid = wgid / nig, fm = gid * WGM, gsz = (nM - fm) < WGM ? (nM - fm) : WGM;
        u.pm = fm + ((wgid % nig) % gsz); u.pn = (wgid % nig) / gsz; return true;
    }
    __device__ __forceinline__ const char* a_base(const Unit& u) const { return A + (size_t)u.pm * tstep; }
    __device__ __forceinline__ const char* b_base(const Unit& u) const { return Bt + (size_t)u.pn * tstep; }
};
struct MoeSched {
    int nunits, nN, G, c; const char* A; const char* W; size_t tstep, estride; const int* blk_e;
    __device__ bool next(int i, Unit& u) const {
        long L;
        if ((G & 7) == 0) { const int per = (nunits + 7) >> 3, v = i * (G >> 3) + (c >> 3); if (v >= per) return false; L = (long)(c & 7) * per + v; }
        else L = (long)i * G + c;
        if (L >= nunits) return false; u.pm = (int)(L / nN); u.pn = (int)(L % nN); return true; }
    __device__ __forceinline__ const char* a_base(const Unit& u) const { return A + (size_t)u.pm * tstep; }
    __device__ __forceinline__ const char* b_base(const Unit& u) const { return W + (size_t)blk_e[u.pm] * estride + (size_t)u.pn * tstep; }
};

template <class Epi, class Sched, bool FP8 = false>
__device__ __forceinline__ void gemm_phase(LAS unsigned char* lds, const int K, const Sched& S, const Epi& E, const int wave0) {
    const int lane = lane_id_v(), wid = wave0, tid = wid * 64 + lane, wr = wid >> 2, wc = wid & 3, fr = lane & 15, fq = lane >> 4;
    const int nt = K / BK;
    unsigned voffA[2], voffB[2];
#pragma unroll
    for (int i = 0; i < 2; ++i) { int R, C; stage_rc(tid * 16 + i * 8192, R, C); voffA[i] = (unsigned)(R * K + C) * 2u; voffB[i] = voffA[i]; }
    asm volatile("" : "+v"(voffA[0]), "+v"(voffA[1]), "+v"(voffB[0]), "+v"(voffB[1]));
    const size_t kstep = (size_t)(BK * 2);
    const size_t hstep = (size_t)HALF * K * 2;
    const unsigned ldsw = (unsigned)wid * 1024u;
    const int aoff = lds_byte(wr * 64 + fr, fq * 8), boff = lds_byte(wc * 32 + fr, fq * 8);
#define PG8_SA(b, h) (((b) * 2 + (h)) * HTB)
#define PG8_SB(b, h) ((4 + (b) * 2 + (h)) * HTB)
#define PG8_STAGE(bufoff, gbase, voff) do { _Pragma("unroll") for (int _i = 0; _i < 2; ++_i) \
        __builtin_amdgcn_global_load_lds((const unsigned*)((const char*)(gbase) + (voff)[_i]), (LAS unsigned*)(lds + (bufoff) + ldsw + _i * 8192), 16, 0, 0); } while (0)
#define PG8_LD1(d2, d8, i, p_) do { if (FP8) { const i32x4_ lo_ = *(const LAS i32x4_*)(p_), hi_ = *(const LAS i32x4_*)((p_) + 1024); d8[i] = __builtin_shufflevector(lo_, hi_, 0, 1, 2, 3, 4, 5, 6, 7); } \
        else { d2[i][0] = *(const LAS bf16x8*)(p_); d2[i][1] = *(const LAS bf16x8*)((p_) + 1024); } } while (0)
#define PG8_LDA(dst, b, h) do { _Pragma("unroll") for (int m = 0; m < 4; ++m) PG8_LD1(dst, dst##8, m, lds + PG8_SA(b, h) + aoff + m * 2048); } while (0)
#define PG8_LDB(dst, b, h) do { _Pragma("unroll") for (int n = 0; n < 2; ++n) PG8_LD1(dst, dst##8, n, lds + PG8_SB(b, h) + boff + n * 2048); } while (0)
#define PG8_MMA(ai, bj, At, Bt) do { __builtin_amdgcn_s_setprio(1); _Pragma("unroll") for (int m = 0; m < 4; ++m) _Pragma("unroll") for (int n = 0; n < 2; ++n) { \
        if (FP8) asm volatile("v_mfma_scale_f32_16x16x128_f8f6f4 %0, %1, %2, %0, %3, %3 op_sel_hi:[0,0,0]" : "+v"(acc[ai][bj][m][n]) : "v"(Bt##8[n]), "v"(At##8[m]), "v"(scl1));   \
        else { _Pragma("unroll") for (int k = 0; k < 2; ++k) acc[ai][bj][m][n] = __builtin_amdgcn_mfma_f32_16x16x32_bf16(Bt[n][k], At[m][k], acc[ai][bj][m][n], 0, 0, 0); } } __builtin_amdgcn_s_setprio(0); } while (0)
#define PG8_WAIT_V(n) asm volatile("s_waitcnt vmcnt(" #n ")" ::: "memory")
#define PG8_WAIT_L(n) asm volatile("s_waitcnt lgkmcnt(" #n ")" ::: "memory")
#define PG8_BAR __builtin_amdgcn_s_barrier()
#define PG8_SCHED __builtin_amdgcn_sched_barrier(0)
    Unit cur, nxt; int ui = 0;
    if (!S.next(0, cur)) return;
    int scl1 = 0x7F7F7F7F; asm volatile("" : "+v"(scl1));
    f32x4 acc[2][2][4][2];
#pragma unroll
    for (int a = 0; a < 2; ++a)
#pragma unroll
        for (int b = 0; b < 2; ++b)
#pragma unroll
            for (int m = 0; m < 4; ++m)
#pragma unroll
                for (int n = 0; n < 2; ++n) acc[a][b][m][n] = (f32x4){0.f, 0.f, 0.f, 0.f};
    bf16x8 At[4][2], B0[2][2], B1[2][2]; i32x8_ At8[4], B08[2], B18[2];
    const char* cA = S.a_base(cur); const char* cB = S.b_base(cur);
    PG8_STAGE(PG8_SB(0, 0), cB, voffB); PG8_STAGE(PG8_SA(0, 0), cA, voffA); PG8_STAGE(PG8_SB(0, 1), cB + hstep, voffB); PG8_STAGE(PG8_SA(0, 1), cA + hstep, voffA);
    if (wr == 1) PG8_BAR;
    PG8_WAIT_V(4); PG8_BAR;
    PG8_STAGE(PG8_SB(1, 0), cB + kstep, voffB); PG8_STAGE(PG8_SA(1, 0), cA + kstep, voffA); PG8_STAGE(PG8_SB(1, 1), cB + hstep + kstep, voffB);
    PG8_WAIT_V(6); PG8_BAR;
    for (;;) {
        const bool has_next = S.next(ui + 1, nxt);
        const char* nA = has_next ? S.a_base(nxt) : cA; const char* nB = has_next ? S.b_base(nxt) : cB;
        for (int t = 0; t < nt; t += 2) {
            const bool last = (t == nt - 2);
            const char* a1 = cA + (size_t)(t + 1) * kstep;
            const char* a2 = last ? nA : cA + (size_t)(t + 2) * kstep; const char* b2 = last ? nB : cB + (size_t)(t + 2) * kstep;
            const char* a3 = a2 + kstep; const char* b3 = b2 + kstep;
            PG8_LDB(B0, 0, 0); PG8_SCHED; PG8_LDA(At, 0, 0); PG8_STAGE(PG8_SA(1, 1), a1 + hstep, voffA);
            PG8_WAIT_L(8); PG8_BAR; PG8_WAIT_L(0); PG8_MMA(0, 0, At, B0); PG8_BAR; PG8_SCHED;
            PG8_LDB(B1, 0, 1); PG8_STAGE(PG8_SB(0, 0), b2, voffB);
            PG8_BAR; PG8_WAIT_L(0); PG8_MMA(0, 1, At, B1); PG8_BAR;
            PG8_LDA(At, 0, 1); PG8_STAGE(PG8_SA(0, 0), a2, voffA);
            PG8_BAR; PG8_WAIT_L(0); PG8_MMA(1, 0, At, B0); PG8_BAR; PG8_SCHED;
            PG8_STAGE(PG8_SB(0, 1), b2 + hstep, voffB);
            PG8_WAIT_V(6); PG8_BAR; PG8_MMA(1, 1, At, B1); PG8_BAR;
            PG8_LDB(B0, 1, 0); PG8_SCHED; PG8_LDA(At, 1, 0); PG8_STAGE(PG8_SA(0, 1), a2 + hstep, voffA);
            PG8_WAIT_L(8); PG8_BAR; PG8_WAIT_L(0); PG8_MMA(0, 0, At, B0); PG8_BAR; PG8_SCHED;
            PG8_LDB(B1, 1, 1); PG8_STAGE(PG8_SB(1, 0), b3, voffB);
            PG8_BAR; PG8_WAIT_L(0); PG8_MMA(0, 1, At, B1); PG8_BAR;
            PG8_LDA(At, 1, 1); PG8_STAGE(PG8_SA(1, 0), a3, voffA);
            PG8_BAR; PG8_WAIT_L(0); PG8_MMA(1, 0, At, B0); PG8_BAR; PG8_SCHED;
            PG8_STAGE(PG8_SB(1, 1), b3 + hstep, voffB);
            PG8_WAIT_V(6); PG8_BAR; PG8_MMA(1, 1, At, B1); PG8_BAR;
        }
        if (FP8) asm volatile("s_nop 15\n\ts_nop 3" ::: "memory");
        E(acc, cur, wr, wc, fr, fq);
        if (!has_next) break;
#pragma unroll
        for (int a = 0; a < 2; ++a)
#pragma unroll
            for (int b = 0; b < 2; ++b)
#pragma unroll
                for (int m = 0; m < 4; ++m)
#pragma unroll
                    for (int n = 0; n < 2; ++n) acc[a][b][m][n] = (f32x4){0.f, 0.f, 0.f, 0.f};
        cur = nxt; cA = nA; cB = nB; ++ui;
    }
    PG8_WAIT_V(0);
    if (wr == 0) PG8_BAR;
    PG8_BAR;
#undef PG8_SA
#undef PG8_SB
#undef PG8_STAGE
#undef PG8_LDA
#undef PG8_LD1
#undef PG8_LDB
#undef PG8_MMA
#undef PG8_WAIT_V
#undef PG8_WAIT_L
#undef PG8_BAR
#undef PG8_SCHED
}
}

struct EpiP {
    float* C;
    __device__ __forceinline__ void operator()(const f32x4 (&acc)[2][2][4][2], const pg8::Unit& u, int wr, int wc, int fr, int fq) const {
        const int row0 = u.pm * 256 + wr * 64 + fr, col0 = u.pn * 256 + wc * 32 + 4 * fq;
#pragma unroll
        for (int ai = 0; ai < 2; ++ai)
#pragma unroll
            for (int m = 0; m < 4; ++m) { float* rowp = C + (size_t)(row0 + ai * 128 + m * 16) * INP + col0;
#pragma unroll
                for (int bj = 0; bj < 2; ++bj)
#pragma unroll
                    for (int n = 0; n < 2; ++n) *(f32x4*)(rowp + bj * 128 + n * 16) = acc[ai][bj][m][n]; }
    }
};
struct EpiOut {
    const float* xl; const float* xc; float* xo; const float* gate;
    __device__ __forceinline__ void operator()(const f32x4 (&acc)[2][2][4][2], const pg8::Unit& u, int wr, int wc, int fr, int fq) const {
        const bool lat = u.pm < 64; const int bi = lat ? (u.pm >> 4) : 4;
        const float* xin = lat ? xl + (size_t)u.pm * 256 * D : xc + (size_t)(u.pm - 64) * 256 * D;
        float* xop = xo + (size_t)u.pm * 256 * D;
        const int r0 = wr * 64 + fr, c0 = u.pn * 256 + wc * 32 + 4 * fq;
        f32x4 gv[2][2];
#pragma unroll
        for (int bj = 0; bj < 2; ++bj)
#pragma unroll
            for (int n = 0; n < 2; ++n) gv[bj][n] = *(const f32x4*)(gate + (size_t)bi * 6144 + c0 + bj * 128 + n * 16);
#pragma unroll
        for (int ai = 0; ai < 2; ++ai)
#pragma unroll
            for (int m = 0; m < 4; ++m) { const size_t ro = (size_t)(r0 + ai * 128 + m * 16) * D + c0;
#pragma unroll
                for (int bj = 0; bj < 2; ++bj)
#pragma unroll
                    for (int n = 0; n < 2; ++n) { const f32x4 xv = *(const f32x4*)(xin + ro + bj * 128 + n * 16);
                        *(f32x4*)(xop + ro + bj * 128 + n * 16) = xv + gv[bj][n] * acc[ai][bj][m][n]; } }
    }
};
struct EpiGU {
    unsigned char* act; const float* bias; const int* blk_e;
    __device__ __forceinline__ void operator()(const f32x4 (&acc)[2][2][4][2], const pg8::Unit& u, int wr, int wc, int fr, int fq) const {
        const int e = blk_e[u.pm];
        const float* bg = bias + (size_t)e * 2048 + u.pn * 128 + wc * 32 + 4 * fq;
        f32x4 bgv[2], buv[2];
#pragma unroll
        for (int n = 0; n < 2; ++n) { bgv[n] = *(const f32x4*)(bg + n * 16); buv[n] = *(const f32x4*)(bg + 1024 + n * 16); }
#pragma unroll
        for (int ai = 0; ai < 2; ++ai)
#pragma unroll
            for (int m = 0; m < 4; ++m) { unsigned char* rowp = act + (size_t)(u.pm * 256 + ai * 128 + wr * 64 + m * 16 + fr) * DFF + u.pn * 128 + wc * 32 + 4 * fq;
#pragma unroll
                for (int n = 0; n < 2; ++n) { const f32x4 g = acc[ai][0][m][n] * 0.03125f + bgv[n], uu = acc[ai][1][m][n] * 0.03125f + buv[n]; float o[4];
#pragma unroll
                    for (int i = 0; i < 4; ++i) { const float g_ = fminf(g[i], 7.f), u_ = fminf(fmaxf(uu[i], -7.f), 7.f); o[i] = g_ * sigm(1.702f * g_) * (u_ + 1.f); }
                    *(unsigned*)(rowp + n * 16) = pk8(o[0], o[1], o[2], o[3]); } }
    }
};
struct EpiDown {
    bf16_t* Y; const float* bias; const int* blk_e;
    __device__ __forceinline__ void operator()(const f32x4 (&acc)[2][2][4][2], const pg8::Unit& u, int wr, int wc, int fr, int fq) const {
        const int e = blk_e[u.pm];
        const int row0 = u.pm * 256 + wr * 64 + fr, col0 = u.pn * 256 + wc * 32 + 4 * fq;
        f32x4 bv[2][2];
#pragma unroll
        for (int bj = 0; bj < 2; ++bj)
#pragma unroll
            for (int n = 0; n < 2; ++n) bv[bj][n] = *(const f32x4*)(bias + (size_t)e * D + col0 + bj * 128 + n * 16);
#pragma unroll
        for (int ai = 0; ai < 2; ++ai)
#pragma unroll
            for (int m = 0; m < 4; ++m) { bf16_t* rowp = Y + (size_t)(row0 + ai * 128 + m * 16) * D + col0;
#pragma unroll
                for (int bj = 0; bj < 2; ++bj)
#pragma unroll
                    for (int n = 0; n < 2; ++n) { const f32x4 v = acc[ai][bj][m][n] * 0.03125f + bv[bj][n]; u32x2 pk; pk.x = pk2(v.x, v.y); pk.y = pk2(v.z, v.w); *(u32x2*)(rowp + bj * 128 + n * 16) = pk; } }
    }
};

template <int MODE, bool FP8 = false>
__device__ __forceinline__ void transpose_item(const float* W, int ldn, int nvalid, bf16_t* WT, LAS float* scr, int kb, int nb, int lane) {
    const int k0 = 64 * kb, n0 = 32 * nb;
    const int nn = n0 + (lane & 31); const bool ok = nn < nvalid;
#pragma unroll 8
    for (int i = 0; i < 32; ++i) { const int kk = 2 * i + (lane >> 5); scr[kk * 33 + (lane & 31)] = ok ? __builtin_nontemporal_load(W + (size_t)(k0 + kk) * ldn + nn) : 0.f; }
    LDS_WAIT(); asm volatile("" ::: "memory");
    const int c = lane & 7;
#pragma unroll
    for (int j = 0; j < 4; ++j) { const int n = (lane >> 3) + 8 * j; const LAS float* s = scr + (8 * c) * 33 + n;
        int gn = n0 + n, drow = gn;
        if (MODE == 1) drow = (gn < 1024) ? ((gn >> 7) * 256 + (gn & 127)) : (((gn - 1024) >> 7) * 256 + 128 + ((gn - 1024) & 127));
        if (FP8) { u32x2 o; o.x = pk8(32.f * s[0 * 33], 32.f * s[1 * 33], 32.f * s[2 * 33], 32.f * s[3 * 33]); o.y = pk8(32.f * s[4 * 33], 32.f * s[5 * 33], 32.f * s[6 * 33], 32.f * s[7 * 33]);
            *(u32x2*)((unsigned char*)WT + (size_t)drow * 1024 + k0 + 8 * c) = o; }
        else { u32x4 o; o.x = pk2(s[0 * 33], s[1 * 33]); o.y = pk2(s[2 * 33], s[3 * 33]); o.z = pk2(s[4 * 33], s[5 * 33]); o.w = pk2(s[6 * 33], s[7 * 33]);
            *(u32x4*)(WT + (size_t)drow * 1024 + k0 + 8 * c) = o; } }
    LDS_WAIT(); asm volatile("" ::: "memory");
}
__device__ __forceinline__ void phase_prep(const Args& a, LAS unsigned char* lds, int tid, int lane, int wave, int bid, int G) {
    LAS float* scr = (LAS float*)(lds + wave * 16384);
    const int gw = bid * 8 + wave, NGW = G * 8;
    constexpr int I_IN = 16 * 136, I_OUT = 16 * 32, I_GU = 16 * 64, I_D = 16 * 32;
    constexpr int N_IN = 2 * I_IN, N_OUT = 2 * I_OUT, N_GU = 64 * I_GU, N_D = 64 * I_D, NITEMS = N_IN + N_OUT + N_GU + N_D;
    bf16_t* WinT = (bf16_t*)(a.ws + WS_WIN); bf16_t* WoutT = (bf16_t*)(a.ws + WS_WOUT); bf16_t* WguT = (bf16_t*)(a.ws + WS_WGU); bf16_t* WdT = (bf16_t*)(a.ws + WS_WD);
    for (int it = gw; it < NITEMS; it += NGW) {
        int r = it;
        if (r < N_IN) { const int l = r / I_IN, q = r % I_IN; transpose_item<0>(a.in[8] + (size_t)l * 1024 * INC, INC, INC, WinT + (size_t)l * INP * 1024, scr, q / 136, q % 136, lane); continue; } r -= N_IN;
        if (r < N_OUT) { const int l = r / I_OUT, q = r % I_OUT; transpose_item<0>(a.in[9] + (size_t)l * 1024 * 1024, 1024, 1024, WoutT + (size_t)l * 1024 * 1024, scr, q / 32, q % 32, lane); continue; } r -= N_OUT;
        if (r < N_GU) { const int le = r / I_GU, q = r % I_GU; transpose_item<1, true>(a.in[33] + (size_t)le * 1024 * 2048, 2048, 2048, WguT + (size_t)le * 2048 * 512, scr, q / 64, q % 64, lane); continue; } r -= N_GU;
        { const int le = r / I_D, q = r % I_D; transpose_item<0, true>(a.in[35] + (size_t)le * 1024 * 1024, 1024, 1024, WdT + (size_t)le * 1024 * 512, scr, q / 32, q % 32, lane); }
    }
    __syncthreads();
    LAS float* sv = (LAS float*)lds; LAS float* red = sv + 5 * 1024;
    for (int i = tid; i < 5 * 1024; i += 512) { const int r = i >> 10, k = i & 1023; const float cv = (r < 4) ? a.in[1][r * 1024 + k] : a.in[3][k]; sv[i] = siluf(cv); }
    __syncthreads();
    float* mod = (float*)(a.ws + WS_MOD);
    for (int grp = bid; grp < 768; grp += G) {
        const int l = grp / 384, j0 = (grp % 384) * 16, col = tid & 15, ks = tid >> 4;
        const float* w = a.in[4] + (size_t)l * 1024 * 6144 + j0 + col;
        float a0 = 0.f, a1 = 0.f, a2 = 0.f, a3 = 0.f, a4 = 0.f;
#pragma unroll 8
        for (int kk = 0; kk < 32; ++kk) { const int k = ks * 32 + kk; const float wv = w[(size_t)k * 6144];
            a0 += sv[k] * wv; a1 += sv[1024 + k] * wv; a2 += sv[2048 + k] * wv; a3 += sv[3072 + k] * wv; a4 += sv[4096 + k] * wv; }
        LAS float* rp = red + (ks * 16 + col) * 5; rp[0] = a0; rp[1] = a1; rp[2] = a2; rp[3] = a3; rp[4] = a4;
        __syncthreads();
        if (tid < 80) { const int c = tid / 5, r = tid % 5; float s = 0.f;
            for (int q = 0; q < 32; ++q) s += red[(q * 16 + c) * 5 + r];
            mod[(size_t)(l * 5 + r) * 6144 + j0 + c] = s + a.in[5][l * 6144 + j0 + c]; }
        __syncthreads();
    }
    bf16_t* LW = (bf16_t*)(a.ws + WS_LORA);
    for (int i = bid * 512 + tid; i < 2 * 81920; i += G * 512) {
        const int l = i / 81920, r = i % 81920;
        if (r < 16384) { const int q = r >> 8, c = r & 255; LW[(size_t)l * 81920 + c * 64 + q] = (bf16_t)f2bf(a.in[24][(size_t)l * 16384 + r]); }
        else if (r < 49152) { const int r2 = r - 16384, dj = r2 >> 14, q = (r2 >> 8) & 63, c = r2 & 255; LW[(size_t)l * 81920 + 16384 + dj * 16384 + c * 64 + q] = (bf16_t)f2bf(a.in[22][(size_t)l * 32768 + r2]); }
        else { const int r2 = r - 49152, q = r2 >> 8, c = r2 & 255; LW[(size_t)l * 81920 + 49152 + c * 128 + q] = (bf16_t)f2bf(a.in[25][(size_t)l * 32768 + r2]); }
    }
}

template <bool FP8 = false>
__device__ __forceinline__ void norm_mod_store(f32x4 (&v)[4], const float* nw, const float* shift, const float* scale, bf16_t* hrow, int lane) {
    float ss = 0.f;
#pragma unroll
    for (int j = 0; j < 4; ++j) ss += (v[j].x * v[j].x + v[j].y * v[j].y) + (v[j].z * v[j].z + v[j].w * v[j].w);
    const float r = frsq(wave_sum(ss) * (1.f / D) + 1e-6f);
#pragma unroll
    for (int j = 0; j < 4; ++j) { const int c = j * 256 + lane * 4;
        const f32x4 w4 = *(const f32x4*)(nw + c), sh = *(const f32x4*)(shift + c), sc = *(const f32x4*)(scale + c);
        v[j] = (v[j] * r * w4) * (sc + 1.f) + sh;
        if (FP8) *(unsigned*)((unsigned char*)hrow + c) = pk8(v[j].x, v[j].y, v[j].z, v[j].w);
        else { u32x2 pk; pk.x = pk2(v[j].x, v[j].y); pk.y = pk2(v[j].z, v[j].w); *(u32x2*)(hrow + c) = pk; } }
}
__device__ __forceinline__ void phase_norm1(const Args& a, int L, const float* xl, const float* xc, int lane, int wave, int bid, int G) {
    const float* mod = (const float*)(a.ws + WS_MOD) + (size_t)L * 5 * 6144;
    bf16_t* Hn = (bf16_t*)(a.ws + WS_HN);
    for (int row = bid * 8 + wave; row < MALL; row += G * 8) {
        const float* xr = row < NL ? xl + (size_t)row * D : xc + (size_t)(row - NL) * D;
        const int bi = row < NL ? (row >> 12) : 4;
        f32x4 v[4];
#pragma unroll
        for (int j = 0; j < 4; ++j) v[j] = *(const f32x4*)(xr + j * 256 + lane * 4);
        norm_mod_store(v, a.in[6] + L * D, mod + (size_t)bi * 6144, mod + (size_t)bi * 6144 + 1024, Hn + (size_t)row * D, lane);
    }
}

__device__ __forceinline__ void phase_mixprep(const Args& a, int L, LAS unsigned char* lds, int lane_, int wave, int bid, int G) {
    const float* P = (const float*)(a.ws + WS_P);
    const int gw = bid * 8 + wave, NGW = G * 8;
    for (int rp_ = 0; rp_ < 1 + ((PROBE_MIX >> 0) & 1); ++rp_) if (MIXPARTS & 1) {
        float* MX = (float*)(a.ws + WS_MXBC); float* MD = (float*)(a.ws + WS_MDT);
        const float* cw = a.in[10] + (size_t)L * 3 * 768; const float* cb = a.in[11] + (size_t)L * 768;
        float w0[12], w1[12], w2[12], wb[12];
#pragma unroll
        for (int j = 0; j < 12; ++j) { const int c = j * 64 + lane_; w0[j] = cw[c]; w1[j] = cw[768 + c]; w2[j] = cw[1536 + c]; wb[j] = cb[c]; }
        const float dtb = lane_ < 8 ? a.in[12][L * 8 + lane_] : 0.f, aneg = lane_ < 8 ? -__expf(a.in[13][L * 8 + lane_]) : 0.f;
        for (int row = gw; row < MALL; row += NGW) {
            const int lane = opq(lane_);
            int t, len; if (row < NL) { t = row & 4095; len = 4096; } else { t = (row - NL) & 255; len = 256; }
            const bool hp = t > 0, hn = t < len - 1;
            const float* p1 = P + (size_t)row * INP + 256 + lane;
            float x0[12], x1[12], x2[12];
#pragma unroll
            for (int j = 0; j < 12; ++j) { x0[j] = hp ? p1[j * 64 - INP] : 0.f; x1[j] = p1[j * 64]; x2[j] = hn ? p1[j * 64 + INP] : 0.f; }
            const float draw = lane < 8 ? P[(size_t)row * INP + 1024 + lane] : 0.f;
#pragma unroll
            for (int j = 0; j < 12; ++j) MX[(size_t)row * 768 + j * 64 + lane] = siluf(w0[j] * x0[j] + w1[j] * x1[j] + w2[j] * x2[j] + wb[j]);
            if (lane < 8) { const float dt = softplusf(draw + dtb); MD[(size_t)row * 16 + lane] = dt; MD[(size_t)row * 16 + 8 + lane] = dt * aneg; }
        }
    }
    for (int rp_ = 0; rp_ < 1 + ((PROBE_MIX >> 1) & 1); ++rp_) if (MIXPARTS & 2) {
        bf16_t* DQ = (bf16_t*)(a.ws + WS_DNQKV); float* DG = (float*)(a.ws + WS_DNGB);
        const float* cw = a.in[16] + (size_t)L * 3 * 1536;
#define DN_ROWS(dr) size_t r0, r1, r2; bool hp, hn; \
            if (dr < NL) { const int b = dr >> 12, pos = dr & 4095; hp = pos > 0; hn = pos < 4095; const int pp = pos - 1, pn = pos + 1; \
                r1 = (size_t)b * 4096 + ((pos & 63) * 64 + (pos >> 6)); r0 = (size_t)b * 4096 + ((pp & 63) * 64 + ((pp >> 6) & 63)); r2 = (size_t)b * 4096 + ((pn & 63) * 64 + ((pn >> 6) & 63)); } \
            else { const int t = (dr - NL) & 255; hp = t > 0; hn = t < 255; r1 = dr; r0 = dr - 1; r2 = dr + 1; }
        {
            float w0[16], w1[16], w2[16];
#pragma unroll
            for (int j = 0; j < 16; ++j) { const int c = j * 64 + lane_; w0[j] = cw[c]; w1[j] = cw[1536 + c]; w2[j] = cw[3072 + c]; }
            const float dtb = lane_ < 8 ? a.in[17][L * 8 + lane_] : 0.f, apos = lane_ < 8 ? __expf(a.in[18][L * 8 + lane_]) : 0.f;
            for (int dr = gw; dr < MALL; dr += NGW) {
                const int lane = opq(lane_);
                DN_ROWS(dr)
                const float* q0 = P + r0 * INP + DN_OFF + lane; const float* q1 = P + r1 * INP + DN_OFF + lane; const float* q2 = P + r2 * INP + DN_OFF + lane;
                float x0[16], x1[16], x2[16];
#pragma unroll
                for (int j = 0; j < 16; ++j) { x0[j] = hp ? q0[j * 64] : 0.f; x1[j] = q1[j * 64]; x2[j] = hn ? q2[j * 64] : 0.f; }
                const float braw = lane < 8 ? q1[2048] : 0.f, araw = lane < 8 ? q1[2056] : 0.f;
                float v[16];
#pragma unroll
                for (int j = 0; j < 16; ++j) v[j] = siluf(w0[j] * x0[j] + w1[j] * x1[j] + w2[j] * x2[j]);
                float qk[4];
#pragma unroll
                for (int h = 0; h < 4; ++h) {
                    const float sq = wave_sum(v[2 * h] * v[2 * h] + v[2 * h + 1] * v[2 * h + 1]);
                    const float sk = wave_sum(v[8 + 2 * h] * v[8 + 2 * h] + v[8 + 2 * h + 1] * v[8 + 2 * h + 1]);
                    const float rq = frsq(sq + 1e-6f) * 0.08838834764831845f, rk = frsq(sk + 1e-6f);
                    v[2 * h] *= rq; v[2 * h + 1] *= rq; v[8 + 2 * h] *= rk; v[8 + 2 * h + 1] *= rk;
                    qk[h] = wave_sum(v[2 * h] * v[8 + 2 * h] + v[2 * h + 1] * v[8 + 2 * h + 1]);
                }
#pragma unroll
                for (int j = 0; j < 16; ++j) DQ[(size_t)dr * 1536 + j * 64 + lane] = (bf16_t)f2bf(v[j]);
                if (lane < 8) { const float beta = sigm(braw); const float g = -apos * softplusf(araw + dtb);
                    DG[(size_t)dr * 32 + lane] = beta; DG[(size_t)dr * 32 + 8 + lane] = __expf(g); DG[(size_t)dr * 32 + 16 + lane] = g; }
                if (lane < 4) { const float s = lane == 0 ? qk[0] : lane == 1 ? qk[1] : lane == 2 ? qk[2] : qk[3]; DG[(size_t)dr * 32 + 24 + lane] = s; }
            }
        }
        {
            float w0[8], w1[8], w2[8];
#pragma unroll
            for (int j = 0; j < 8; ++j) { const int c = 1024 + j * 64 + lane_; w0[j] = cw[c]; w1[j] = cw[1536 + c]; w2[j] = cw[3072 + c]; }
            for (int dr = gw; dr < MALL; dr += NGW) {
                const int lane = opq(lane_);
                DN_ROWS(dr)
                const float* q0 = P + r0 * INP + DN_OFF + 1024 + lane; const float* q1 = P + r1 * INP + DN_OFF + 1024 + lane; const float* q2 = P + r2 * INP + DN_OFF + 1024 + lane;
                float x0[8], x1[8], x2[8];
#pragma unroll
                for (int j = 0; j < 8; ++j) { x0[j] = hp ? q0[j * 64] : 0.f; x1[j] = q1[j * 64]; x2[j] = hn ? q2[j * 64] : 0.f; }
#pragma unroll
                for (int j = 0; j < 8; ++j) DQ[(size_t)dr * 1536 + 1024 + j * 64 + lane] = (bf16_t)f2bf(siluf(w0[j] * x0[j] + w1[j] * x1[j] + w2[j] * x2[j]));
            }
        }
#undef DN_ROWS
    }
    for (int rp_ = 0; rp_ < 1 + ((PROBE_MIX >> 2) & 1); ++rp_) if (MIXPARTS & 4) {
        bf16_t* RW = (bf16_t*)(a.ws + WS_RW); float* RWW = (float*)(a.ws + WS_RWW); float* RG = (float*)(a.ws + WS_RWG);
        const bf16_t* LW = (const bf16_t*)(a.ws + WS_LORA) + (size_t)L * 81920;
        LAS float* KS = (LAS float*)lds;
        LAS bf16_t* INB = (LAS bf16_t*)(lds + 16640);
        const int hh = wave >> 1, half = wave & 1, tokn = lane_ & 15, g4 = lane_ >> 4;
        float mu[17];
#pragma unroll
        for (int j = 0; j < 17; ++j) mu[j] = a.in[20][(size_t)L * 1088 + j * 64 + lane_];
        bf16x8 fa[4][2], fb[4][4];
        {
            const bf16_t* m0 = half == 0 ? LW : LW + 16384 + 16384;
#pragma unroll
            for (int ct = 0; ct < 4; ++ct)
#pragma unroll
                for (int kb = 0; kb < 2; ++kb) fa[ct][kb] = *(const bf16x8*)(m0 + (size_t)(hh * 64 + ct * 16 + tokn) * 64 + kb * 32 + g4 * 8);
            if (half == 0) {
#pragma unroll
                for (int ct = 0; ct < 4; ++ct)
#pragma unroll
                    for (int kb = 0; kb < 4; ++kb) fb[ct][kb] = *(const bf16x8*)(LW + 16384 + (size_t)(hh * 64 + ct * 16 + tokn) * 64 + (kb & 1) * 32 + g4 * 8);
            } else {
#pragma unroll
                for (int ct = 0; ct < 4; ++ct)
#pragma unroll
                    for (int kb = 0; kb < 4; ++kb) fb[ct][kb] = *(const bf16x8*)(LW + 49152 + (size_t)(hh * 64 + ct * 16 + tokn) * 128 + kb * 32 + g4 * 8);
            }
        }
        __syncthreads();
        for (int ti = bid; ti < MALL / 16; ti += G) {
            const int lane = opq(lane_);
#pragma unroll
            for (int t2 = 0; t2 < 2; ++t2) {
                const int tk = wave * 2 + t2, row = ti * 16 + tk; int nb; bool ok;
                if (row < NL) { const int t = row & 4095, gr = t >> 6, gc = t & 63, sel = lane & 3;
                    nb = sel == 0 ? -1 : sel == 1 ? 1 : sel == 2 ? -64 : 64; ok = sel == 0 ? gc > 0 : sel == 1 ? gc < 63 : sel == 2 ? gr > 0 : gr < 63; }
                else { const int t = (row - NL) & 255; nb = (lane & 1) ? 1 : -1; ok = (lane & 1) ? t < 255 : t > 0; }
                const float* p = P + (size_t)row * INP + RW_OFF + lane; const float* ps = p + (long)nb * INP;
                bf16_t* o = RW + (size_t)row * 1280 + lane;
                float xv[17], sv[17];
#pragma unroll
                for (int j = 0; j < 17; ++j) { xv[j] = p[j * 64]; sv[j] = ok ? ps[j * 64] : 0.f; }
#pragma unroll
                for (int j = 0; j < 17; ++j) { const float m = xv[j] + (sv[j] - xv[j]) * mu[j];
                    if (j < 4) o[j * 64] = (bf16_t)f2bf(m); else if (j < 8) KS[tk * 260 + (j - 4) * 64 + lane] = m; else if (j < 12) o[j * 64] = (bf16_t)f2bf(m);
                    else if (j < 14) INB[tk * 328 + (j - 12) * 64 + lane] = (bf16_t)f2bf(tanh_fast(m)); else if (j < 15) INB[tk * 328 + 128 + lane] = (bf16_t)f2bf(m);
                    else INB[tk * 328 + 192 + (j - 15) * 64 + lane] = (bf16_t)f2bf(sigm(m)); }
            }
            __syncthreads();
            {
                const size_t row = (size_t)ti * 16 + tokn;
                const int ch0 = hh * 64 + g4 * 4;
                const LAS bf16_t* ib = INB + tokn * 328 + g4 * 8;
                f32x4 accA[4], accB[4];
#pragma unroll
                for (int ct = 0; ct < 4; ++ct) { accA[ct] = (f32x4){0.f, 0.f, 0.f, 0.f}; accB[ct] = accA[ct]; }
                if (half == 0) {
                    bf16x8 bi[2], bw[2];
#pragma unroll
                    for (int kb = 0; kb < 2; ++kb) { bi[kb] = *(const LAS bf16x8*)(ib + 128 + kb * 32); bw[kb] = *(const LAS bf16x8*)(ib + kb * 32); }
#pragma unroll
                    for (int ct = 0; ct < 4; ++ct)
#pragma unroll
                        for (int kb = 0; kb < 2; ++kb) { accA[ct] = __builtin_amdgcn_mfma_f32_16x16x32_bf16(fa[ct][kb], bi[kb], accA[ct], 0, 0, 0); accB[ct] = __builtin_amdgcn_mfma_f32_16x16x32_bf16(fb[ct][kb], bw[kb], accB[ct], 0, 0, 0); }
                    f32x4 kx[4], kn[4]; float ss = 0.f;
#pragma unroll
                    for (int ct = 0; ct < 4; ++ct) { kx[ct] = *(const LAS f32x4*)(KS + tokn * 260 + ch0 + ct * 16);
                        kn[ct] = kx[ct] * *(const f32x4*)(a.in[26] + L * 256 + ch0 + ct * 16); ss += (kn[ct].x * kn[ct].x + kn[ct].y * kn[ct].y) + (kn[ct].z * kn[ct].z + kn[ct].w * kn[ct].w); }
                    { float u = ss, v = ss; pswap16(u, v); ss = u + v; u = ss; v = ss; pswap32(u, v); ss = u + v; }
                    const float rn = frsq(ss + 1e-6f);
                    bf16_t* o = RW + row * 1280 + ch0; float* ow = RWW + row * 512 + ch0;
#pragma unroll
                    for (int ct = 0; ct < 4; ++ct) { const f32x4 a0v = *(const f32x4*)(a.in[23] + L * 256 + ch0 + ct * 16), kav = *(const f32x4*)(a.in[27] + L * 256 + ch0 + ct * 16), w0v = *(const f32x4*)(a.in[21] + L * 512 + ch0 + ct * 16);
                        f32x4 av, km, wv;
#pragma unroll
                        for (int i = 0; i < 4; ++i) { av[i] = sigm(a0v[i] + accA[ct][i]); km[i] = kx[ct][i] * (1.f + (av[i] - 1.f) * kav[i]); wv[i] = __expf(-__expf(-softplusf(-(w0v[i] + accB[ct][i])) - 0.5f)); }
                        const f32x4 knn = kn[ct] * rn;
                        const f32x4 bb = knn * av; u32x2 pk;
                        pk.x = cvt2(km.x, km.y); pk.y = cvt2(km.z, km.w); *(u32x2*)(o + 256 + ct * 16) = pk;
                        pk.x = cvt2(-knn.x, -knn.y); pk.y = cvt2(-knn.z, -knn.w); *(u32x2*)(o + 768 + ct * 16) = pk;
                        pk.x = cvt2(bb.x, bb.y); pk.y = cvt2(bb.z, bb.w); *(u32x2*)(o + 1024 + ct * 16) = pk;
                        *(f32x4*)(ow + ct * 16) = wv; }
                } else {
                    bf16x8 bw[2], bg[4];
#pragma unroll
                    for (int kb = 0; kb < 2; ++kb) bw[kb] = *(const LAS bf16x8*)(ib + 64 + kb * 32);
#pragma unroll
                    for (int kb = 0; kb < 4; ++kb) bg[kb] = *(const LAS bf16x8*)(ib + 192 + kb * 32);
#pragma unroll
                    for (int ct = 0; ct < 4; ++ct) {
#pragma unroll
                        for (int kb = 0; kb < 2; ++kb) accA[ct] = __builtin_amdgcn_mfma_f32_16x16x32_bf16(fa[ct][kb], bw[kb], accA[ct], 0, 0, 0);
#pragma unroll
                        for (int kb = 0; kb < 4; ++kb) accB[ct] = __builtin_amdgcn_mfma_f32_16x16x32_bf16(fb[ct][kb], bg[kb], accB[ct], 0, 0, 0); }
                    float* o = RWW + row * 512 + 256 + ch0; float* og = RG + row * 256 + ch0;
#pragma unroll
                    for (int ct = 0; ct < 4; ++ct) { const f32x4 w0v = *(const f32x4*)(a.in[21] + L * 512 + 256 + ch0 + ct * 16); f32x4 wv;
#pragma unroll
                        for (int i = 0; i < 4; ++i) wv[i] = __expf(-__expf(-softplusf(-(w0v[i] + accA[ct][i])) - 0.5f));
                        *(f32x4*)(o + ct * 16) = wv; *(f32x4*)(og + ct * 16) = accB[ct]; }
                }
            }
            __syncthreads();
        }
    }
}

__device__ __forceinline__ int seqrow(int b, int dir, int s) {
    if (s < 256) return NL + b * 256 + (dir ? 255 - s : s);
    const int p = s - 256; return b * 4096 + (dir ? 4095 - p : p);
}
template <int CTRL> __device__ __forceinline__ float dppz(float v) { return __builtin_bit_cast(float, __builtin_amdgcn_update_dpp(0, __builtin_bit_cast(int, v), CTRL, 0xF, 0xF, true)); }
__device__ __forceinline__ void phase_dnpre(const Args& a, LAS unsigned char* lds, int lane_, int wave, int bid, int G) {
    const bf16_t* DQ = (const bf16_t*)(a.ws + WS_DNQKV); const float* DG = (const float*)(a.ws + WS_DNGB);
    LAS float* sc = (LAS float*)(lds + wave * 13312);
    LAS unsigned char* stg = (LAS unsigned char*)(sc + 576);
    for (int u = bid * 8 + wave; u < DN_UNITS; u += G * 8) {
        const int lane = opq(lane_);
        const int chain = u / DN_NSUB, c = u % DN_NSUB, dir = chain & 1, h = (chain >> 1) & 3, b = chain >> 3;
        const int ti = lane & 15, kg = lane >> 4;
        const int Lh = lane & 31; const bool isw = lane >= 32;
        const size_t rowi = (size_t)seqrow(b, dir, c * 16 + ti);
        const float gi = DG[rowi * 32 + 16 + dir * 4 + h], bi = DG[rowi * 32 + dir * 4 + h];
        u32x4 kk[4], qq[4];
#pragma unroll
        for (int s = 0; s < 4; ++s) { kk[s] = *(const u32x4*)(DQ + rowi * 1536 + 512 + h * 128 + 32 * s + 8 * kg); qq[s] = *(const u32x4*)(DQ + rowi * 1536 + h * 128 + 32 * s + 8 * kg); }
        const bf16_t* src = DQ + (isw ? 512 : 1024) + h * 128 + 4 * Lh;
        f32x4 x[16];
#pragma unroll
        for (int i = 0; i < 16; ++i) { const size_t row = (size_t)seqrow(b, dir, c * 16 + i); x[i] = ldp4(src + row * 1536); }
        float gc = gi; gc += dppz<0x111>(gc); gc += dppz<0x112>(gc); gc += dppz<0x114>(gc); gc += dppz<0x118>(gc);
        if (lane < 16) { sc[lane] = gc; sc[16 + lane] = bi; }
        f32x4 KKd = {0.f, 0.f, 0.f, 0.f}, QKd = KKd;
#pragma unroll
        for (int s = 0; s < 4; ++s) { const bf16x8 kf = __builtin_bit_cast(bf16x8, kk[s]);
            KKd = __builtin_amdgcn_mfma_f32_16x16x32_bf16(kf, kf, KKd, 0, 0, 0); QKd = __builtin_amdgcn_mfma_f32_16x16x32_bf16(__builtin_bit_cast(bf16x8, qq[s]), kf, QKd, 0, 0, 0); }
        LDS_WAIT(); asm volatile("" ::: "memory");
        {
            const f32x4 gci = *(const LAS f32x4*)(sc + 4 * kg), bti = *(const LAS f32x4*)(sc + 16 + 4 * kg);
#pragma unroll
            for (int r = 0; r < 4; ++r) { const int i = 4 * kg + r; const float dec = __expf(gci[r] - gc);
                sc[32 + i * 16 + ti] = (i > ti) ? bti[r] * KKd[r] * dec : 0.f; sc[288 + i * 16 + ti] = (i >= ti) ? QKd[r] * dec : 0.f; }
        }
        {
            const float eq = __expf(gc);
#pragma unroll
            for (int s = 0; s < 4; ++s) { const unsigned w0 = qq[s].x, w1 = qq[s].y, w2 = qq[s].z, w3 = qq[s].w;
                u32x2 lo, hi2;
                lo.x = cvt2(__builtin_bit_cast(float, w0 << 16) * eq, __builtin_bit_cast(float, w0 & 0xffff0000u) * eq); lo.y = cvt2(__builtin_bit_cast(float, w1 << 16) * eq, __builtin_bit_cast(float, w1 & 0xffff0000u) * eq);
                hi2.x = cvt2(__builtin_bit_cast(float, w2 << 16) * eq, __builtin_bit_cast(float, w2 & 0xffff0000u) * eq); hi2.y = cvt2(__builtin_bit_cast(float, w3 << 16) * eq, __builtin_bit_cast(float, w3 & 0xffff0000u) * eq);
                const int kq0 = 2 * (kg & 1), hf = kg >> 1;
                *(LAS u32x2*)(stg + 4096 + ((s * 64 + kq0 * 16 + ti) * 8 + hf * 4) * 2) = lo; *(LAS u32x2*)(stg + 4096 + ((s * 64 + (kq0 + 1) * 16 + ti) * 8 + hf * 4) * 2) = hi2; }
        }
        LDS_WAIT(); asm volatile("" ::: "memory");
        unsigned char* ub = a.ws + WS_DNC + (size_t)u * 12800;
        {
            const f32x4 at = *(const LAS f32x4*)(sc + 288 + ti * 16 + 4 * kg);
            u32x2 o; o.x = cvt2(at.x, at.y); o.y = cvt2(at.z, at.w); *(u32x2*)(ub + 12288 + lane * 8) = o;
            if (lane == 15) ((float*)(a.ws + WS_DNG))[u] = __expf(gc);
        }
#pragma unroll
        for (int i = 0; i < 16; ++i) { const float gci = sc[i], bti = sc[16 + i]; x[i] = x[i] * (isw ? bti * __expf(gci) : bti);
#pragma unroll
            for (int j = 0; j < i; ++j) x[i] -= x[j] * sc[32 + i * 16 + j]; }
        const int sW = Lh >> 3, hfW = (Lh >> 2) & 1, kqW = Lh & 3;
        if (isw) {
#pragma unroll
            for (int m = 0; m < 16; ++m) { u32x2 o; o.x = cvt2(x[m].x, x[m].y); o.y = cvt2(x[m].z, x[m].w); *(LAS u32x2*)(stg + ((sW * 64 + kqW * 16 + m) * 8 + hfW * 4) * 2) = o; }
        }
        LDS_WAIT(); asm volatile("" ::: "memory");
#pragma unroll
        for (int q = 0; q < 8; ++q) *(u32x4*)(ub + q * 1024 + lane * 16) = *(const LAS u32x4*)(stg + q * 1024 + lane * 16);
        LDS_WAIT(); asm volatile("" ::: "memory");
        if (!isw) {
#pragma unroll
            for (int g = 0; g < 4; ++g)
#pragma unroll
                for (int q = 0; q < 4; ++q) { const f32x4 o = {x[4 * g][q], x[4 * g + 1][q], x[4 * g + 2][q], x[4 * g + 3][q]}; *(LAS f32x4*)(stg + ((Lh >> 2) * 256 + (g * 16 + 4 * (Lh & 3) + q) * 4) * 4) = o; }
        }
        LDS_WAIT(); asm volatile("" ::: "memory");
        { unsigned char* ud = a.ws + WS_DNU + (size_t)u * 8192;
#pragma unroll
          for (int q = 0; q < 8; ++q) *(u32x4*)(ud + q * 1024 + lane * 16) = *(const LAS u32x4*)(stg + q * 1024 + lane * 16); }
        LDS_WAIT(); asm volatile("" ::: "memory");
        {
            const float ek = __expf(sc[15] - gc);
            LAS bf16_t* kfi = (LAS bf16_t*)stg;
#pragma unroll
            for (int s = 0; s < 4; ++s) { const unsigned w[4] = {kk[s].x, kk[s].y, kk[s].z, kk[s].w};
#pragma unroll
                for (int e2 = 0; e2 < 4; ++e2) { const unsigned pk = cvt2(__builtin_bit_cast(float, w[e2] << 16) * ek, __builtin_bit_cast(float, w[e2] & 0xffff0000u) * ek);
                    const int d0 = 32 * s + 8 * kg + 2 * e2;
                    kfi[(((d0 >> 4) * 64 + (ti >> 2) * 16 + (d0 & 15)) * 4) + (ti & 3)] = (bf16_t)(pk & 0xffffu);
                    kfi[(((d0 >> 4) * 64 + (ti >> 2) * 16 + ((d0 + 1) & 15)) * 4) + (ti & 3)] = (bf16_t)(pk >> 16); } }
        }
        LDS_WAIT(); asm volatile("" ::: "memory");
#pragma unroll
        for (int q = 0; q < 4; ++q) *(u32x4*)(ub + 8192 + q * 1024 + lane * 16) = *(const LAS u32x4*)(stg + q * 1024 + lane * 16);
        LDS_WAIT(); asm volatile("" ::: "memory");
    }
}
__device__ __forceinline__ void phase_mbpre(const Args& a, int lane_, int wave, int bid, int G) {
    const float* MX = (const float*)(a.ws + WS_MXBC);
    for (int u = bid * 8 + wave; u < MB_UNITS; u += G * 8) {
        const int lane = opq(lane_);
        const int bg = u / DN_NSUB, gi = u % DN_NSUB, b = bg >> 1, grp = bg & 1;
        const size_t base = gi < 16 ? (size_t)NL + b * 256 + gi * 16 : (size_t)b * 4096 + (gi - 16) * 16;
        const int tk = lane & 15, kg = lane >> 4;
        unsigned char* ub0 = a.ws + WS_MBC + (size_t)u * 12288; unsigned char* ub = ub0 + lane * 16;
        const float* cp = MX + (base + tk) * 768 + 512 + grp * 128 + 4 * kg; const float* bp = MX + (base + tk) * 768 + 256 + grp * 128 + 4 * kg;
#pragma unroll
        for (int s = 0; s < 4; ++s) { const f32x4 c0 = *(const f32x4*)(cp + 32 * s), c1 = *(const f32x4*)(cp + 32 * s + 16), b0 = *(const f32x4*)(bp + 32 * s), b1 = *(const f32x4*)(bp + 32 * s + 16);
            u32x4 oc, ob; oc.x = cvt2(c0.x, c0.y); oc.y = cvt2(c0.z, c0.w); oc.z = cvt2(c1.x, c1.y); oc.w = cvt2(c1.z, c1.w);
            ob.x = cvt2(b0.x, b0.y); ob.y = cvt2(b0.z, b0.w); ob.z = cvt2(b1.x, b1.y); ob.w = cvt2(b1.z, b1.w);
            *(u32x4*)(ub + s * 1024) = oc; *(u32x4*)(ub + 4096 + s * 1024) = ob; }
        const float* bt = MX + (base + 4 * kg) * 768 + 256 + grp * 128 + tk;
#pragma unroll
        for (int dt = 0; dt < 8; ++dt) { u32x2 o; o.x = cvt2(bt[16 * dt], bt[768 + 16 * dt]); o.y = cvt2(bt[1536 + 16 * dt], bt[2304 + 16 * dt]); *(u32x2*)(ub0 + 8192 + dt * 512 + lane * 8) = o; }
    }
}
constexpr int RING_OFF = 4608, RING_SLOT = 18432, RING_R = 7, RING_NP = 18;
struct RingSync { volatile LAS int* prog; volatile LAS int* lready; };
__device__ __forceinline__ void ring_wait_ready(const RingSync& rs, int c) { unsigned sp = 0; while (rs.lready[c & 3] < c + 1 && ++sp < (1u << 24)) __builtin_amdgcn_s_sleep(1); }
__device__ __forceinline__ void ring_release(const RingSync& rs, int w, int c, int lane) { asm volatile("" ::: "memory"); if (lane == 0) rs.prog[w] = c + 1; asm volatile("" ::: "memory"); }
struct MbBuf { bf16x8 cf[4], bf[4], btf[8]; float la, xr[4]; size_t base; };
__device__ __forceinline__ size_t mb_base(int b, int dir, int c, int& gi) { gi = c < 16 ? (dir ? 15 - c : c) : (dir ? 16 + 255 - (c - 16) : c); return gi < 16 ? (size_t)NL + b * 256 + gi * 16 : (size_t)b * 4096 + (gi - 16) * 16; }
__device__ __forceinline__ void mb_load(MbBuf& B, const LAS unsigned char* slot, int b, int h, int dir, int pt, int c, int lane) {
    const int n = lane & 15, g = lane >> 4; int gi;
    const LAS unsigned char* ub = slot + lane * 16;
#pragma unroll
    for (int s = 0; s < 4; ++s) { B.cf[s] = *(const LAS bf16x8*)(ub + s * 1024); B.bf[s] = *(const LAS bf16x8*)(ub + 4096 + s * 1024); }
#pragma unroll
    for (int dt = 0; dt < 8; ++dt) { const u32x2 v = *(const LAS u32x2*)(slot + 8192 + dt * 512 + lane * 8); const u32x4 f = {v.x, v.y, 0u, 0u}; B.btf[dt] = __builtin_bit_cast(bf16x8, f); }
    const LAS float* xs = (const LAS float*)(slot + 12288); const LAS float* md = (const LAS float*)(slot + 16384);
    B.la = md[n * 16 + 8 + dir * 4 + h];
#pragma unroll
    for (int r = 0; r < 4; ++r) B.xr[r] = xs[(4 * g + r) * 64 + pt * 16 + n] * md[(4 * g + r) * 16 + dir * 4 + h];
    B.base = mb_base(b, dir, c, gi);
}
__device__ __forceinline__ void mb_step(const MbBuf& B, f32x4 (&hT)[8], LAS float* sc, float* YM, int dir, int h, int pt, int lane) {
    const int n = lane & 15, g = lane >> 4;
    float cum = B.la;
    if (dir == 0) { cum += dppz<0x111>(cum); cum += dppz<0x112>(cum); cum += dppz<0x114>(cum); cum += dppz<0x118>(cum); }
    else          { cum += dppz<0x101>(cum); cum += dppz<0x102>(cum); cum += dppz<0x104>(cum); cum += dppz<0x108>(cum); }
    if (lane < 16) sc[lane] = cum;
    LDS_WAIT(); asm volatile("" ::: "memory");
    const f32x4 cj = *(const LAS f32x4*)(sc + 4 * g); const float cend = sc[dir ? 0 : 15];
    u32x4 px, px2; px.x = cvt2(B.xr[0], B.xr[1]); px.y = cvt2(B.xr[2], B.xr[3]); px.z = 0u; px.w = 0u;
    px2.x = cvt2(B.xr[0] * __expf(cend - cj.x), B.xr[1] * __expf(cend - cj.y)); px2.y = cvt2(B.xr[2] * __expf(cend - cj.z), B.xr[3] * __expf(cend - cj.w)); px2.z = 0u; px2.w = 0u;
    const bf16x8 xdf = __builtin_bit_cast(bf16x8, px), xd2f = __builtin_bit_cast(bf16x8, px2);
    f32x4 gt = {0.f, 0.f, 0.f, 0.f}, yo = gt;
#pragma unroll
    for (int s = 0; s < 4; ++s) { gt = __builtin_amdgcn_mfma_f32_16x16x32_bf16(B.bf[s], B.cf[s], gt, 0, 0, 0);
        u32x4 p; p.x = cvt2(hT[2 * s].x, hT[2 * s].y); p.y = cvt2(hT[2 * s].z, hT[2 * s].w); p.z = cvt2(hT[2 * s + 1].x, hT[2 * s + 1].y); p.w = cvt2(hT[2 * s + 1].z, hT[2 * s + 1].w);
        yo = __builtin_amdgcn_mfma_f32_16x16x32_bf16(__builtin_bit_cast(bf16x8, p), B.cf[s], yo, 0, 0, 0); }
    float st[4];
#pragma unroll
    for (int r = 0; r < 4; ++r) { const int j = 4 * g + r; const bool ok = dir ? (j >= n) : (j <= n); st[r] = ok ? gt[r] * __expf(cum - cj[r]) : 0.f; }
    u32x4 ps; ps.x = cvt2(st[0], st[1]); ps.y = cvt2(st[2], st[3]); ps.z = 0u; ps.w = 0u;
    const f32x4 y = __builtin_amdgcn_mfma_f32_16x16x32_bf16(xdf, __builtin_bit_cast(bf16x8, ps), yo * __expf(cum), 0, 0, 0);
    *(f32x4*)(YM + (B.base + n) * 256 + h * 64 + pt * 16 + 4 * g) = y;
    const float dtot = __expf(cend);
#pragma unroll
    for (int dt = 0; dt < 8; ++dt) hT[dt] = __builtin_amdgcn_mfma_f32_16x16x32_bf16(B.btf[dt], xd2f, hT[dt] * dtot, 0, 0, 0);
    LDS_WAIT(); asm volatile("" ::: "memory");
}
__device__ __forceinline__ void scan_mamba_seq(const Args& a, LAS unsigned char* lds, int chain, int pt, int lane, const RingSync& rs) {
    const int dir = chain & 1, h = (chain >> 1) & 3, b = chain >> 3;
    LAS float* sc = (LAS float*)(lds + 1024 + pt * 256);
    float* YM = (float*)(a.ws + WS_YM) + (size_t)dir * MALL * 256;
    f32x4 hT[8];
#pragma unroll
    for (int i = 0; i < 8; ++i) hT[i] = (f32x4){0.f, 0.f, 0.f, 0.f};
    MbBuf A, B;
    ring_wait_ready(rs, 0); mb_load(A, lds + RING_OFF, b, h, dir, pt, 0, lane); ring_release(rs, pt, 0, lane);
    for (int c = 0; c < DN_NSUB; c += 2) {
        ring_wait_ready(rs, c + 1); mb_load(B, lds + RING_OFF + ((c + 1) % RING_R) * RING_SLOT, b, h, dir, pt, c + 1, lane); ring_release(rs, pt, c + 1, lane);
        mb_step(A, hT, sc, YM, dir, h, pt, lane);
        if (c + 2 < DN_NSUB) { ring_wait_ready(rs, c + 2); mb_load(A, lds + RING_OFF + ((c + 2) % RING_R) * RING_SLOT, b, h, dir, pt, c + 2, lane); ring_release(rs, pt, c + 2, lane); }
        mb_step(B, hT, sc, YM, dir, h, pt, lane);
    }
}

template <int CTRL> __device__ __forceinline__ float dpp1(float v) { return __builtin_bit_cast(float, __builtin_amdgcn_update_dpp(0x3f800000, __builtin_bit_cast(int, v), CTRL, 0xF, 0xF, false)); }
__device__ __forceinline__ void phase_rwpre(const Args& a, LAS unsigned char* lds, int lane_, int wave, int bid, int G) {
    const bf16_t* RW = (const bf16_t*)(a.ws + WS_RW); const float* RWW = (const float*)(a.ws + WS_RWW);
    LAS unsigned char* wl = lds + wave * 13312;
    LAS bf16_t* Ab = (LAS bf16_t*)wl; LAS bf16_t* Rb = Ab + 1024; LAS bf16_t* Bb = Rb + 1024; LAS bf16_t* Kb = Bb + 1024;
    LAS float* Lab = (LAS float*)(wl + 8192); LAS float* Lak = Lab + 256; LAS float* Lbr = Lak + 256; LAS float* Lkr = Lbr + 256; LAS float* Nm = Lkr + 256;
    for (int u = bid * 8 + wave; u < DN_UNITS; u += G * 8) {
        const int lane = opq(lane_);
        const int chain = u / DN_NSUB, c = u % DN_NSUB, dir = chain & 1, h = (chain >> 1) & 3, b = chain >> 3;
        const int ti = lane & 15, kg = lane >> 4;
        const size_t rrow = (size_t)seqrow(b, dir, c * 16 + ti);
        const bf16_t* p = RW + rrow * 1280 + h * 64 + 8 * kg; const float* pw = RWW + rrow * 512 + dir * 256 + h * 64 + 8 * kg;
        float av[16], bv[16], kv[16], rv[16], wv[16];
#pragma unroll
        for (int s = 0; s < 2; ++s)
#pragma unroll
            for (int q = 0; q < 2; ++q) { const int o = 32 * s + 4 * q;
                const f32x4 r4 = ldp4(p + o), k4 = ldp4(p + 256 + o), a4 = ldp4(p + 768 + o), b4 = ldp4(p + 1024 + o), w4 = *(const f32x4*)(pw + o);
#pragma unroll
                for (int e = 0; e < 4; ++e) { const int x = 8 * s + 4 * q + e; rv[x] = r4[e]; kv[x] = k4[e]; av[x] = a4[e]; bv[x] = b4[e]; wv[x] = w4[e]; } }
        u32x4 fa[2], fr[2], fb[2], fk[2];
        float p15[16];
#pragma unroll
        for (int x = 0; x < 16; ++x) {
            float P = wv[x]; P *= dpp1<0x111>(P); P *= dpp1<0x112>(P); P *= dpp1<0x114>(P); P *= dpp1<0x118>(P);
            const float Pex = dpp1<0x111>(P), ip = frcp(P);
            av[x] *= Pex; rv[x] *= P; bv[x] *= ip; kv[x] *= ip;
            p15[x] = dppf<0x140>(P);
        }
#pragma unroll
        for (int s = 0; s < 2; ++s) {
            fa[s].x = cvt2(av[8 * s], av[8 * s + 1]); fa[s].y = cvt2(av[8 * s + 2], av[8 * s + 3]); fa[s].z = cvt2(av[8 * s + 4], av[8 * s + 5]); fa[s].w = cvt2(av[8 * s + 6], av[8 * s + 7]);
            fr[s].x = cvt2(rv[8 * s], rv[8 * s + 1]); fr[s].y = cvt2(rv[8 * s + 2], rv[8 * s + 3]); fr[s].z = cvt2(rv[8 * s + 4], rv[8 * s + 5]); fr[s].w = cvt2(rv[8 * s + 6], rv[8 * s + 7]);
            fb[s].x = cvt2(bv[8 * s], bv[8 * s + 1]); fb[s].y = cvt2(bv[8 * s + 2], bv[8 * s + 3]); fb[s].z = cvt2(bv[8 * s + 4], bv[8 * s + 5]); fb[s].w = cvt2(bv[8 * s + 6], bv[8 * s + 7]);
            fk[s].x = cvt2(kv[8 * s], kv[8 * s + 1]); fk[s].y = cvt2(kv[8 * s + 2], kv[8 * s + 3]); fk[s].z = cvt2(kv[8 * s + 4], kv[8 * s + 5]); fk[s].w = cvt2(kv[8 * s + 6], kv[8 * s + 7]);
            *(LAS u32x4*)(Ab + ti * 64 + 32 * s + 8 * kg) = fa[s]; *(LAS u32x4*)(Rb + ti * 64 + 32 * s + 8 * kg) = fr[s];
            *(LAS u32x4*)(Bb + ti * 64 + 32 * s + 8 * kg) = fb[s]; *(LAS u32x4*)(Kb + ti * 64 + 32 * s + 8 * kg) = fk[s];
        }
        unsigned char* ub = a.ws + WS_RWC + (size_t)u * 10496;
        if (ti == 0) {
            float* pp = (float*)(ub + 10240) + 8 * kg;
            *(f32x4*)(pp) = (f32x4){p15[0], p15[1], p15[2], p15[3]}; *(f32x4*)(pp + 4) = (f32x4){p15[4], p15[5], p15[6], p15[7]};
            *(f32x4*)(pp + 32) = (f32x4){p15[8], p15[9], p15[10], p15[11]}; *(f32x4*)(pp + 36) = (f32x4){p15[12], p15[13], p15[14], p15[15]};
        }
        f32x4 dab = {0.f, 0.f, 0.f, 0.f}, dak = dab, dbr = dab, dkr = dab;
#pragma unroll
        for (int s = 0; s < 2; ++s) { const bf16x8 A = __builtin_bit_cast(bf16x8, fa[s]), R = __builtin_bit_cast(bf16x8, fr[s]), B = __builtin_bit_cast(bf16x8, fb[s]), K = __builtin_bit_cast(bf16x8, fk[s]);
            dab = __builtin_amdgcn_mfma_f32_16x16x32_bf16(A, B, dab, 0, 0, 0); dak = __builtin_amdgcn_mfma_f32_16x16x32_bf16(A, K, dak, 0, 0, 0);
            dbr = __builtin_amdgcn_mfma_f32_16x16x32_bf16(R, B, dbr, 0, 0, 0); dkr = __builtin_amdgcn_mfma_f32_16x16x32_bf16(R, K, dkr, 0, 0, 0); }
#pragma unroll
        for (int r = 0; r < 4; ++r) { const int i = 4 * kg + r;
            Lab[i * 16 + ti] = (ti < i) ? dab[r] : 0.f; Lak[i * 16 + ti] = (ti < i) ? dak[r] : 0.f; Lbr[i * 16 + ti] = (ti <= i) ? dbr[r] : 0.f; Lkr[i * 16 + ti] = (ti <= i) ? dkr[r] : 0.f; }
        LDS_WAIT(); asm volatile("" ::: "memory");
        if (lane < 16) {
            float nn[16];
#pragma unroll
            for (int i = 0; i < 16; ++i) { float v = (i == lane) ? 1.f : 0.f;
#pragma unroll
                for (int j = 0; j < i; ++j) v += Lab[i * 16 + j] * nn[j];
                nn[i] = v; Nm[i * 16 + lane] = v; }
        }
        LDS_WAIT(); asm volatile("" ::: "memory");
        {
            const f32x4 m0 = *(const LAS f32x4*)(Lak + ti * 16 + 4 * kg), m1 = *(const LAS f32x4*)(Nm + ti * 16 + 4 * kg), m2 = *(const LAS f32x4*)(Lbr + ti * 16 + 4 * kg), m3 = *(const LAS f32x4*)(Lkr + ti * 16 + 4 * kg);
            u32x2 o;
            o.x = cvt2(m0.x, m0.y); o.y = cvt2(m0.z, m0.w); *(u32x2*)(ub + 4096 + lane * 8) = o;
            o.x = cvt2(m1.x, m1.y); o.y = cvt2(m1.z, m1.w); *(u32x2*)(ub + 4608 + lane * 8) = o;
            o.x = cvt2(m2.x, m2.y); o.y = cvt2(m2.z, m2.w); *(u32x2*)(ub + 5120 + lane * 8) = o;
            o.x = cvt2(m3.x, m3.y); o.y = cvt2(m3.z, m3.w); *(u32x2*)(ub + 5632 + lane * 8) = o;
        }
#pragma unroll
        for (int s = 0; s < 2; ++s) {
            u32x4 o; const u32x2 a0 = *(const LAS u32x2*)(Ab + ti * 64 + 32 * s + 4 * kg), a1 = *(const LAS u32x2*)(Ab + ti * 64 + 32 * s + 16 + 4 * kg);
            o.x = a0.x; o.y = a0.y; o.z = a1.x; o.w = a1.y; *(u32x4*)(ub + s * 1024 + lane * 16) = o;
            const u32x2 r0 = *(const LAS u32x2*)(Rb + ti * 64 + 32 * s + 4 * kg), r1 = *(const LAS u32x2*)(Rb + ti * 64 + 32 * s + 16 + 4 * kg);
            o.x = r0.x; o.y = r0.y; o.z = r1.x; o.w = r1.y; *(u32x4*)(ub + 2048 + s * 1024 + lane * 16) = o;
        }
#pragma unroll
        for (int dt = 0; dt < 4; ++dt) {
            u32x2 o;
            const LAS bf16_t* bp = Bb + (4 * kg) * 64 + 16 * dt + ti; const LAS bf16_t* kp = Kb + (4 * kg) * 64 + 16 * dt + ti;
            o.x = (unsigned)bp[0] | ((unsigned)bp[64] << 16); o.y = (unsigned)bp[128] | ((unsigned)bp[192] << 16); *(u32x2*)(ub + 6144 + dt * 512 + lane * 8) = o;
            o.x = (unsigned)kp[0] | ((unsigned)kp[64] << 16); o.y = (unsigned)kp[128] | ((unsigned)kp[192] << 16); *(u32x2*)(ub + 8192 + dt * 512 + lane * 8) = o;
        }
        LDS_WAIT(); asm volatile("" ::: "memory");
    }
}
struct RwBuf { bf16x8 atf[2], rtf[2], lakf, nf, lbrf, lkrf, bfr[4], kfr[4]; float vr[4]; };
struct RwBuf2 { f32x4 p15[4]; };
__device__ __forceinline__ void rw_load(RwBuf& B, f32x4 (&p15)[4], const LAS unsigned char* slot, int vt, int lane) {
    const int n = lane & 15, g = lane >> 4;
    const LAS unsigned char* ub = slot + lane * 16;
#pragma unroll
    for (int s = 0; s < 2; ++s) { B.atf[s] = *(const LAS bf16x8*)(ub + s * 1024); B.rtf[s] = *(const LAS bf16x8*)(ub + 2048 + s * 1024); }
#define RW_HALF(off) ({ const u32x2 v_ = *(const LAS u32x2*)(slot + (off) + lane * 8); const u32x4 f_ = {v_.x, v_.y, 0u, 0u}; __builtin_bit_cast(bf16x8, f_); })
    B.lakf = RW_HALF(4096); B.nf = RW_HALF(4608); B.lbrf = RW_HALF(5120); B.lkrf = RW_HALF(5632);
#pragma unroll
    for (int dt = 0; dt < 4; ++dt) { B.bfr[dt] = RW_HALF(6144 + dt * 512); B.kfr[dt] = RW_HALF(8192 + dt * 512); p15[dt] = *(const LAS f32x4*)(slot + 10240 + (16 * dt + 4 * g) * 4); }
#undef RW_HALF
    const LAS bf16_t* vs = (const LAS bf16_t*)(slot + 11264);
#pragma unroll
    for (int r = 0; r < 4; ++r) B.vr[r] = __builtin_bit_cast(float, ((unsigned)vs[(4 * g + r) * 64 + vt * 16 + n]) << 16);
}
__device__ __forceinline__ void rw_step(const RwBuf& B, const f32x4 (&p15)[4], f32x4 (&Sd)[4], float* YR, int b, int dir, int h, int vt, int c, int lane) {
    const int n = lane & 15, g = lane >> 4;
    const f32x4 z4 = {0.f, 0.f, 0.f, 0.f};
    u32x4 pv; pv.x = cvt2(B.vr[0], B.vr[1]); pv.y = cvt2(B.vr[2], B.vr[3]); pv.z = 0u; pv.w = 0u;
    const bf16x8 vb = __builtin_bit_cast(bf16x8, pv);
    bf16x8 sb[2];
#pragma unroll
    for (int s = 0; s < 2; ++s) { u32x4 p; p.x = cvt2(Sd[2 * s].x, Sd[2 * s].y); p.y = cvt2(Sd[2 * s].z, Sd[2 * s].w); p.z = cvt2(Sd[2 * s + 1].x, Sd[2 * s + 1].y); p.w = cvt2(Sd[2 * s + 1].z, Sd[2 * s + 1].w); sb[s] = __builtin_bit_cast(bf16x8, p); }
    f32x4 X = __builtin_amdgcn_mfma_f32_16x16x32_bf16(B.atf[0], sb[0], z4, 0, 0, 0);
    X = __builtin_amdgcn_mfma_f32_16x16x32_bf16(B.atf[1], sb[1], X, 0, 0, 0);
    X = __builtin_amdgcn_mfma_f32_16x16x32_bf16(B.lakf, vb, X, 0, 0, 0);
    u32x4 px; px.x = cvt2(X.x, X.y); px.y = cvt2(X.z, X.w); px.z = 0u; px.w = 0u;
    const f32x4 UT = __builtin_amdgcn_mfma_f32_16x16x32_bf16(B.nf, __builtin_bit_cast(bf16x8, px), z4, 0, 0, 0);
    u32x4 pu; pu.x = cvt2(UT.x, UT.y); pu.y = cvt2(UT.z, UT.w); pu.z = 0u; pu.w = 0u;
    const bf16x8 ubf = __builtin_bit_cast(bf16x8, pu);
    f32x4 Y = __builtin_amdgcn_mfma_f32_16x16x32_bf16(B.rtf[0], sb[0], z4, 0, 0, 0);
    Y = __builtin_amdgcn_mfma_f32_16x16x32_bf16(B.rtf[1], sb[1], Y, 0, 0, 0);
    Y = __builtin_amdgcn_mfma_f32_16x16x32_bf16(B.lbrf, ubf, Y, 0, 0, 0);
    Y = __builtin_amdgcn_mfma_f32_16x16x32_bf16(B.lkrf, vb, Y, 0, 0, 0);
#pragma unroll
    for (int r = 0; r < 4; ++r) YR[(size_t)seqrow(b, dir, c * 16 + 4 * g + r) * 256 + h * 64 + vt * 16 + n] = Y[r];
#pragma unroll
    for (int dt = 0; dt < 4; ++dt) { f32x4 t = __builtin_amdgcn_mfma_f32_16x16x32_bf16(B.bfr[dt], ubf, Sd[dt], 0, 0, 0); t = __builtin_amdgcn_mfma_f32_16x16x32_bf16(B.kfr[dt], vb, t, 0, 0, 0); Sd[dt] = t * p15[dt]; }
}
__device__ __forceinline__ void scan_rw_seq(const Args& a, LAS unsigned char* lds, int chain, int vt, int lane, const RingSync& rs) {
    const int dir = chain & 1, h = (chain >> 1) & 3, b = chain >> 3;
    float* YR = (float*)(a.ws + WS_YRW) + (size_t)dir * MALL * 256;
    f32x4 Sd[4];
#pragma unroll
    for (int i = 0; i < 4; ++i) Sd[i] = (f32x4){0.f, 0.f, 0.f, 0.f};
    RwBuf A, B; f32x4 pa[4], pb[4];
    ring_wait_ready(rs, 0); rw_load(A, pa, lds + RING_OFF, vt, lane); ring_release(rs, vt, 0, lane);
    for (int c = 0; c < DN_NSUB; c += 2) {
        ring_wait_ready(rs, c + 1); rw_load(B, pb, lds + RING_OFF + ((c + 1) % RING_R) * RING_SLOT, vt, lane); ring_release(rs, vt, c + 1, lane);
        rw_step(A, pa, Sd, YR, b, dir, h, vt, c, lane);
        if (c + 2 < DN_NSUB) { ring_wait_ready(rs, c + 2); rw_load(A, pa, lds + RING_OFF + ((c + 2) % RING_R) * RING_SLOT, vt, lane); ring_release(rs, vt, c + 2, lane); }
        rw_step(B, pb, Sd, YR, b, dir, h, vt, c + 1, lane);
    }
}

struct DnBuf { bf16x8 wf[4], qf[4], kf[8], af; f32x4 uv; float gam; };
__device__ __forceinline__ void dn_load(DnBuf& B, const LAS unsigned char* slot, int w, int lane) {
    const LAS unsigned char* ub = slot + lane * 16;
#pragma unroll
    for (int s = 0; s < 4; ++s) { B.wf[s] = *(const LAS bf16x8*)(ub + s * 1024); B.qf[s] = *(const LAS bf16x8*)(ub + 4096 + s * 1024); }
#pragma unroll
    for (int dt = 0; dt < 8; ++dt) { const u32x2 v = *(const LAS u32x2*)(slot + 8192 + dt * 512 + lane * 8); const u32x4 f = {v.x, v.y, 0u, 0u}; B.kf[dt] = __builtin_bit_cast(bf16x8, f); }
    { const u32x2 v = *(const LAS u32x2*)(slot + 12288 + lane * 8); const u32x4 f = {v.x, v.y, 0u, 0u}; B.af = __builtin_bit_cast(bf16x8, f); }
    B.uv = *(const LAS f32x4*)(ub + 13312 + w * 1024);
    B.gam = *(const LAS float*)(slot + 17408);
}
__device__ __forceinline__ void dn_step(const DnBuf& B, f32x4 (&Sd)[8], float* OD, int b, int dir, int h, int c, int ct, int n, int g) {
    f32x4 ws = {0.f, 0.f, 0.f, 0.f}, qs = ws;
#pragma unroll
    for (int s = 0; s < 4; ++s) { u32x4 p; p.x = cvt2(Sd[2 * s].x, Sd[2 * s].y); p.y = cvt2(Sd[2 * s].z, Sd[2 * s].w); p.z = cvt2(Sd[2 * s + 1].x, Sd[2 * s + 1].y); p.w = cvt2(Sd[2 * s + 1].z, Sd[2 * s + 1].w);
        const bf16x8 sb = __builtin_bit_cast(bf16x8, p);
        ws = __builtin_amdgcn_mfma_f32_16x16x32_bf16(B.wf[s], sb, ws, 0, 0, 0); qs = __builtin_amdgcn_mfma_f32_16x16x32_bf16(B.qf[s], sb, qs, 0, 0, 0); }
    const f32x4 vn = B.uv - ws;
    u32x4 pv; pv.x = cvt2(vn.x, vn.y); pv.y = cvt2(vn.z, vn.w); pv.z = 0u; pv.w = 0u;
    const bf16x8 vb = __builtin_bit_cast(bf16x8, pv);
    const f32x4 o = __builtin_amdgcn_mfma_f32_16x16x32_bf16(B.af, vb, qs, 0, 0, 0);
#pragma unroll
    for (int dt = 0; dt < 8; ++dt) Sd[dt] = __builtin_amdgcn_mfma_f32_16x16x32_bf16(B.kf[dt], vb, Sd[dt] * B.gam, 0, 0, 0);
#pragma unroll
    for (int r = 0; r < 4; ++r) OD[(size_t)seqrow(b, dir, c * 16 + 4 * g + r) * 512 + h * 128 + ct * 16 + n] = o[r];
}
__device__ __forceinline__ void scan_dn_seq(const Args& a, LAS unsigned char* lds, int chain, int ct, int lane, const RingSync& rs) {
    const int dir = chain & 1, h = (chain >> 1) & 3, b = chain >> 3, w = ct & 3;
    const int n = lane & 15, g = lane >> 4;
    float* OD = (float*)(a.ws + WS_ODN) + (size_t)dir * MALL * 512;
    f32x4 Sd[8];
#pragma unroll
    for (int i = 0; i < 8; ++i) Sd[i] = (f32x4){0.f, 0.f, 0.f, 0.f};
    DnBuf A, B;
    ring_wait_ready(rs, 0); dn_load(A, lds + RING_OFF, w, lane); ring_release(rs, w, 0, lane);
    for (int c = 0; c < DN_NSUB; c += 2) {
        ring_wait_ready(rs, c + 1); dn_load(B, lds + RING_OFF + ((c + 1) % RING_R) * RING_SLOT, w, lane); ring_release(rs, w, c + 1, lane);
        dn_step(A, Sd, OD, b, dir, h, c, ct, n, g);
        if (c + 2 < DN_NSUB) { ring_wait_ready(rs, c + 2); dn_load(A, lds + RING_OFF + ((c + 2) % RING_R) * RING_SLOT, w, lane); ring_release(rs, w, c + 2, lane); }
        dn_step(B, Sd, OD, b, dir, h, c + 1, ct, n, g);
    }
}

__device__ __forceinline__ void ring_issue(const Args& a, LAS unsigned char* lds, int kind, int chain, int half, int c, int lane) {
    const int dir = chain & 1, h = (chain >> 1) & 3, b = chain >> 3, grp = h >> 1;
    LAS unsigned char* slot = lds + RING_OFF + (c % RING_R) * RING_SLOT;
    const size_t u = (size_t)chain * DN_NSUB + c;
    int gi; const size_t mbase = mb_base(b, dir, c, gi);
#pragma unroll
    for (int p = 0; p < RING_NP; ++p) {
        const int off = p * 1024 + lane * 16; const unsigned char* gp = nullptr;
        if (kind == 0) { if (off < 12800) gp = a.ws + WS_DNC + u * 12800 + off; else if (off >= 13312 && off < 17408) gp = a.ws + WS_DNU + u * 8192 + half * 4096 + (off - 13312); else if (off == 17408) gp = a.ws + WS_DNG + u * 4; }
        else if (kind == 1) { if (p < 12) gp = a.ws + WS_MBC + ((size_t)(b * 2 + grp) * DN_NSUB + gi) * 12288 + off;
            else if (p < 16) gp = a.ws + WS_MXBC + ((mbase + (p - 12) * 4 + (lane >> 4)) * 768 + h * 64) * 4 + (lane & 15) * 16;
            else if (p == 16) gp = a.ws + WS_MDT + mbase * 64 + lane * 16; }
        else { if (off < 10496) gp = a.ws + WS_RWC + u * 10496 + off;
            else if (p >= 11 && p < 13) gp = a.ws + WS_RW + ((size_t)seqrow(b, dir, c * 16 + (p - 11) * 8 + (lane >> 3)) * 1280 + 512 + h * 64) * 2 + (lane & 7) * 16; }
        if (gp) __builtin_amdgcn_global_load_lds((const unsigned*)gp, (LAS unsigned*)(slot + p * 1024), 16, 0, 0);
        else asm volatile("s_nop 0");
    }
}
__device__ __forceinline__ void ring_loader(const Args& a, LAS unsigned char* lds, int kind, int chain, int half, int j, int lane, const RingSync& rs) {
    int c = j;
    ring_issue(a, lds, kind, chain, half, c, lane);
    for (; c < DN_NSUB; c += 4) {
        const int cn = c + 4;
        if (cn < DN_NSUB) {
            if (cn >= RING_R) { unsigned sp = 0; while ((rs.prog[0] < cn - RING_R + 1 || rs.prog[1] < cn - RING_R + 1 || rs.prog[2] < cn - RING_R + 1 || rs.prog[3] < cn - RING_R + 1) && ++sp < (1u << 24)) __builtin_amdgcn_s_sleep(1); }
            ring_issue(a, lds, kind, chain, half, cn, lane);
            if (kind == 0) asm volatile("s_waitcnt vmcnt(18)" ::: "memory"); else if (kind == 1) asm volatile("s_waitcnt vmcnt(17)" ::: "memory"); else asm volatile("s_waitcnt vmcnt(13)" ::: "memory");
        } else asm volatile("s_waitcnt vmcnt(0)" ::: "memory");
        if (lane == 0) rs.lready[j] = c + 1;
    }
}
__device__ __forceinline__ void phase_scan(const Args& a, LAS unsigned char* lds, int tid_, int bid, int G) {
    RingSync rs; rs.prog = (volatile LAS int*)(lds + 4096); rs.lready = (volatile LAS int*)(lds + 4096 + 64);
    for (int item = bid; item < 128; item += G) {
        if (tid_ < 8) { if (tid_ < 4) rs.prog[tid_] = 0; else rs.lready[tid_ - 4] = 0; }
        __syncthreads();
        const int tid = opq(tid_), w = tid >> 6, lane = tid & 63;
        if (item < 64) { const int chain = item >> 1, half = item & 1;
            if (w < 4) scan_dn_seq(a, lds, chain, half * 4 + w, lane, rs); else ring_loader(a, lds, 0, chain, half, w - 4, lane, rs); }
        else if (item < 96) { const int chain = item - 64;
            if (w < 4) scan_mamba_seq(a, lds, chain, w, lane, rs); else ring_loader(a, lds, 1, chain, 0, w - 4, lane, rs); }
        else { const int chain = item - 96;
            if (w < 4) scan_rw_seq(a, lds, chain, w, lane, rs); else ring_loader(a, lds, 2, chain, 0, w - 4, lane, rs); }
        __syncthreads();
    }
}

struct FnBuf { f32x4 xs, ym0, ym1, z, od0[2], od1[2], gt[2], yr0, yr1, g; u32x2 rr, kk, vv; };
__device__ __forceinline__ void fn_load(FnBuf& B, const Args& a, int row, int lane) {
    const float* P = (const float*)(a.ws + WS_P);
    const float* MX = (const float*)(a.ws + WS_MXBC); const float* YM = (const float*)(a.ws + WS_YM);
    const float* OD = (const float*)(a.ws + WS_ODN); const float* YR = (const float*)(a.ws + WS_YRW);
    const bf16_t* RW = (const bf16_t*)(a.ws + WS_RW); const float* RG = (const float*)(a.ws + WS_RWG);
    const int c4 = lane * 4;
    B.xs = *(const f32x4*)(MX + (size_t)row * 768 + c4);
    B.ym0 = *(const f32x4*)(YM + (size_t)row * 256 + c4); B.ym1 = *(const f32x4*)(YM + (size_t)(MALL + row) * 256 + c4);
    B.z = *(const f32x4*)(P + (size_t)row * INP + c4);
    int dr = row;
    if (row < NL) { const int b = row >> 12, t = row & 4095; dr = b * 4096 + (t & 63) * 64 + (t >> 6); }
#pragma unroll
    for (int blk = 0; blk < 2; ++blk) { const int ch = blk * 256 + c4;
        B.od0[blk] = *(const f32x4*)(OD + (size_t)dr * 512 + ch); B.od1[blk] = *(const f32x4*)(OD + (size_t)(MALL + dr) * 512 + ch);
        B.gt[blk] = *(const f32x4*)(P + (size_t)row * INP + DN_OFF + 1536 + ch); }
    B.yr0 = *(const f32x4*)(YR + (size_t)row * 256 + c4); B.yr1 = *(const f32x4*)(YR + (size_t)(MALL + row) * 256 + c4);
    const bf16_t* rwp = RW + (size_t)row * 1280 + c4;
    B.rr = *(const u32x2*)rwp; B.kk = *(const u32x2*)(rwp + 256); B.vv = *(const u32x2*)(rwp + 512);
    B.g = *(const f32x4*)(RG + (size_t)row * 256 + c4);
}
__device__ __forceinline__ f32x4 up4(u32x2 v) { return (f32x4){__builtin_bit_cast(float, v.x << 16), __builtin_bit_cast(float, v.x & 0xffff0000u), __builtin_bit_cast(float, v.y << 16), __builtin_bit_cast(float, v.y & 0xffff0000u)}; }
__device__ __forceinline__ void fn_step(const FnBuf& B, const Args& a, int L, int row, int lane) {
    const int c4 = lane * 4;
    bf16_t* yo = (bf16_t*)(a.ws + WS_YMIX) + (size_t)row * D;
    {
        const float dsk = a.in[14][L * 4 + (lane >> 4)];
        f32x4 y = B.xs * dsk + B.ym0 + B.ym1;
#pragma unroll
        for (int i = 0; i < 4; ++i) y[i] *= siluf(B.z[i]);
        const float ss = grp_sum<32>((y.x * y.x + y.y * y.y) + (y.z * y.z + y.w * y.w));
        const float r = frsq(ss * (1.f / 128.f) + 1e-5f);
        const f32x4 nw = *(const f32x4*)(a.in[15] + L * 256 + c4);
        y = y * r * nw;
        u32x2 pk; pk.x = cvt2(y.x, y.y); pk.y = cvt2(y.z, y.w); *(u32x2*)(yo + c4) = pk;
    }
#pragma unroll
    for (int blk = 0; blk < 2; ++blk) {
        const int ch = blk * 256 + c4;
        f32x4 o = B.od0[blk] + B.od1[blk];
        const float ss = grp_sum<32>((o.x * o.x + o.y * o.y) + (o.z * o.z + o.w * o.w));
        const float r = frsq(ss * (1.f / 128.f) + 1e-6f);
        const f32x4 nw = *(const f32x4*)(a.in[19] + L * 128 + (ch & 127));
#pragma unroll
        for (int i = 0; i < 4; ++i) o[i] = o[i] * r * nw[i] * siluf(B.gt[blk][i]);
        u32x2 pk; pk.x = cvt2(o.x, o.y); pk.y = cvt2(o.z, o.w); *(u32x2*)(yo + 256 + ch) = pk;
    }
    {
        f32x4 y = B.yr0 + B.yr1;
        const float mean = grp_sum<16>((y.x + y.y) + (y.z + y.w)) * (1.f / 64.f);
        y = y - mean;
        const float var = grp_sum<16>((y.x * y.x + y.y * y.y) + (y.z * y.z + y.w * y.w)) * (1.f / 64.f);
        const float r = frsq(var + 64e-5f);
        const f32x4 lw = *(const f32x4*)(a.in[29] + L * 256 + c4), lb = *(const f32x4*)(a.in[30] + L * 256 + c4);
        const f32x4 rv = up4(B.rr), kv = up4(B.kk), vv = up4(B.vv);
        const f32x4 rkw = *(const f32x4*)(a.in[28] + L * 256 + c4);
        const float bs = grp_sum<16>((rv.x * kv.x * rkw.x + rv.y * kv.y * rkw.y) + (rv.z * kv.z * rkw.z + rv.w * kv.w * rkw.w));
        f32x4 o = (y * r * lw + lb + vv * bs) * B.g;
        u32x2 pk; pk.x = cvt2(o.x, o.y); pk.y = cvt2(o.z, o.w); *(u32x2*)(yo + 768 + c4) = pk;
    }
}
__device__ __forceinline__ void phase_finish(const Args& a, int L, int nrows, int lane_, int wave, int bid, int G) {
    const int lane = opq(lane_), r0 = bid * 8 + wave, st = G * 8;
    if (r0 >= nrows) return;
    FnBuf A, B; fn_load(A, a, r0, lane);
    for (int row = r0; row < nrows; row += 2 * st) {
        const int r1 = row + st, r2 = row + 2 * st;
        if (r1 < nrows) fn_load(B, a, r1, lane);
        fn_step(A, a, L, row, lane);
        if (r1 < nrows) { if (r2 < nrows) fn_load(A, a, r2, lane); fn_step(B, a, L, r1, lane); }
    }
}

__device__ __forceinline__ void phase_router(const Args& a, int L, int nrows, const float* xm, LAS unsigned char* lds, int tid, int lane, int wave, int bid, int G) {
    LAS float* wr = (LAS float*)lds;
    const float* wsrc = a.in[31] + (size_t)L * 1024 * 32;
    for (int i = tid; i < 8192; i += 512) { const f32x4 v = *(const f32x4*)(wsrc + i * 4); const int k = i >> 3, e = (i & 7) * 4;
        wr[(e + 0) * 1024 + k] = v.x; wr[(e + 1) * 1024 + k] = v.y; wr[(e + 2) * 1024 + k] = v.z; wr[(e + 3) * 1024 + k] = v.w; }
    __syncthreads();
    const float* mod = (const float*)(a.ws + WS_MOD) + (size_t)L * 5 * 6144;
    bf16_t* H2 = (bf16_t*)(a.ws + WS_HN);
    int* tok = (int*)(a.ws + WS_TOK + (size_t)L * TOK_STRIDE);
    LAS unsigned* hist = (LAS unsigned*)(lds + RING_BYTES + 2048);
    if (tid < 32) hist[tid] = 0u;
    __syncthreads();
    const float brt = lane < 32 ? a.in[32][L * 32 + lane] : 0.f;
    for (int row = bid * 8 + wave; row < nrows; row += G * 8) {
        const int bi = row < NL ? (row >> 12) : 4;
        f32x4 v[4];
#pragma unroll
        for (int j = 0; j < 4; ++j) v[j] = *(const f32x4*)(xm + (size_t)row * D + j * 256 + lane * 4);
        norm_mod_store<true>(v, a.in[7] + L * D, mod + (size_t)bi * 6144 + 3 * 1024, mod + (size_t)bi * 6144 + 4 * 1024, H2 + (size_t)row * 512, lane);
        float mine = -3.0e38f;
#pragma unroll 4
        for (int e = 0; e < 32; ++e) { float p = 0.f;
#pragma unroll
            for (int j = 0; j < 4; ++j) { const f32x4 w4 = *(const LAS f32x4*)(wr + e * 1024 + j * 256 + lane * 4); p += (v[j].x * w4.x + v[j].y * w4.y) + (v[j].z * w4.z + v[j].w * w4.w); }
            p = wave_sum(p);
            if (lane == e) mine = p + brt; }
        float tl[4]; int te[4];
#pragma unroll
        for (int k = 0; k < 4; ++k) { const float m = wave_max(mine); const unsigned long long bal = __ballot(mine == m); const int idx = __ffsll((long long)bal) - 1;
            tl[k] = m; te[k] = idx; if (lane == idx) mine = -3.0e38f; }
        const float e1 = __expf(tl[1] - tl[0]), e2 = __expf(tl[2] - tl[0]), e3 = __expf(tl[3] - tl[0]); const float inv = 1.f / (1.f + e1 + e2 + e3);
        if (lane < 4) { const int e = lane == 0 ? te[0] : lane == 1 ? te[1] : lane == 2 ? te[2] : te[3];
            const float g = (lane == 0 ? 1.f : lane == 1 ? e1 : lane == 2 ? e2 : e3) * inv;
            const unsigned pos = __hip_atomic_fetch_add(hist + e, 1u, __ATOMIC_RELAXED, __HIP_MEMORY_SCOPE_WORKGROUP);
            tok[TK_E + row * 4 + lane] = e; ((float*)tok)[TK_G + row * 4 + lane] = g; tok[TK_POS + row * 4 + lane] = (int)pos; }
    }
    __syncthreads();
    if (tid < 32) tok[TK_BCNT + bid * 32 + tid] = (int)hist[tid];
}
__device__ __forceinline__ void phase_scatter(const Args& a, int L, int nrows, LAS unsigned char* lds, int tid, int lane, int wave, int bid, int G) {
    LAS int* ps = (LAS int*)lds;
    int* tok = (int*)(a.ws + WS_TOK + (size_t)L * TOK_STRIDE);
    if (tid < 32) { int tot = 0, off = 0; for (int b = 0; b < G; ++b) { const int c = tok[TK_BCNT + b * 32 + tid]; tot += c; off += (b < bid) ? c : 0; } ps[64 + tid] = tot; ps[128 + tid] = off; }
    __syncthreads();
    if (tid == 0) { int acc = 0; for (int e = 0; e < 32; ++e) { ps[e] = acc; acc += (ps[64 + e] + 255) & ~255; } ps[32] = acc; }
    __syncthreads();
    if (tid < 32) ps[128 + tid] += ps[tid];
    if (bid == 0) { const int nblk = ps[32] >> 8;
        for (int m = tid; m < MAXBLK; m += 512) { int e = 0; for (int q = 1; q < 32; ++q) if ((m << 8) >= ps[q]) e = q; tok[TK_BLKE + m] = e; }
        if (tid == 0) tok[TK_NBLK] = nblk; }
    __syncthreads();
    const bf16_t* H2 = (const bf16_t*)(a.ws + WS_HN); bf16_t* HS = (bf16_t*)(a.ws + WS_HS);
    for (int row = bid * 8 + wave; row < nrows; row += G * 8) {
        const u32x4 d0 = *(const u32x4*)(H2 + (size_t)row * 512 + lane * 8);
#pragma unroll
        for (int k = 0; k < 4; ++k) { const int e = tok[TK_E + row * 4 + k], pos = tok[TK_POS + row * 4 + k]; const int slot = ps[128 + e] + pos;
            *(u32x4*)(HS + (size_t)slot * 512 + lane * 8) = d0;
            if (lane == 0) tok[TK_SLOT + row * 4 + k] = slot; }
    }
}
struct CbTok { int slot[4]; float g[4]; };
struct CbBuf { u32x2 y[4][4]; f32x4 x[4]; float g[4]; };
__device__ __forceinline__ void cb_tok(CbTok& T, const int* tok, int row) {
#pragma unroll
    for (int k = 0; k < 4; ++k) { T.slot[k] = tok[TK_SLOT + row * 4 + k]; T.g[k] = ((const float*)tok)[TK_G + row * 4 + k]; }
}
__device__ __forceinline__ void cb_load(CbBuf& B, const CbTok& T, const bf16_t* Y, const float* xm, int row, int lane) {
#pragma unroll
    for (int k = 0; k < 4; ++k) { B.g[k] = T.g[k];
#pragma unroll
        for (int j = 0; j < 4; ++j) B.y[k][j] = *(const u32x2*)(Y + (size_t)T.slot[k] * D + j * 256 + lane * 4); }
#pragma unroll
    for (int j = 0; j < 4; ++j) B.x[j] = *(const f32x4*)(xm + (size_t)row * D + j * 256 + lane * 4);
}
__device__ __forceinline__ void cb_finish(const CbBuf& B, const Args& a, int L, const float* mod, int row, int lane) {
    const int bi = row < NL ? (row >> 12) : 4;
    f32x4 v[4];
#pragma unroll
    for (int j = 0; j < 4; ++j) { f32x4 acc = {0.f, 0.f, 0.f, 0.f};
#pragma unroll
        for (int k = 0; k < 4; ++k) { const u32x2 yv = B.y[k][j];
            acc += (f32x4){__builtin_bit_cast(float, yv.x << 16), __builtin_bit_cast(float, yv.x & 0xffff0000u), __builtin_bit_cast(float, yv.y << 16), __builtin_bit_cast(float, yv.y & 0xffff0000u)} * B.g[k]; }
        v[j] = B.x[j] + *(const f32x4*)(mod + (size_t)bi * 6144 + 5 * 1024 + j * 256 + lane * 4) * acc; }
    if (L == 0) {
        float* xb = (float*)(a.ws + WS_XB) + (size_t)row * D;
#pragma unroll
        for (int j = 0; j < 4; ++j) *(f32x4*)(xb + j * 256 + lane * 4) = v[j];
        const float* mod1 = (const float*)(a.ws + WS_MOD) + (size_t)5 * 6144;
        norm_mod_store(v, a.in[6] + D, mod1 + (size_t)bi * 6144, mod1 + (size_t)bi * 6144 + 1024, (bf16_t*)(a.ws + WS_HN) + (size_t)row * D, lane);
    } else {
        float ss = 0.f;
#pragma unroll
        for (int j = 0; j < 4; ++j) ss += (v[j].x * v[j].x + v[j].y * v[j].y) + (v[j].z * v[j].z + v[j].w * v[j].w);
        const float r = frsq(wave_sum(ss) * (1.f / D) + 1e-6f);
#pragma unroll
        for (int j = 0; j < 4; ++j) { const int c = j * 256 + lane * 4; *(f32x4*)(a.out + (size_t)row * D + c) = v[j] * r * *(const f32x4*)(a.in[37] + c); }
    }
}
__device__ __forceinline__ void phase_combine(const Args& a, int L, int nrows, const float* xm, int lane_, int wave, int bid, int G) {
    const float* mod = (const float*)(a.ws + WS_MOD) + (size_t)L * 5 * 6144;
    const int* tok = (const int*)(a.ws + WS_TOK + (size_t)L * TOK_STRIDE);
    const bf16_t* Y = (const bf16_t*)(a.ws + WS_Y);
    const int lane = opq(lane_), r0 = bid * 8 + wave, st = G * 8;
    if (r0 >= nrows) return;
    CbTok T0, T1; CbBuf A, B;
    cb_tok(T0, tok, r0); cb_load(A, T0, Y, xm, r0, lane);
    if (r0 + st < nrows) cb_tok(T1, tok, r0 + st);
    for (int row = r0; row < nrows; row += 2 * st) {
        const int r1 = row + st, r2 = row + 2 * st, r3 = row + 3 * st;
        if (r1 < nrows) cb_load(B, T1, Y, xm, r1, lane);
        if (r2 < nrows) cb_tok(T0, tok, r2);
        cb_finish(A, a, L, mod, row, lane);
        if (r1 < nrows) {
            if (r2 < nrows) cb_load(A, T0, Y, xm, r2, lane);
            if (r3 < nrows) cb_tok(T1, tok, r3);
            cb_finish(B, a, L, mod, r1, lane);
        }
    }
}

__global__ void __launch_bounds__(512, 2) fwd_kernel(Args a) {
    extern __shared__ __attribute__((aligned(16))) unsigned char lds_raw[];
    LAS unsigned char* lds = (LAS unsigned char*)lds_raw;
    const int wave0 = __builtin_amdgcn_readfirstlane((int)threadIdx.x >> 6), bid = blockIdx.x, G = gridDim.x;
    const int tid0 = threadIdx.x;
    volatile LAS unsigned* MISC = (volatile LAS unsigned*)(lds + MISC_OFF);
    for (int u = tid0; u < (LDS_BYTES - RING_BYTES) / 4; u += 512) ((LAS unsigned*)(lds + RING_BYTES))[u] = 0u;
    __syncthreads();
    const int lo = a.ph_lo, hi = a.ph_hi;
    XcdBarrier bar; bar.bar = (unsigned*)(a.ws + WS_CTL) + CW_BAR; bar.x = 0; bar.st = nullptr;
    if (hi - lo > 1) bar = xcd_barrier_post((unsigned*)(a.ws + WS_CTL) + CW_BAR, MISC + 8);
#define IN(k) (lo <= (k) && (k) < hi)
#define SEAM(k) do { if (IN(k) && IN((k) + 1)) xcd_barrier(bar); } while (0)

#define PH_IDS const int lane = lane_id_v(), wave = wave0, tid = wave0 * 64 + lane
    if (IN(0)) for (int rep_ = 0; rep_ < REPN(0); ++rep_) { PH_IDS; phase_prep(a, lds, tid, lane, wave, bid, G); __syncthreads(); }
    SEAM(0);
    if (IN(1)) { PH_IDS; phase_norm1(a, 0, a.in[0], a.in[2], lane, wave, bid, G); }
    SEAM(1);
    for (int L = 0; L < 2; ++L) {
        const int pb = 2 + L * 10;
        const float* xl = L == 0 ? a.in[0] : (const float*)(a.ws + WS_XB);
        const float* xc = L == 0 ? a.in[2] : (const float*)(a.ws + WS_XB) + (size_t)NL * D;
        const int nrows = L == 0 ? MALL : NL;
        float* xm = (float*)(a.ws + WS_XA);
        int* tok = (int*)(a.ws + WS_TOK + (size_t)L * TOK_STRIDE);
        if (IN(pb + 0)) for (int rep_ = 0; rep_ < REPN(2); ++rep_) {
            pg8::StaticSched S; S.init((const bf16_t*)(a.ws + WS_HN), (const bf16_t*)(a.ws + WS_WIN) + (size_t)L * INP * 1024, MALL, INP, 1024, G, bid);
            EpiP E{(float*)(a.ws + WS_P)};
            pg8::gemm_phase<EpiP, pg8::StaticSched>(lds, 1024, S, E, wave0);
        }
        SEAM(pb + 0);
        if (IN(pb + 1)) for (int rep_ = 0; rep_ < REPN(3); ++rep_) { PH_IDS; phase_mixprep(a, L, lds, lane, wave, bid, G); }
        SEAM(pb + 1);
        if (IN(pb + 2)) for (int rep_ = 0; rep_ < REPN(4); ++rep_) { for (int r2_ = 0; r2_ < 1 + (PROBE_SCAN & 1); ++r2_) { PH_IDS; for (int r3_ = 0; r3_ < 1 + ((PROBE_SCAN >> 2) & 1); ++r3_) phase_dnpre(a, lds, lane, wave, bid, G); for (int r3_ = 0; r3_ < 1 + ((PROBE_SCAN >> 3) & 1); ++r3_) phase_mbpre(a, lane, wave, bid, G); for (int r3_ = 0; r3_ < 1 + ((PROBE_SCAN >> 4) & 1); ++r3_) phase_rwpre(a, lds, lane, wave, bid, G); } if (hi - lo > 1) xcd_barrier(bar); for (int r2_ = 0; r2_ < 1 + ((PROBE_SCAN >> 1) & 1); ++r2_) { PH_IDS; phase_scan(a, lds, tid, bid, G); } }
        SEAM(pb + 2);
        if (IN(pb + 3)) for (int rep_ = 0; rep_ < REPN(5); ++rep_) { PH_IDS; phase_finish(a, L, nrows, lane, wave, bid, G); }
        SEAM(pb + 3);
        if (IN(pb + 4)) for (int rep_ = 0; rep_ < REPN(6); ++rep_) {
            pg8::StaticSched S; S.init((const bf16_t*)(a.ws + WS_YMIX), (const bf16_t*)(a.ws + WS_WOUT) + (size_t)L * 1024 * 1024, nrows, 1024, 1024, G, bid);
            EpiOut E{xl, xc, xm, (const float*)(a.ws + WS_MOD) + (size_t)L * 5 * 6144 + 2 * 1024};
            pg8::gemm_phase<EpiOut, pg8::StaticSched>(lds, 1024, S, E, wave0);
        }
        SEAM(pb + 4);
        if (IN(pb + 5)) { PH_IDS; phase_router(a, L, nrows, xm, lds, tid, lane, wave, bid, G); }
        SEAM(pb + 5);
        if (IN(pb + 6)) for (int rep_ = 0; rep_ < REPN(8); ++rep_) { PH_IDS; phase_scatter(a, L, nrows, lds, tid, lane, wave, bid, G); __syncthreads(); }
        SEAM(pb + 6);
        if (IN(pb + 7)) for (int rep_ = 0; rep_ < REPN(9); ++rep_) {
            pg8::MoeSched S; S.nN = 8; S.nunits = tok[TK_NBLK] * 8; S.G = G; S.c = bid; S.A = (const char*)(a.ws + WS_HS); S.W = (const char*)(a.ws + WS_WGU) + (size_t)L * 32 * 2048 * 1024;
            S.tstep = (size_t)256 * 1024; S.estride = (size_t)2048 * 1024; S.blk_e = tok + TK_BLKE;
            EpiGU E{(unsigned char*)(a.ws + WS_ACT), a.in[34] + (size_t)L * 32 * 2048, tok + TK_BLKE};
            pg8::gemm_phase<EpiGU, pg8::MoeSched, true>(lds, 512, S, E, wave0);
        }
        SEAM(pb + 7);
        if (IN(pb + 8)) for (int rep_ = 0; rep_ < REPN(10); ++rep_) {
            pg8::MoeSched S; S.nN = 4; S.nunits = tok[TK_NBLK] * 4; S.G = G; S.c = bid; S.A = (const char*)(a.ws + WS_ACT); S.W = (const char*)(a.ws + WS_WD) + (size_t)L * 32 * 1024 * 1024;
            S.tstep = (size_t)256 * 1024; S.estride = (size_t)1024 * 1024; S.blk_e = tok + TK_BLKE;
            EpiDown E{(bf16_t*)(a.ws + WS_Y), a.in[36] + (size_t)L * 32 * 1024, tok + TK_BLKE};
            pg8::gemm_phase<EpiDown, pg8::MoeSched, true>(lds, 512, S, E, wave0);
        }
        SEAM(pb + 8);
        if (IN(pb + 9)) for (int rep_ = 0; rep_ < REPN(11); ++rep_) { PH_IDS; phase_combine(a, L, nrows, xm, lane, wave, bid, G); }
        SEAM(pb + 9);
    }
#undef IN
#undef SEAM
}

extern "C" void kernel_launch(void* const* d_in, const int* in_sizes, int n_in, void* d_out, int out_size, void* d_ws, size_t ws_size, hipStream_t stream) {
    static int grid = 0;
    if (grid == 0) {
        if (n_in != 38 || ws_size < WS_END) { fprintf(stderr, "kernel_launch: unexpected n_in %d / ws %zu\n", n_in, ws_size); grid = -1; return; }
        int dev = 0, cus = 0, per_cu = 0;
        if (hipGetDevice(&dev) != hipSuccess || hipDeviceGetAttribute(&cus, hipDeviceAttributeMultiprocessorCount, dev) != hipSuccess) { grid = -1; return; }
        if (hipFuncSetAttribute((const void*)fwd_kernel, hipFuncAttributeMaxDynamicSharedMemorySize, LDS_BYTES) != hipSuccess) { fprintf(stderr, "kernel_launch: hipFuncSetAttribute failed\n"); grid = -1; return; }
        if (hipOccupancyMaxActiveBlocksPerMultiprocessor(&per_cu, (const void*)fwd_kernel, 512, LDS_BYTES) != hipSuccess || per_cu < 1) { fprintf(stderr, "kernel_launch: occupancy query says %d\n", per_cu); }
        (void)hipGetLastError();
        grid = cus;
    }
    if (grid < 0) return;
    (void)hipMemsetAsync((char*)d_ws + WS_CTL, 0, CTL_BYTES, stream);
    Args a{};
    for (int i = 0; i < 38; ++i) a.in[i] = (const float*)d_in[i];
    a.out = (float*)d_out; a.ws = (unsigned char*)d_ws;
#if MK_PER_PHASE
    for (int p = 0; p < NPHASE; ++p) { a.ph_lo = p; a.ph_hi = p + 1; hipLaunchKernelGGL(fwd_kernel, dim3(grid), dim3(512), LDS_BYTES, stream, a); }
#else
    a.ph_lo = 0; a.ph_hi = NPHASE;
    hipLaunchKernelGGL(fwd_kernel, dim3(grid), dim3(512), LDS_BYTES, stream, a);
#endif
}
```

```cpp
#include <hip/hip_runtime.h>
#include <cstdio>
#include <cstdint>

#ifndef PROBE_REP
#define PROBE_REP 0
#endif
#define REPN(k) ((((PROBE_REP) >> (k)) & 1) + 1)
#ifndef PROBE_SCAN
#define PROBE_SCAN 0
#endif
#ifndef PROBE_GK
#define PROBE_GK -1
#endif
#ifndef PROBE_GM
#define PROBE_GM 0
#endif
#ifndef STG_IN
#define STG_IN 0
#endif
#ifndef STG_DN
#define STG_DN 0
#endif
#ifndef PREP_IN_SCAN
#define PREP_IN_SCAN 0
#endif
#ifndef PROBE_MIX
#define PROBE_MIX 0
#endif
#ifndef MIXPARTS
#define MIXPARTS 7
#endif
#ifndef MK_PER_PHASE
#define MK_PER_PHASE 0
#endif

#define GAS __attribute__((address_space(1)))
#define LAS __attribute__((address_space(3)))
typedef unsigned short bf16_t;
typedef short bf16x8 __attribute__((ext_vector_type(8)));
typedef float f32x4 __attribute__((ext_vector_type(4)));
typedef unsigned u32x4 __attribute__((ext_vector_type(4)));
typedef unsigned u32x2 __attribute__((ext_vector_type(2)));

constexpr int D = 1024, NB = 4, SEQ = 4096, CTXL = 256;
constexpr int NL = NB * SEQ, NC = NB * CTXL, MALL = NL + NC;
constexpr int INC = 4184, INP = 4352;
constexpr int DN_OFF = 1032, RW_OFF = 3096;
constexpr int NE = 32, DFF = 1024;
constexpr int MAXBLK = 304, MAXSLOT = MAXBLK * 256;
constexpr int NPHASE = 22;

constexpr size_t MiB = 1u << 20;
constexpr size_t WS_CTL = 0, CTL_BYTES = 1 * MiB;
constexpr size_t WS_MOD = 1 * MiB;
constexpr size_t WS_LORA = 1 * MiB + 512 * 1024;
constexpr size_t WS_TOK = 1332 * MiB, TOK_STRIDE = 2 * MiB;
constexpr size_t WS_WIN = 4 * MiB, WS_WOUT = 21 * MiB, WS_WGU = 25 * MiB, WS_WD = 281 * MiB;
constexpr size_t WS_XA = 409 * MiB, WS_XB = 477 * MiB, WS_HN = 545 * MiB, WS_YMIX = 579 * MiB;
constexpr size_t WS_P = 613 * MiB, WS_MXBC = 902 * MiB, WS_MDT = 953 * MiB, WS_DNQKV = 955 * MiB, WS_DNGB = 1057 * MiB;
constexpr size_t WS_RWW = 1108 * MiB;
constexpr size_t WS_RW = 1060 * MiB, WS_RWG = 1179 * MiB, WS_YM = 1196 * MiB, WS_ODN = 1230 * MiB, WS_YRW = 1298 * MiB;
constexpr size_t WS_DNC = 1336 * MiB, WS_DNU = 1482 * MiB, WS_DNG = 1550 * MiB, WS_MBC = 1551 * MiB, WS_RWC = 1585 * MiB, WS_END = 1724 * MiB;
constexpr int DN_NSUB = (CTXL + SEQ) / 16, DN_UNITS = 32 * DN_NSUB, MB_UNITS = 8 * DN_NSUB;
constexpr int DN_UNITS_DUMMY = 0;
constexpr size_t WS_HS = WS_P, WS_ACT = 765 * MiB, WS_Y = 917 * MiB;
constexpr int CW_CNT = 64;
constexpr int CW_BAR = 4096;
constexpr int TK_ROWOF = 300000;
constexpr int TK_E = 0, TK_G = MALL * 4, TK_POS = MALL * 8, TK_SLOT = MALL * 12, TK_BLKE = MALL * 16, TK_NBLK = MALL * 16 + 512, TK_BCNT = MALL * 16 + 1024;

constexpr int RING_BYTES = 131072, LDS_BYTES = 147456, MISC_OFF = LDS_BYTES - 256;

struct Args { const float* in[38]; float* out; unsigned char* ws; int ph_lo, ph_hi; };

__device__ __forceinline__ unsigned f2bf(float f) { unsigned u = __builtin_bit_cast(unsigned, f); return (u + 0x7fffu + ((u >> 16) & 1u)) >> 16; }
__device__ __forceinline__ unsigned pk2(float lo, float hi) { return f2bf(lo) | (f2bf(hi) << 16); }
__device__ __forceinline__ f32x4 ldp4(const bf16_t* p) { const u32x2 v = *(const u32x2*)p; return (f32x4){__builtin_bit_cast(float, v.x << 16), __builtin_bit_cast(float, v.x & 0xffff0000u), __builtin_bit_cast(float, v.y << 16), __builtin_bit_cast(float, v.y & 0xffff0000u)}; }
__device__ __forceinline__ float frcp(float x) { return __builtin_amdgcn_rcpf(x); }
__device__ __forceinline__ float frsq(float x) { return __builtin_amdgcn_rsqf(x); }
typedef __bf16 bf16x2_t __attribute__((ext_vector_type(2)));
typedef float f32x2_ __attribute__((ext_vector_type(2)));
__device__ __forceinline__ unsigned cvt2(float lo, float hi) { const f32x2_ v = {lo, hi}; return __builtin_bit_cast(unsigned, __builtin_convertvector(v, bf16x2_t)); }
__device__ __forceinline__ f32x4 upk4(u32x2 v) { return (f32x4){__builtin_bit_cast(float, v.x << 16), __builtin_bit_cast(float, v.x & 0xffff0000u), __builtin_bit_cast(float, v.y << 16), __builtin_bit_cast(float, v.y & 0xffff0000u)}; }
__device__ __forceinline__ u32x2 pk4(f32x4 v) { u32x2 o; o.x = cvt2(v.x, v.y); o.y = cvt2(v.z, v.w); return o; }
__device__ __forceinline__ float bflo(unsigned v) { return __builtin_bit_cast(float, v << 16); }
__device__ __forceinline__ float bfhi(unsigned v) { return __builtin_bit_cast(float, v & 0xffff0000u); }
typedef float f32x2v __attribute__((ext_vector_type(2)));
typedef int i32x4_ __attribute__((ext_vector_type(4)));
typedef int i32x8_ __attribute__((ext_vector_type(8)));
__device__ __forceinline__ float sat8(float x) { return __builtin_amdgcn_fmed3f(x, -448.f, 448.f); }
__device__ __forceinline__ unsigned pk8(float a, float b, float c, float d) {
    int r = __builtin_amdgcn_cvt_pk_fp8_f32(sat8(a), sat8(b), 0, false); r = __builtin_amdgcn_cvt_pk_fp8_f32(sat8(c), sat8(d), r, true); return (unsigned)r; }
__device__ __forceinline__ i32x8_ cat8(bf16x8 lo, bf16x8 hi) { const i32x4_ a = __builtin_bit_cast(i32x4_, lo), b = __builtin_bit_cast(i32x4_, hi); return __builtin_shufflevector(a, b, 0, 1, 2, 3, 4, 5, 6, 7); }
__device__ __forceinline__ float siluf(float x) { return x * frcp(1.f + __expf(-x)); }
__device__ __forceinline__ float sigm(float x) { return frcp(1.f + __expf(-x)); }
__device__ __forceinline__ float softplusf(float x) { return fmaxf(x, 0.f) + __logf(1.f + __expf(-fabsf(x))); }
__device__ __forceinline__ float tanh_fast(float x) { return 1.f - 2.f * frcp(__expf(2.f * x) + 1.f); }
template <int CTRL> __device__ __forceinline__ float dppf(float v) { return __builtin_bit_cast(float, __builtin_amdgcn_update_dpp(0, __builtin_bit_cast(int, v), CTRL, 0xF, 0xF, true)); }
__device__ __forceinline__ void pswap16(float& a, float& b) { asm("s_nop 1\n\tv_permlane16_swap_b32 %0, %1" : "+v"(a), "+v"(b)); }
__device__ __forceinline__ void pswap32(float& a, float& b) { asm("s_nop 1\n\tv_permlane32_swap_b32 %0, %1" : "+v"(a), "+v"(b)); }
template <int W> __device__ __forceinline__ float grp_sum(float v) {
    v += dppf<0xB1>(v); v += dppf<0x4E>(v); v += dppf<0x141>(v); v += dppf<0x140>(v);
    if (W >= 32) { float a = v, b = v; pswap16(a, b); v = a + b; }
    if (W >= 64) { float a = v, b = v; pswap32(a, b); v = a + b; }
    return v;
}
__device__ __forceinline__ float wave_sum(float v) { return grp_sum<64>(v); }
__device__ __forceinline__ float wave_max(float v) {
    v = fmaxf(v, dppf<0xB1>(v)); v = fmaxf(v, dppf<0x4E>(v)); v = fmaxf(v, dppf<0x141>(v)); v = fmaxf(v, dppf<0x140>(v));
    { float a = v, b = v; pswap16(a, b); v = fmaxf(a, b); }
    { float a = v, b = v; pswap32(a, b); v = fmaxf(a, b); }
    return v;
}
#define LDS_BARRIER() asm volatile("s_waitcnt lgkmcnt(0)\n\ts_barrier" ::: "memory")
#define LDS_WAIT() asm volatile("" ::: "memory")
__device__ __forceinline__ int lane_id_v() { int l; asm volatile("v_mbcnt_lo_u32_b32 %0, -1, 0\n\tv_mbcnt_hi_u32_b32 %0, -1, %0" : "=v"(l)); return l; }
__device__ __forceinline__ int opq(int v) { asm volatile("" : "+v"(v)); return v; }

#define XB_TMO      128
#define XB_XCNT(j)  (256  + 64 * (j))
#define XB_XSUB(j)  (1280 + 64 * (j))
#define XB_XGEN(j)  (2304 + 64 * (j))
#define XB_TOP      3328
#define XB_TOPGEN   3392
#define XCD_BAR_WORDS 3456
#define XB_SPIN_CAP (1u << 18)
__device__ __forceinline__ unsigned xb_ld(unsigned* p)              { return __hip_atomic_load(p, __ATOMIC_RELAXED, __HIP_MEMORY_SCOPE_AGENT); }
__device__ __forceinline__ unsigned xb_add(unsigned* p, unsigned v) { return __hip_atomic_fetch_add(p, v, __ATOMIC_RELAXED, __HIP_MEMORY_SCOPE_AGENT); }
__device__ __forceinline__ unsigned xb_xcc_id() { return (unsigned)__builtin_amdgcn_s_getreg((3 << 11) | 20) & 0xFu; }
#define XB_SPIN(cond, bar) do { unsigned _sp = 0; while (cond) { __builtin_amdgcn_s_sleep(1); \
    if ((++_sp & 255u) == 0u) { if (xb_ld(&(bar)[XB_TMO])) break; if (_sp > XB_SPIN_CAP) { atomicAdd(&(bar)[XB_TMO], 1u); break; } } } } while (0)
struct XcdBarrier { unsigned* bar; unsigned x; volatile LAS unsigned* st; };
__device__ __forceinline__ XcdBarrier xcd_barrier_post(unsigned* bar, volatile LAS unsigned* st) {
    XcdBarrier b; b.bar = bar; b.x = xb_xcc_id(); b.st = st;
    if (threadIdx.x == 0) (void)xb_add(&bar[XB_XCNT(b.x)], 1u);
    return b;
}
__device__ __forceinline__ void xcd_barrier_complete(unsigned* bar, unsigned x, unsigned& nloc, unsigned& nx) {
    const unsigned G = gridDim.x * gridDim.y * gridDim.z;
    unsigned sum, cnt, mine, sp = 0u;
    for (;;) {
        sum = 0u; cnt = 0u; mine = 0u;
#pragma unroll
        for (unsigned j = 0; j < 16; ++j) { const unsigned c = xb_ld(&bar[XB_XCNT(j)]); sum += c; cnt += (c > 0u) ? 1u : 0u; mine = (j == x) ? c : mine; }
        if (sum == G) break;
        __builtin_amdgcn_s_sleep(1);
        if ((++sp & 255u) == 0u) { if (xb_ld(&bar[XB_TMO])) break; if (sp > XB_SPIN_CAP) { atomicAdd(&bar[XB_TMO], 1u); break; } }
    }
    nloc = mine > 0u ? mine : 1u; nx = cnt > 0u ? cnt : 1u;
}
__device__ __forceinline__ void xcd_barrier(const XcdBarrier& b) {
    asm volatile("s_waitcnt vmcnt(0)" ::: "memory");
    __syncthreads();
    if (threadIdx.x == 0) {
        unsigned* bar = b.bar;
        __builtin_amdgcn_s_waitcnt(0);
        unsigned nloc = b.st[0], nx = b.st[1];
        if (nloc == 0u) { xcd_barrier_complete(bar, b.x, nloc, nx); b.st[0] = nloc; b.st[1] = nx; }
        const unsigned old = xb_add(&bar[XB_XSUB(b.x)], 1u);
        const unsigned gen = old / nloc;
        if (old + 1u == (gen + 1u) * nloc) {
            __builtin_amdgcn_fence(__ATOMIC_RELEASE, "agent");
            asm volatile("s_waitcnt vmcnt(0)" ::: "memory");
            const unsigned og = xb_add(&bar[XB_TOP], 1u);
            const unsigned tg = og / nx;
            if (og + 1u == (tg + 1u) * nx) xb_add(&bar[XB_TOPGEN], 1u);
            else XB_SPIN(xb_ld(&bar[XB_TOPGEN]) == tg, bar);
            __builtin_amdgcn_fence(__ATOMIC_ACQUIRE, "agent");
            xb_add(&bar[XB_XGEN(b.x)], 1u);
            asm volatile("s_waitcnt vmcnt(0)" ::: "memory");
        } else {
            XB_SPIN(xb_ld(&bar[XB_XGEN(b.x)]) == gen, bar);
            __builtin_amdgcn_fence(__ATOMIC_ACQUIRE, "agent");
            asm volatile("s_waitcnt vmcnt(0)" ::: "memory");
        }
    }
    __syncthreads();
}

namespace pg8 {
constexpr int BM = 256, BK = 64, HALF = 128, HTB = HALF * BK * 2, STAGE_BYTES = 8 * HTB, NXCD = 8, WGM = 4;
__host__ __device__ __forceinline__ int lds_byte(int r, int c) { const int st = (r >> 4) * 2 + (c >> 5), rr = r & 15, cc = c & 31, ob = rr * 64 + cc * 2; return st * 1024 + (ob ^ (((ob >> 9) & 1) << 5)); }
__host__ __device__ __forceinline__ void stage_rc(int b, int& R, int& C) { const int st = b / 1024, sb = b % 1024, swz = sb ^ (((sb >> 9) & 1) << 5); R = (st >> 1) * 16 + swz / 64; C = (st & 1) * 32 + (swz % 64) / 2; }
struct Unit { int pm, pn, e; };

struct StaticSched {
    int nM, nN, nwg, G, c; const char* A; const char* Bt; size_t tstep; const int* rowof;
    __device__ void init(const bf16_t* A_, const bf16_t* Bt_, int M, int N, int K, int G_, int c_) { nM = M / BM; nN = N / BM; nwg = nM * nN; G = G_; c = c_; A = (const char*)A_; Bt = (const char*)Bt_; tstep = (size_t)BM * K * 2; }
    __device__ bool next(int i, Unit& u) const {
        const long L = (long)i * G + c; if (L >= nwg) return false;
        int wgid = (int)L; { const int q = nwg / NXCD, r = nwg % NXCD, xcd = wgid % NXCD, off = wgid / NXCD; wgid = (xcd < r ? xcd * (q + 1) : r * (q + 1) + (xcd - r) * q) + off; }
        const int nig = WGM * nN, gid = wgid / nig, fm = gid * WGM, gsz = (nM - fm) < WGM ? (nM - fm) : WGM;
        u.pm = fm + ((wgid % nig) % gsz); u.pn = (wgid % nig) / gsz; return true;
    }
    __device__ __forceinline__ const char* a_base(const Unit& u) const { return A + (size_t)u.pm * tstep; }
    __device__ __forceinline__ const char* b_base(const Unit& u) const { return Bt + (size_t)u.pn * tstep; }
    __device__ __forceinline__ bool slack() const { const int r = nwg % G; return r != 0 && c >= r; }
    __device__ __forceinline__ int e_load(const Unit&) const { return 0; }
    __device__ __forceinline__ const char* b_base_e(const Unit& u, int) const { return b_base(u); }
};
struct MoeSched {
    int nunits, nN, G, c; const char* A; const char* W; size_t tstep, astep, estride; const int* blk_e; const int* rowof;
    __device__ bool next(int i, Unit& u) const {
        long L;
        if ((G & 7) == 0) { const int per = (nunits + 7) >> 3, v = i * (G >> 3) + (c >> 3); if (v >= per) return false; L = (long)(c & 7) * per + v; }
        else L = (long)i * G + c;
        if (L >= nunits) return false; u.pm = (int)(L / nN); u.pn = (int)(L % nN); return true; }
    __device__ __forceinline__ const char* a_base(const Unit& u) const { return A + (size_t)u.pm * astep; }
    __device__ __forceinline__ const char* b_base(const Unit& u) const { return W + (size_t)blk_e[u.pm] * estride + (size_t)u.pn * tstep; }
    __device__ __forceinline__ int e_load(const Unit& u) const { return blk_e[u.pm]; }
    __device__ __forceinline__ const char* b_base_e(const Unit& u, int e) const { return W + (size_t)e * estride + (size_t)u.pn * tstep; }
    __device__ __forceinline__ bool slack() const { if (G & 7) return false; const int per = (nunits + 7) >> 3, r = per % (G >> 3); return r != 0 && (c >> 3) >= r; }
};

template <class Epi, class Sched, bool FP8 = false, int KIND = 0, bool GATHER = false>
__device__ __forceinline__ void gemm_phase(LAS unsigned char* lds, const int K, const Sched& S, const Epi& E, const int wave0, const int stagger = 0) {
    const int lane = lane_id_v(), wid = wave0, tid = wid * 64 + lane, wr = wid >> 2, wc = wid & 3, fr = lane & 15, fq = lane >> 4;
    const int nt = K / BK;
    unsigned voffA[2], voffB[2];
#pragma unroll
    for (int i = 0; i < 2; ++i) { int R, C; stage_rc(tid * 16 + i * 8192, R, C); voffA[i] = (unsigned)(R * K + C) * 2u; voffB[i] = voffA[i]; }
    asm volatile("" : "+v"(voffA[0]), "+v"(voffA[1]), "+v"(voffB[0]), "+v"(voffB[1]));
    const size_t kstep = (size_t)(BK * 2);
    const size_t hstep = (size_t)HALF * K * 2;
    const unsigned ldsw = (unsigned)wid * 1024u;
    const int aoff = lds_byte(wr * 64 + fr, fq * 8), boff = lds_byte(wc * 32 + fr, fq * 8);
#define PG8_SA(b, h) (((b) * 2 + (h)) * HTB)
#define PG8_SB(b, h) ((4 + (b) * 2 + (h)) * HTB)
#define PG8_STAGE(bufoff, gbase, voff) do { _Pragma("unroll") for (int _i = 0; _i < 2; ++_i) \
        __builtin_amdgcn_global_load_lds((const unsigned*)((const char*)(gbase) + (voff)[_i]), (LAS unsigned*)(lds + (bufoff) + ldsw + _i * 8192), 16, 0, 0); } while (0)
#define PG8_LD1(d2, d8, i, p_) do { if (FP8) { const i32x4_ lo_ = *(const LAS i32x4_*)(p_), hi_ = *(const LAS i32x4_*)((p_) + 1024); d8[i] = __builtin_shufflevector(lo_, hi_, 0, 1, 2, 3, 4, 5, 6, 7); } \
        else { d2[i][0] = *(const LAS bf16x8*)(p_); d2[i][1] = *(const LAS bf16x8*)((p_) + 1024); } } while (0)
#define PG8_LDA(dst, b, h) do { _Pragma("unroll") for (int m = 0; m < 4; ++m) PG8_LD1(dst, dst##8, m, lds + PG8_SA(b, h) + aoff + m * 2048); } while (0)
#define PG8_LDB(dst, b, h) do { _Pragma("unroll") for (int n = 0; n < 2; ++n) PG8_LD1(dst, dst##8, n, lds + PG8_SB(b, h) + boff + n * 2048); } while (0)
#define PG8_MMA(ai, bj, At, Bt) do { __builtin_amdgcn_s_setprio(1); _Pragma("unroll") for (int m = 0; m < 4; ++m) _Pragma("unroll") for (int n = 0; n < 2; ++n) { \
        if (FP8) asm volatile("v_mfma_f32_16x16x128_f8f6f4 %0, %1, %2, %0" : "+v"(acc[ai][bj][m][n]) : "v"(Bt##8[n]), "v"(At##8[m]));       \
        else { _Pragma("unroll") for (int k = 0; k < 2; ++k) acc[ai][bj][m][n] = __builtin_amdgcn_mfma_f32_16x16x32_bf16(Bt[n][k], At[m][k], acc[ai][bj][m][n], 0, 0, 0); } } __builtin_amdgcn_s_setprio(0); } while (0)
#define PG8_MMAZ(ai, bj, At, Bt, first) do { if (FP8 && (first)) { __builtin_amdgcn_s_setprio(1); _Pragma("unroll") for (int m = 0; m < 4; ++m) _Pragma("unroll") for (int n = 0; n < 2; ++n) \
        asm volatile("v_mfma_f32_16x16x128_f8f6f4 %0, %1, %2, 0" : "=v"(acc[ai][bj][m][n]) : "v"(Bt##8[n]), "v"(At##8[m]));   \
        __builtin_amdgcn_s_setprio(0); } else PG8_MMA(ai, bj, At, Bt); } while (0)
#define PG8_STAGE_A(b, h, ptr) do { if (GATHER) { _Pragma("unroll") for (int _i = 0; _i < 2; ++_i) { const unsigned o_ = ((vp[_i] >> (16 * (h))) & 0xffffu) * 1024u + (voffB[_i] & 1023u); \
        __builtin_amdgcn_global_load_lds((const unsigned*)((const char*)(ptr) + o_), (LAS unsigned*)(lds + PG8_SA(b, h) + ldsw + _i * 8192), 16, 0, 0); } } else PG8_STAGE(PG8_SA(b, h), (ptr) + (h) * hstep, voffA); } while (0)
#define PG8_RAW(u_, raw_) do { _Pragma("unroll") for (int h_ = 0; h_ < 2; ++h_) _Pragma("unroll") for (int i_ = 0; i_ < 2; ++i_) raw_[h_][i_] = S.rowof[(u_).pm * 256 + h_ * 128 + (int)(voffB[i_] >> 10)]; } while (0)
#define PG8_MKV(v_, raw_) do { _Pragma("unroll") for (int i_ = 0; i_ < 2; ++i_) v_[i_] = (unsigned)raw_[0][i_] | ((unsigned)raw_[1][i_] << 16); } while (0)
#define PG8_WAIT_V(n) asm volatile("s_waitcnt vmcnt(" #n ")" ::: "memory")
#define PG8_WAIT_L(n) asm volatile("s_waitcnt lgkmcnt(" #n ")" ::: "memory")
#define PG8_BAR __builtin_amdgcn_s_barrier()
#define PG8_SCHED __builtin_amdgcn_sched_barrier(0)
    constexpr bool K2 = (PROBE_GK == KIND) && (PROBE_GM & 1), E2 = (PROBE_GK == KIND) && (PROBE_GM & 2);
    Unit cur, nxt; int ui = 0;
    if (!S.next(0, cur)) return;
    if (stagger > 0 && S.slack()) { const unsigned long long t0 = __builtin_amdgcn_s_memrealtime(); while (__builtin_amdgcn_s_memrealtime() - t0 < (unsigned long long)stagger) __builtin_amdgcn_s_sleep(32); }
    int scl1 = 0x7F7F7F7F; asm volatile("" : "+v"(scl1));
    f32x4 acc[2][2][4][2];
#pragma unroll
    for (int a = 0; a < 2; ++a)
#pragma unroll
        for (int b = 0; b < 2; ++b)
#pragma unroll
            for (int m = 0; m < 4; ++m)
#pragma unroll
                for (int n = 0; n < 2; ++n) if (!FP8) acc[a][b][m][n] = (f32x4){0.f, 0.f, 0.f, 0.f};
    bf16x8 At[4][2], B0[2][2], B1[2][2]; i32x8_ At8[4], B08[2], B18[2];
    cur.e = __builtin_amdgcn_readfirstlane(S.e_load(cur));
    const char* cA = S.a_base(cur); const char* cB = S.b_base_e(cur, cur.e);
    int eraw = 0; if (S.next(K2 ? 0 : 1, nxt)) eraw = S.e_load(nxt);
    unsigned vp[2], nvp[2]; int raw[2][2];
    if (GATHER) { PG8_RAW(cur, raw); PG8_MKV(vp, raw); if (S.next(K2 ? 0 : 1, nxt)) PG8_RAW(nxt, raw); }
    PG8_STAGE(PG8_SB(0, 0), cB, voffB); PG8_STAGE_A(0, 0, cA); PG8_STAGE(PG8_SB(0, 1), cB + hstep, voffB); PG8_STAGE_A(0, 1, cA);
    if (wr == 1) PG8_BAR;
    PG8_WAIT_V(4); PG8_BAR;
    PG8_STAGE(PG8_SB(1, 0), cB + kstep, voffB); PG8_STAGE_A(1, 0, cA + kstep); PG8_STAGE(PG8_SB(1, 1), cB + hstep + kstep, voffB);
    PG8_WAIT_V(6); PG8_BAR;
    for (;;) {
        const bool has_next = S.next(K2 ? ((ui + 1) >> 1) : (ui + 1), nxt);
        if (GATHER) PG8_MKV(nvp, raw);
        nxt.e = __builtin_amdgcn_readfirstlane(eraw);
        const char* nA = has_next ? S.a_base(nxt) : cA; const char* nB = has_next ? S.b_base_e(nxt, nxt.e) : cB;
        for (int t = 0; t < nt; t += 2) {
            const bool last = (t == nt - 2);
            const char* a1 = cA + (size_t)(t + 1) * kstep;
            const char* a2 = last ? nA : cA + (size_t)(t + 2) * kstep; const char* b2 = last ? nB : cB + (size_t)(t + 2) * kstep;
            const char* a3 = a2 + kstep; const char* b3 = b2 + kstep;
            PG8_LDB(B0, 0, 0); PG8_SCHED; PG8_LDA(At, 0, 0); PG8_STAGE_A(1, 1, a1);
            if (GATHER && last && has_next) { vp[0] = nvp[0]; vp[1] = nvp[1]; }
            PG8_WAIT_L(8); PG8_BAR; PG8_WAIT_L(0); PG8_MMAZ(0, 0, At, B0, t == 0); PG8_BAR; PG8_SCHED;
            PG8_LDB(B1, 0, 1); PG8_STAGE(PG8_SB(0, 0), b2, voffB);
            PG8_BAR; PG8_WAIT_L(0); PG8_MMAZ(0, 1, At, B1, t == 0); PG8_BAR;
            PG8_LDA(At, 0, 1); PG8_STAGE_A(0, 0, a2);
            PG8_BAR; PG8_WAIT_L(0); PG8_MMAZ(1, 0, At, B0, t == 0); PG8_BAR; PG8_SCHED;
            PG8_STAGE(PG8_SB(0, 1), b2 + hstep, voffB);
            PG8_WAIT_V(6); PG8_BAR; PG8_MMAZ(1, 1, At, B1, t == 0); PG8_BAR;
            PG8_LDB(B0, 1, 0); PG8_SCHED; PG8_LDA(At, 1, 0); PG8_STAGE_A(0, 1, a2);
            PG8_WAIT_L(8); PG8_BAR; PG8_WAIT_L(0); PG8_MMA(0, 0, At, B0); PG8_BAR; PG8_SCHED;
            PG8_LDB(B1, 1, 1); PG8_STAGE(PG8_SB(1, 0), b3, voffB);
            PG8_BAR; PG8_WAIT_L(0); PG8_MMA(0, 1, At, B1); PG8_BAR;
            PG8_LDA(At, 1, 1); PG8_STAGE_A(1, 0, a3);
            PG8_BAR; PG8_WAIT_L(0); PG8_MMA(1, 0, At, B0); PG8_BAR; PG8_SCHED;
            PG8_STAGE(PG8_SB(1, 1), b3 + hstep, voffB);
            PG8_WAIT_V(6); PG8_BAR; PG8_MMA(1, 1, At, B1); PG8_BAR;
        }
        if (FP8) asm volatile("s_nop 15\n\ts_nop 3" ::: "memory");
        { Unit n2; if (S.next(K2 ? ((ui + 2) >> 1) : (ui + 2), n2)) { eraw = S.e_load(n2); if (GATHER) PG8_RAW(n2, raw); } }
        if (!K2 || (ui & 1)) { E(acc, cur, wr, wc, fr, fq); if (E2) { asm volatile("" ::: "memory"); E(acc, cur, wr, wc, fr, fq); } }
        if (!has_next) break;
#pragma unroll
        for (int a = 0; a < 2; ++a)
#pragma unroll
            for (int b = 0; b < 2; ++b)
#pragma unroll
                for (int m = 0; m < 4; ++m)
#pragma unroll
                    for (int n = 0; n < 2; ++n) if (!FP8) acc[a][b][m][n] = (f32x4){0.f, 0.f, 0.f, 0.f};
        cur = nxt; cA = nA; cB = nB; ++ui;
    }
    PG8_WAIT_V(0);
    if (wr == 0) PG8_BAR;
    PG8_BAR;
#undef PG8_SA
#undef PG8_SB
#undef PG8_STAGE
#undef PG8_STAGE_A
#undef PG8_RAW
#undef PG8_MKV
#undef PG8_LDA
#undef PG8_LD1
#undef PG8_LDB
#undef PG8_MMA
#undef PG8_MMAZ
#undef PG8_WAIT_V
#undef PG8_WAIT_L
#undef PG8_BAR
#undef PG8_SCHED
}
}

__device__ __forceinline__ int rowify_addr(int lane) { const int R = lane >> 3, c = lane & 7; return 4 * ((c & 3) * 16 + R + 8 * (c >> 2)); }
template <int W> __device__ __forceinline__ void rowify(const unsigned (&v0)[W], const unsigned (&v1)[W], unsigned (&o0)[W], unsigned (&o1)[W], int baddr) {
#pragma unroll
    for (int j = 0; j < W; ++j) {
        const int u0 = __builtin_amdgcn_update_dpp((int)v0[j], (int)v1[j], 0x128, 0xF, 0xC, false);
        const int u1 = __builtin_amdgcn_update_dpp((int)v1[j], (int)v0[j], 0x128, 0xF, 0x3, false);
        o0[j] = (unsigned)__builtin_amdgcn_ds_bpermute(baddr, u0); o1[j] = (unsigned)__builtin_amdgcn_ds_bpermute(baddr, u1); }
}
struct EpiP {
    bf16_t* C;
    __device__ __forceinline__ void operator()(const f32x4 (&acc)[2][2][4][2], const pg8::Unit& u, int wr, int wc, int fr, int fq) const {
        const int lane = fq * 16 + fr, baddr = rowify_addr(lane), R = lane >> 3, c = lane & 7;
        const int row0 = u.pm * 256 + wr * 64 + R, col0 = u.pn * 256 + wc * 32 + 4 * c;
#pragma unroll
        for (int ai = 0; ai < 2; ++ai)
#pragma unroll
            for (int m = 0; m < 4; ++m) { bf16_t* rowp = C + (size_t)(row0 + ai * 128 + m * 16) * INP + col0;
#pragma unroll
                for (int bj = 0; bj < 2; ++bj) { unsigned v[2][2], o0[2], o1[2];
#pragma unroll
                    for (int n = 0; n < 2; ++n) { const f32x4 t = acc[ai][bj][m][n]; v[n][0] = cvt2(t.x, t.y); v[n][1] = cvt2(t.z, t.w); }
                    rowify<2>(v[0], v[1], o0, o1, baddr);
                    *(u32x2*)(rowp + bj * 128) = (u32x2){o0[0], o0[1]}; *(u32x2*)(rowp + (size_t)8 * INP + bj * 128) = (u32x2){o1[0], o1[1]}; } }
    }
};
struct EpiOut {
    const void* xl; const void* xc; bf16_t* xo; const float* gate; int xbf;
    template <bool XBF> __device__ __forceinline__ void body(const f32x4 (&acc)[2][2][4][2], const pg8::Unit& u, int wr, int wc, int fr, int fq) const {
        constexpr int PF = XBF ? 6 : 4;
        const bool lat = u.pm < 64; const int bi = lat ? (u.pm >> 4) : 4;
        const void* xin = lat ? xl : xc; const size_t xbase = (size_t)(lat ? u.pm : u.pm - 64) * 256 * D;
        bf16_t* xop = xo + (size_t)u.pm * 256 * D;
        const int lane = opq(fq * 16 + fr), baddr = rowify_addr(lane), R = lane >> 3, c = lane & 7;
        const int r0 = wr * 64 + R, c0 = u.pn * 256 + wc * 32 + 4 * c;
        f32x4 gv[2];
#pragma unroll
        for (int bj = 0; bj < 2; ++bj) gv[bj] = *(const f32x4*)(gate + (size_t)bi * 6144 + c0 + bj * 128);
        f32x4 xf[16][2]; u32x2 xh[16][2];
#define EO_RO(st) ((size_t)(r0 + ((st) >> 3) * 128 + (((st) >> 1) & 3) * 16) * D + c0 + ((st) & 1) * 128)
#define EO_LD(st) do { if (XBF) { const bf16_t* xp = (const bf16_t*)xin + xbase + EO_RO(st); xh[st][0] = *(const u32x2*)xp; xh[st][1] = *(const u32x2*)(xp + 8 * D); } \
                       else { const float* xp = (const float*)xin + xbase + EO_RO(st); xf[st][0] = *(const f32x4*)xp; xf[st][1] = *(const f32x4*)(xp + 8 * D); } } while (0)
#pragma unroll
        for (int st = 0; st < PF; ++st) EO_LD(st);
#pragma unroll
        for (int st = 0; st < 16; ++st) { const int ai = st >> 3, m = (st >> 1) & 3, bj = st & 1;
            if (st + PF < 16) EO_LD(st + PF);
            const f32x4 x0 = XBF ? upk4(xh[st][0]) : xf[st][0], x1 = XBF ? upk4(xh[st][1]) : xf[st][1];
            unsigned v0[4], v1[4], o0[4], o1[4];
#pragma unroll
            for (int i = 0; i < 4; ++i) { const float t0 = acc[ai][bj][m][0][i], t1 = acc[ai][bj][m][1][i]; v0[i] = __builtin_bit_cast(unsigned, t0); v1[i] = __builtin_bit_cast(unsigned, t1); }
            rowify<4>(v0, v1, o0, o1, baddr);
            f32x4 a0, a1;
#pragma unroll
            for (int i = 0; i < 4; ++i) { a0[i] = __builtin_bit_cast(float, o0[i]); a1[i] = __builtin_bit_cast(float, o1[i]); }
            *(u32x2*)(xop + EO_RO(st)) = pk4(x0 + gv[bj] * a0); *(u32x2*)(xop + EO_RO(st) + 8 * D) = pk4(x1 + gv[bj] * a1); }
#undef EO_LD
#undef EO_RO
    }
    __device__ __forceinline__ void operator()(const f32x4 (&acc)[2][2][4][2], const pg8::Unit& u, int wr, int wc, int fr, int fq) const {
        if (xbf) body<true>(acc, u, wr, wc, fr, fq); else body<false>(acc, u, wr, wc, fr, fq);
    }
};
struct EpiGU {
    unsigned char* act; const float* bias; const int* blk_e;
    __device__ __forceinline__ void operator()(const f32x4 (&acc)[2][2][4][2], const pg8::Unit& u, int wr, int wc, int fr, int fq) const {
        const int e = u.e;
        const float* bg = bias + (size_t)e * 2048 + u.pn * 128 + wc * 32 + 4 * fq;
        f32x4 bgv[2], buv[2];
#pragma unroll
        for (int n = 0; n < 2; ++n) { bgv[n] = *(const f32x4*)(bg + n * 16); buv[n] = *(const f32x4*)(bg + 1024 + n * 16); }
        const int lane = fq * 16 + fr, baddr = rowify_addr(lane), R = lane >> 3, c = lane & 7;
#pragma unroll
        for (int ai = 0; ai < 2; ++ai)
#pragma unroll
            for (int m = 0; m < 4; ++m) { unsigned char* rowp = act + (size_t)(u.pm * 256 + ai * 128 + wr * 64 + m * 16 + R) * DFF + u.pn * 128 + wc * 32 + 4 * c;
                unsigned v[2][1], o0[1], o1[1];
#pragma unroll
                for (int n = 0; n < 2; ++n) { const f32x4 g = acc[ai][0][m][n] * 0.03125f + bgv[n], uu = acc[ai][1][m][n] * 0.03125f + buv[n]; float o[4];
#pragma unroll
                    for (int i = 0; i < 4; ++i) { const float g_ = fminf(g[i], 7.f), u_ = __builtin_amdgcn_fmed3f(uu[i], -7.f, 7.f);
                        const float gs = g_ * __builtin_amdgcn_rcpf(1.f + __builtin_amdgcn_exp2f(g_ * -2.4554669595930156f));
                        o[i] = __builtin_fmaf(gs, u_, gs); }
                    { int r_ = __builtin_amdgcn_cvt_pk_fp8_f32(o[0], o[1], 0, false); r_ = __builtin_amdgcn_cvt_pk_fp8_f32(o[2], o[3], r_, true); v[n][0] = (unsigned)r_; } }
                rowify<1>(v[0], v[1], o0, o1, baddr);
                *(unsigned*)rowp = o0[0]; *(unsigned*)(rowp + 8 * DFF) = o1[0]; }
    }
};
struct EpiDown {
    unsigned char* Y; const float* bias; const int* blk_e;
    __device__ __forceinline__ void operator()(const f32x4 (&acc)[2][2][4][2], const pg8::Unit& u, int wr, int wc, int fr, int fq) const {
        const int e = u.e;
        const int lane = fq * 16 + fr, baddr = rowify_addr(lane), R = lane >> 3, c = lane & 7;
        const int row0 = u.pm * 256 + wr * 64 + R, col0 = u.pn * 256 + wc * 32;
        f32x4 bv[2][2];
#pragma unroll
        for (int bj = 0; bj < 2; ++bj)
#pragma unroll
            for (int n = 0; n < 2; ++n) bv[bj][n] = *(const f32x4*)(bias + (size_t)e * D + col0 + 4 * fq + bj * 128 + n * 16);
#pragma unroll
        for (int ai = 0; ai < 2; ++ai)
#pragma unroll
            for (int m = 0; m < 4; ++m) { unsigned char* rowp = Y + (size_t)(row0 + ai * 128 + m * 16) * D + col0 + 4 * c;
#pragma unroll
                for (int bj = 0; bj < 2; ++bj) { unsigned v[2][1], o0[1], o1[1];
#pragma unroll
                    for (int n = 0; n < 2; ++n) { const f32x4 t = acc[ai][bj][m][n] * 0.03125f + bv[bj][n]; v[n][0] = pk8(t.x, t.y, t.z, t.w); }
                    rowify<1>(v[0], v[1], o0, o1, baddr);
                    *(unsigned*)(rowp + bj * 128) = o0[0]; *(unsigned*)(rowp + (size_t)8 * D + bj * 128) = o1[0]; } }
    }
};

template <int MODE, bool FP8 = false>
__device__ __forceinline__ void transpose_item(const float* W, int ldn, int nvalid, bf16_t* WT, LAS float* scr, int kb, int nb, int lane) {
    const int k0 = 64 * kb, n0 = 32 * nb;
    const int nn = n0 + (lane & 31); const bool ok = nn < nvalid; const int nc = ok ? nn : nvalid - 1;
#pragma unroll 8
    for (int i = 0; i < 32; ++i) { const int kk = 2 * i + (lane >> 5); const float wv = __builtin_nontemporal_load(W + (size_t)(k0 + kk) * ldn + nc); scr[kk * 33 + (lane & 31)] = ok ? wv : 0.f; }
    LDS_WAIT(); asm volatile("" ::: "memory");
    const int c = lane & 7;
#pragma unroll
    for (int j = 0; j < 4; ++j) { const int n = (lane >> 3) + 8 * j; const LAS float* s = scr + (8 * c) * 33 + n;
        int gn = n0 + n, drow = gn;
        if (MODE == 1) drow = (gn < 1024) ? ((gn >> 7) * 256 + (gn & 127)) : (((gn - 1024) >> 7) * 256 + 128 + ((gn - 1024) & 127));
        if (FP8) { u32x2 o; o.x = pk8(32.f * s[0 * 33], 32.f * s[1 * 33], 32.f * s[2 * 33], 32.f * s[3 * 33]); o.y = pk8(32.f * s[4 * 33], 32.f * s[5 * 33], 32.f * s[6 * 33], 32.f * s[7 * 33]);
            *(u32x2*)((unsigned char*)WT + (size_t)drow * 1024 + k0 + 8 * c) = o; }
        else { u32x4 o; o.x = pk2(s[0 * 33], s[1 * 33]); o.y = pk2(s[2 * 33], s[3 * 33]); o.z = pk2(s[4 * 33], s[5 * 33]); o.w = pk2(s[6 * 33], s[7 * 33]);
            *(u32x4*)(WT + (size_t)drow * 1024 + k0 + 8 * c) = o; } }
    LDS_WAIT(); asm volatile("" ::: "memory");
}
__device__ __forceinline__ void phase_prep(const Args& a, LAS unsigned char* lds, int tid, int lane, int wave, int bid, int G) {
    LAS float* scr = (LAS float*)(lds + wave * 16384);
    const int gw = bid * 8 + wave, NGW = G * 8;
    constexpr int I_IN = 16 * 136, I_OUT = 16 * 32, I_GU = 16 * 64, I_D = 16 * 32;
    constexpr int N_IN = 2 * I_IN, N_OUT = 2 * I_OUT, N_GU = (PREP_IN_SCAN ? 32 : 64) * I_GU, N_D = (PREP_IN_SCAN ? 32 : 64) * I_D, NITEMS = N_IN + N_OUT + N_GU + N_D;
    bf16_t* WinT = (bf16_t*)(a.ws + WS_WIN); bf16_t* WoutT = (bf16_t*)(a.ws + WS_WOUT); bf16_t* WguT = (bf16_t*)(a.ws + WS_WGU); bf16_t* WdT = (bf16_t*)(a.ws + WS_WD);
    for (int it = gw; it < NITEMS; it += NGW) {
        int r = it;
        if (r < N_IN) { const int l = r / I_IN, q = r % I_IN; transpose_item<0>(a.in[8] + (size_t)l * 1024 * INC, INC, INC, WinT + (size_t)l * INP * 1024, scr, q / 136, q % 136, lane); continue; } r -= N_IN;
        if (r < N_OUT) { const int l = r / I_OUT, q = r % I_OUT; transpose_item<0>(a.in[9] + (size_t)l * 1024 * 1024, 1024, 1024, WoutT + (size_t)l * 1024 * 1024, scr, q / 32, q % 32, lane); continue; } r -= N_OUT;
        if (r < N_GU) { const int le = r / I_GU, q = r % I_GU; transpose_item<1, true>(a.in[33] + (size_t)le * 1024 * 2048, 2048, 2048, WguT + (size_t)le * 2048 * 512, scr, q / 64, q % 64, lane); continue; } r -= N_GU;
        { const int le = r / I_D, q = r % I_D; transpose_item<0, true>(a.in[35] + (size_t)le * 1024 * 1024, 1024, 1024, WdT + (size_t)le * 1024 * 512, scr, q / 32, q % 32, lane); }
    }
    __syncthreads();
    LAS float* sv = (LAS float*)lds; LAS float* red = sv + 5 * 1024;
    for (int i = tid; i < 5 * 1024; i += 512) { const int r = i >> 10, k = i & 1023; const float cv = (r < 4) ? a.in[1][r * 1024 + k] : a.in[3][k]; sv[i] = siluf(cv); }
    __syncthreads();
    float* mod = (float*)(a.ws + WS_MOD);
    for (int grp = bid; grp < 768; grp += G) {
        const int l = grp / 384, j0 = (grp % 384) * 16, col = tid & 15, ks = tid >> 4;
        const float* w = a.in[4] + (size_t)l * 1024 * 6144 + j0 + col;
        float a0 = 0.f, a1 = 0.f, a2 = 0.f, a3 = 0.f, a4 = 0.f;
#pragma unroll 8
        for (int kk = 0; kk < 32; ++kk) { const int k = ks * 32 + kk; const float wv = w[(size_t)k * 6144];
            a0 += sv[k] * wv; a1 += sv[1024 + k] * wv; a2 += sv[2048 + k] * wv; a3 += sv[3072 + k] * wv; a4 += sv[4096 + k] * wv; }
        LAS float* rp = red + (ks * 16 + col) * 5; rp[0] = a0; rp[1] = a1; rp[2] = a2; rp[3] = a3; rp[4] = a4;
        __syncthreads();
        if (tid < 80) { const int c = tid / 5, r = tid % 5; float s = 0.f;
            for (int q = 0; q < 32; ++q) s += red[(q * 16 + c) * 5 + r];
            mod[(size_t)(l * 5 + r) * 6144 + j0 + c] = s + a.in[5][l * 6144 + j0 + c]; }
        __syncthreads();
    }
    bf16_t* LW = (bf16_t*)(a.ws + WS_LORA);
    for (int i = bid * 512 + tid; i < 2 * 81920; i += G * 512) {
        const int l = i / 81920, r = i % 81920;
        if (r < 16384) { const int q = r >> 8, c = r & 255; LW[(size_t)l * 81920 + c * 64 + q] = (bf16_t)f2bf(a.in[24][(size_t)l * 16384 + r]); }
        else if (r < 49152) { const int r2 = r - 16384, dj = r2 >> 14, q = (r2 >> 8) & 63, c = r2 & 255; LW[(size_t)l * 81920 + 16384 + dj * 16384 + c * 64 + q] = (bf16_t)f2bf(a.in[22][(size_t)l * 32768 + r2]); }
        else { const int r2 = r - 49152, q = r2 >> 8, c = r2 & 255; LW[(size_t)l * 81920 + 49152 + c * 128 + q] = (bf16_t)f2bf(a.in[25][(size_t)l * 32768 + r2]); }
    }
}

__device__ __forceinline__ void prep_moe_l1(const Args& a, LAS unsigned char* lds, int part, int wk, int nwk, int wave, int lane) {
    LAS float* scr = (LAS float*)(lds + wave * 16384);
    constexpr int I_GU = 16 * 64, I_D = 16 * 32, N_GU = 32 * I_GU, N_D = 32 * I_D, NIT = N_GU + N_D, HALF = NIT / 2;
    bf16_t* WguT = (bf16_t*)(a.ws + WS_WGU); bf16_t* WdT = (bf16_t*)(a.ws + WS_WD);
    for (int it = part * HALF + wk * 8 + wave; it < (part + 1) * HALF; it = opq(it + nwk * 8)) {
        int r = it;
        if (r < N_GU) { const int le = 32 + r / I_GU, q = r % I_GU; transpose_item<1, true>(a.in[33] + (size_t)le * 1024 * 2048, 2048, 2048, WguT + (size_t)le * 2048 * 512, scr, q / 64, q % 64, lane); continue; } r -= N_GU;
        { const int le = 32 + r / I_D, q = r % I_D; transpose_item<0, true>(a.in[35] + (size_t)le * 1024 * 1024, 1024, 1024, WdT + (size_t)le * 1024 * 512, scr, q / 32, q % 32, lane); }
    }
}

template <bool FP8 = false>
__device__ __forceinline__ void norm_mod_store(f32x4 (&v)[4], const float* nw, const float* shift, const float* scale, bf16_t* hrow, int lane) {
    float ss = 0.f;
#pragma unroll
    for (int j = 0; j < 4; ++j) ss += (v[j].x * v[j].x + v[j].y * v[j].y) + (v[j].z * v[j].z + v[j].w * v[j].w);
    const float r = frsq(wave_sum(ss) * (1.f / D) + 1e-6f);
    f32x4 w4v[4], shv[4], scv[4];
#pragma unroll
    for (int j = 0; j < 4; ++j) { const int c = j * 256 + lane * 4; w4v[j] = *(const f32x4*)(nw + c); shv[j] = *(const f32x4*)(shift + c); scv[j] = *(const f32x4*)(scale + c); }
#pragma unroll
    for (int j = 0; j < 4; ++j) { const int c = j * 256 + lane * 4;
        const f32x4 w4 = w4v[j], sh = shv[j], sc = scv[j];
        v[j] = (v[j] * r * w4) * (sc + 1.f) + sh;
        if (FP8) *(unsigned*)((unsigned char*)hrow + c) = pk8(v[j].x, v[j].y, v[j].z, v[j].w);
        else { u32x2 pk; pk.x = pk2(v[j].x, v[j].y); pk.y = pk2(v[j].z, v[j].w); *(u32x2*)(hrow + c) = pk; } }
}
__device__ __forceinline__ void phase_norm1(const Args& a, int L, const float* xl, const float* xc, int lane, int wave, int bid, int G) {
    const float* mod = (const float*)(a.ws + WS_MOD) + (size_t)L * 5 * 6144;
    bf16_t* Hn = (bf16_t*)(a.ws + WS_HN);
    for (int row = bid * 8 + wave; row < MALL; row += G * 8) {
        const float* xr = row < NL ? xl + (size_t)row * D : xc + (size_t)(row - NL) * D;
        const int bi = row < NL ? (row >> 12) : 4;
        f32x4 v[4];
#pragma unroll
        for (int j = 0; j < 4; ++j) v[j] = *(const f32x4*)(xr + j * 256 + lane * 4);
        norm_mod_store(v, a.in[6] + L * D, mod + (size_t)bi * 6144, mod + (size_t)bi * 6144 + 1024, Hn + (size_t)row * D, lane);
    }
}

__device__ __forceinline__ void phase_mixprep(const Args& a, int L, LAS unsigned char* lds, int lane_, int wave, int bid, int G) {
    const bf16_t* P = (const bf16_t*)(a.ws + WS_P);
    const int gw = bid * 8 + wave, NGW = G * 8;
    for (int rp_ = 0; rp_ < 1 + ((PROBE_MIX >> 0) & 1); ++rp_) if (MIXPARTS & 1) {
        bf16_t* MX = (bf16_t*)(a.ws + WS_MXBC); float* MD = (float*)(a.ws + WS_MDT);
        const float* cw = a.in[10] + (size_t)L * 3 * 768; const float* cb = a.in[11] + (size_t)L * 768;
        float w0[12], w1[12], w2[12], wb[12];
#pragma unroll
        for (int j = 0; j < 12; ++j) { const int c = (j >> 1) * 128 + 2 * lane_ + (j & 1); w0[j] = cw[c]; w1[j] = cw[768 + c]; w2[j] = cw[1536 + c]; wb[j] = cb[c]; }
        const float dtb = lane_ < 8 ? a.in[12][L * 8 + lane_] : 0.f, aneg = lane_ < 8 ? -__expf(a.in[13][L * 8 + lane_]) : 0.f;
        struct MbRow { unsigned x0[6], x1[6], x2[6]; unsigned short dr; };
        auto mb_ld = [&](MbRow& R, int row) {
            const int lane = opq(lane_);
            int t, len; if (row < NL) { t = row & 4095; len = 4096; } else { t = (row - NL) & 255; len = 256; }
            const bool hp = t > 0, hn = t < len - 1;
            const bf16_t* p1 = P + (size_t)row * INP + 256 + 2 * lane; const bf16_t* p0 = hp ? p1 - INP : p1; const bf16_t* p2 = hn ? p1 + INP : p1;
#pragma unroll
            for (int j = 0; j < 6; ++j) { R.x0[j] = *(const unsigned*)(p0 + j * 128); R.x1[j] = *(const unsigned*)(p1 + j * 128); R.x2[j] = *(const unsigned*)(p2 + j * 128); }
            R.dr = P[(size_t)row * INP + 1024 + (lane & 7)];
        };
        auto mb_do = [&](const MbRow& R, int row) {
            const int lane = opq(lane_);
            int t, len; if (row < NL) { t = row & 4095; len = 4096; } else { t = (row - NL) & 255; len = 256; }
            const unsigned mp = t > 0 ? 0xffffffffu : 0u, mn = t < len - 1 ? 0xffffffffu : 0u;
#pragma unroll
            for (int j = 0; j < 6; ++j) { const unsigned a0 = R.x0[j] & mp, a1 = R.x1[j], a2 = R.x2[j] & mn; f32x2v o;
                o.x = siluf(w0[2 * j] * bflo(a0) + w1[2 * j] * bflo(a1) + w2[2 * j] * bflo(a2) + wb[2 * j]);
                o.y = siluf(w0[2 * j + 1] * bfhi(a0) + w1[2 * j + 1] * bfhi(a1) + w2[2 * j + 1] * bfhi(a2) + wb[2 * j + 1]);
                *(unsigned*)(MX + (size_t)row * 768 + j * 128 + 2 * lane) = cvt2(o.x, o.y); }
            if (lane < 8) { const float dt = softplusf(bflo((unsigned)R.dr) + dtb); MD[(size_t)row * 16 + lane] = dt; MD[(size_t)row * 16 + 8 + lane] = dt * aneg * 1.4426950408889634f; }
        };
        MbRow RA, RB;
        if (gw < MALL) mb_ld(RA, gw);
        for (int row = gw; row < MALL; row += 2 * NGW) {
            const int r1 = row + NGW, r2 = row + 2 * NGW;
            if (r1 < MALL) mb_ld(RB, r1);
            mb_do(RA, row);
            if (r1 < MALL) { if (r2 < MALL) mb_ld(RA, r2); mb_do(RB, r1); }
        }
    }
    for (int rp_ = 0; rp_ < 1 + ((PROBE_MIX >> 1) & 1); ++rp_) if (MIXPARTS & 2) {
        bf16_t* DQ = (bf16_t*)(a.ws + WS_DNQKV); float* DG = (float*)(a.ws + WS_DNGB);
        const float* cw = a.in[16] + (size_t)L * 3 * 1536;
#define DN_ROWS(dr) size_t r0, r1, r2; bool hp, hn; \
            if (dr < NL) { const int b = dr >> 12, pos = dr & 4095; hp = pos > 0; hn = pos < 4095; const int pp = pos - 1, pn = pos + 1; \
                r1 = (size_t)b * 4096 + ((pos & 63) * 64 + (pos >> 6)); r0 = (size_t)b * 4096 + ((pp & 63) * 64 + ((pp >> 6) & 63)); r2 = (size_t)b * 4096 + ((pn & 63) * 64 + ((pn >> 6) & 63)); } \
            else { const int t = (dr - NL) & 255; hp = t > 0; hn = t < 255; r1 = dr; r0 = dr - 1; r2 = dr + 1; }
        {
            float w0[24], w1[24], w2[24];
#pragma unroll
            for (int j = 0; j < 24; ++j) { const int c = (j >> 1) * 128 + 2 * lane_ + (j & 1); w0[j] = cw[c]; w1[j] = cw[1536 + c]; w2[j] = cw[3072 + c]; }
            const float dtb = lane_ < 8 ? a.in[17][L * 8 + lane_] : 0.f, apos = lane_ < 8 ? __expf(a.in[18][L * 8 + lane_]) : 0.f;
            struct DnRow { unsigned x0[12], x1[12], x2[12]; unsigned short br, ar; };
            auto dn_ld = [&](DnRow& R, int dr) {
                const int lane = opq(lane_);
                DN_ROWS(dr)
                const bf16_t* q0 = P + (hp ? r0 : r1) * INP + DN_OFF + 2 * lane; const bf16_t* q1 = P + r1 * INP + DN_OFF + 2 * lane; const bf16_t* q2 = P + (hn ? r2 : r1) * INP + DN_OFF + 2 * lane;
#pragma unroll
                for (int j = 0; j < 12; ++j) { R.x0[j] = *(const unsigned*)(q0 + j * 128); R.x1[j] = *(const unsigned*)(q1 + j * 128); R.x2[j] = *(const unsigned*)(q2 + j * 128); }
                R.br = P[r1 * INP + DN_OFF + 2048 + (lane & 7)]; R.ar = P[r1 * INP + DN_OFF + 2056 + (lane & 7)];
            };
            auto dn_do = [&](const DnRow& R, int dr) {
                const int lane = opq(lane_);
                bool hp, hn; if (dr < NL) { const int pos = dr & 4095; hp = pos > 0; hn = pos < 4095; } else { const int t = (dr - NL) & 255; hp = t > 0; hn = t < 255; }
                const unsigned mp = hp ? 0xffffffffu : 0u, mn = hn ? 0xffffffffu : 0u;
                float v[24];
#pragma unroll
                for (int j = 0; j < 12; ++j) { const unsigned a0 = R.x0[j] & mp, a1 = R.x1[j], a2 = R.x2[j] & mn;
                    v[2 * j] = siluf(w0[2 * j] * bflo(a0) + w1[2 * j] * bflo(a1) + w2[2 * j] * bflo(a2)); v[2 * j + 1] = siluf(w0[2 * j + 1] * bfhi(a0) + w1[2 * j + 1] * bfhi(a1) + w2[2 * j + 1] * bfhi(a2)); }
                float qk[4];
#pragma unroll
                for (int h = 0; h < 4; ++h) {
                    const float sq = wave_sum(v[2 * h] * v[2 * h] + v[2 * h + 1] * v[2 * h + 1]);
                    const float sk = wave_sum(v[8 + 2 * h] * v[8 + 2 * h] + v[8 + 2 * h + 1] * v[8 + 2 * h + 1]);
                    const float rq = frsq(sq + 1e-6f) * 0.08838834764831845f, rk = frsq(sk + 1e-6f);
                    v[2 * h] *= rq; v[2 * h + 1] *= rq; v[8 + 2 * h] *= rk; v[8 + 2 * h + 1] *= rk;
                    qk[h] = wave_sum(v[2 * h] * v[8 + 2 * h] + v[2 * h + 1] * v[8 + 2 * h + 1]);
                }
#pragma unroll
                for (int j = 0; j < 12; ++j) *(unsigned*)(DQ + (size_t)dr * 1536 + j * 128 + 2 * lane) = cvt2(v[2 * j], v[2 * j + 1]);
                if (lane < 8) { const float braw = bflo((unsigned)R.br), araw = bflo((unsigned)R.ar); const float beta = sigm(braw); const float g = -apos * softplusf(araw + dtb);
                    DG[(size_t)dr * 32 + lane] = beta; DG[(size_t)dr * 32 + 8 + lane] = __expf(g); DG[(size_t)dr * 32 + 16 + lane] = g; }
                if (lane < 4) { const float s = lane == 0 ? qk[0] : lane == 1 ? qk[1] : lane == 2 ? qk[2] : qk[3]; DG[(size_t)dr * 32 + 24 + lane] = s; }
            };
            DnRow RA, RB;
            if (gw < MALL) dn_ld(RA, gw);
            for (int dr = gw; dr < MALL; dr += 2 * NGW) {
                const int d1 = dr + NGW, d2 = dr + 2 * NGW;
                if (d1 < MALL) dn_ld(RB, d1);
                dn_do(RA, dr);
                if (d1 < MALL) { if (d2 < MALL) dn_ld(RA, d2); dn_do(RB, d1); }
            }
        }
#undef DN_ROWS
    }
    for (int rp_ = 0; rp_ < 1 + ((PROBE_MIX >> 2) & 1); ++rp_) if (MIXPARTS & 4) {
        bf16_t* RW = (bf16_t*)(a.ws + WS_RW); float* RWW = (float*)(a.ws + WS_RWW); float* RG = (float*)(a.ws + WS_RWG);
        const bf16_t* LW = (const bf16_t*)(a.ws + WS_LORA) + (size_t)L * 81920;
        LAS float* KS = (LAS float*)lds;
        LAS bf16_t* INB = (LAS bf16_t*)(lds + 16640);
        const int hh = wave >> 1, half = wave & 1, tokn = lane_ & 15, g4 = lane_ >> 4;
        float mu[18];
#pragma unroll
        for (int j = 0; j < 18; ++j) { const int c = (j >> 1) * 128 + 2 * lane_ + (j & 1); const float m = a.in[20][(size_t)L * 1088 + (c < 1088 ? c : 1087)]; mu[j] = c < 1088 ? m : 0.f; }
        bf16x8 fa[4][2], fb[4][4];
        {
            const bf16_t* m0 = half == 0 ? LW : LW + 16384 + 16384;
#pragma unroll
            for (int ct = 0; ct < 4; ++ct)
#pragma unroll
                for (int kb = 0; kb < 2; ++kb) fa[ct][kb] = *(const bf16x8*)(m0 + (size_t)(hh * 64 + ct * 16 + tokn) * 64 + kb * 32 + g4 * 8);
            if (half == 0) {
#pragma unroll
                for (int ct = 0; ct < 4; ++ct)
#pragma unroll
                    for (int kb = 0; kb < 4; ++kb) fb[ct][kb] = *(const bf16x8*)(LW + 16384 + (size_t)(hh * 64 + ct * 16 + tokn) * 64 + (kb & 1) * 32 + g4 * 8);
            } else {
#pragma unroll
                for (int ct = 0; ct < 4; ++ct)
#pragma unroll
                    for (int kb = 0; kb < 4; ++kb) fb[ct][kb] = *(const bf16x8*)(LW + 49152 + (size_t)(hh * 64 + ct * 16 + tokn) * 128 + kb * 32 + g4 * 8);
            }
        }
        LAS float* PRM = (LAS float*)(lds + 32768);
        for (int i = wave * 64 + lane_; i < 1280; i += 512) PRM[i] = i < 256 ? a.in[26][L * 256 + i] : i < 512 ? a.in[23][L * 256 + i - 256] : i < 768 ? a.in[27][L * 256 + i - 512] : a.in[21][L * 512 + i - 768];
        __syncthreads();
        for (int rq_ = 0; rq_ < 1 + ((PROBE_MIX >> 3) & 1); ++rq_)
        for (int ti = bid; ti < MALL / 16; ti += G) {
            const int lane = opq(lane_);
            for (int rs_ = 0; rs_ < 1 + ((PROBE_MIX >> 4) & 1); ++rs_)
            {
            const bool lo32 = lane < 32;
            unsigned xv[2][9], sa[2][9], sb[2][9];
#pragma unroll
            for (int t2 = 0; t2 < 2; ++t2) {
                const int row = ti * 16 + wave * 2 + t2; int nbA, nbB; bool okA, okB;
                if (row < NL) { const int t = row & 4095, gr = t >> 6, gc = t & 63; const bool od = lane & 1;
                    nbA = od ? -64 : -1; okA = od ? gr > 0 : gc > 0; nbB = od ? 64 : 1; okB = od ? gr < 63 : gc < 63; }
                else { const int t = (row - NL) & 255; nbA = -1; okA = t > 0; nbB = 1; okB = t < 255; }
                const bf16_t* p = P + (size_t)row * INP + RW_OFF + 2 * lane; const bf16_t* psA = p + (long)(okA ? nbA : 0) * INP; const bf16_t* psB = p + (long)(okB ? nbB : 0) * INP;
#pragma unroll
                for (int j = 0; j < 9; ++j) { xv[t2][j] = *(const unsigned*)(p + j * 128); sa[t2][j] = *(const unsigned*)(psA + j * 128); sb[t2][j] = *(const unsigned*)(psB + j * 128); }
                asm volatile("" : "+v"(xv[t2][8]), "+v"(sa[t2][8]), "+v"(sb[t2][8]));
#pragma unroll
                for (int j = 0; j < 9; ++j) { sa[t2][j] = okA ? sa[t2][j] : 0u; sb[t2][j] = okB ? sb[t2][j] : 0u; }
            }
#pragma unroll
            for (int t2 = 0; t2 < 2; ++t2) {
                const int tk = wave * 2 + t2, row = ti * 16 + tk;
                bf16_t* o = RW + (size_t)row * 1280 + 2 * lane;
#pragma unroll
                for (int j = 0; j < 9; ++j) { const float xa = bflo(xv[t2][j]), xb = bfhi(xv[t2][j]);
                    const float m0 = xa + (bflo(sa[t2][j]) - xa) * mu[2 * j], m1 = xb + (bfhi(sb[t2][j]) - xb) * mu[2 * j + 1];
                    if (j < 2) *(unsigned*)(o + j * 128) = cvt2(m0, m1);
                    else if (j < 4) { f32x2v kv; kv.x = m0; kv.y = m1; *(LAS f32x2v*)(KS + tk * 260 + (j - 2) * 128 + 2 * lane) = kv; }
                    else if (j < 6) *(unsigned*)(o + j * 128) = cvt2(m0, m1);
                    else if (j == 6) *(LAS unsigned*)(INB + tk * 328 + 2 * lane) = cvt2(tanh_fast(m0), tanh_fast(m1));
                    else if (j == 7) *(LAS unsigned*)(INB + tk * 328 + 128 + 2 * lane) = lo32 ? cvt2(m0, m1) : cvt2(sigm(m0), sigm(m1));
                    else if (lo32) *(LAS unsigned*)(INB + tk * 328 + 256 + 2 * lane) = cvt2(sigm(m0), sigm(m1)); }
            }
            }
            LDS_BARRIER();
            for (int rm_ = 0; rm_ < 1 + ((PROBE_MIX >> 5) & 1); ++rm_)
            {
                const size_t row = (size_t)ti * 16 + tokn;
                const int ch0 = hh * 64 + g4 * 4;
                const LAS bf16_t* ib = INB + tokn * 328 + g4 * 8;
                f32x4 accA[4], accB[4];
#pragma unroll
                for (int ct = 0; ct < 4; ++ct) { accA[ct] = (f32x4){0.f, 0.f, 0.f, 0.f}; accB[ct] = accA[ct]; }
                if (half == 0) {
                    bf16x8 bi[2], bw[2];
#pragma unroll
                    for (int kb = 0; kb < 2; ++kb) { bi[kb] = *(const LAS bf16x8*)(ib + 128 + kb * 32); bw[kb] = *(const LAS bf16x8*)(ib + kb * 32); }
#pragma unroll
                    for (int ct = 0; ct < 4; ++ct)
#pragma unroll
                        for (int kb = 0; kb < 2; ++kb) { accA[ct] = __builtin_amdgcn_mfma_f32_16x16x32_bf16(fa[ct][kb], bi[kb], accA[ct], 0, 0, 0); accB[ct] = __builtin_amdgcn_mfma_f32_16x16x32_bf16(fb[ct][kb], bw[kb], accB[ct], 0, 0, 0); }
                    f32x4 kx[4], kn[4]; float ss = 0.f;
#pragma unroll
                    for (int ct = 0; ct < 4; ++ct) { kx[ct] = *(const LAS f32x4*)(KS + tokn * 260 + ch0 + ct * 16);
                        kn[ct] = kx[ct] * *(const LAS f32x4*)(PRM + ch0 + ct * 16); ss += (kn[ct].x * kn[ct].x + kn[ct].y * kn[ct].y) + (kn[ct].z * kn[ct].z + kn[ct].w * kn[ct].w); }
                    { float u = ss, v = ss; pswap16(u, v); ss = u + v; u = ss; v = ss; pswap32(u, v); ss = u + v; }
                    const float rn = frsq(ss + 1e-6f);
                    const int baddr = rowify_addr(lane), Rr = lane >> 3, cc = lane & 7;
                    unsigned kmv[4][2], knv[4][2], bbv[4][2], wvv[4][4];
#pragma unroll
                    for (int ct = 0; ct < 4; ++ct) { const f32x4 a0v = *(const LAS f32x4*)(PRM + 256 + ch0 + ct * 16), kav = *(const LAS f32x4*)(PRM + 512 + ch0 + ct * 16), w0v = *(const LAS f32x4*)(PRM + 768 + ch0 + ct * 16);
                        f32x4 av, km, wv;
#pragma unroll
                        for (int i = 0; i < 4; ++i) { av[i] = sigm(a0v[i] + accA[ct][i]); km[i] = kx[ct][i] * (1.f + (av[i] - 1.f) * kav[i]); wv[i] = __expf(-0.6065306597126334f * sigm(w0v[i] + accB[ct][i])); }
                        const f32x4 knn = kn[ct] * rn;
                        const f32x4 bb = knn * av;
                        kmv[ct][0] = cvt2(km.x, km.y); kmv[ct][1] = cvt2(km.z, km.w); knv[ct][0] = cvt2(-knn.x, -knn.y); knv[ct][1] = cvt2(-knn.z, -knn.w); bbv[ct][0] = cvt2(bb.x, bb.y); bbv[ct][1] = cvt2(bb.z, bb.w);
#pragma unroll
                        for (int i = 0; i < 4; ++i) { const float t = wv[i]; wvv[ct][i] = __builtin_bit_cast(unsigned, t); } }
                    const size_t r0 = (size_t)ti * 16 + Rr;
#pragma unroll
                    for (int pr = 0; pr < 2; ++pr) { const int chn = hh * 64 + pr * 32 + 4 * cc; unsigned o0[4], o1[4];
                        bf16_t* o = RW + r0 * 1280 + chn; float* ow = RWW + r0 * 512 + chn;
                        rowify<2>(kmv[2 * pr], kmv[2 * pr + 1], (unsigned (&)[2])o0, (unsigned (&)[2])o1, baddr); *(u32x2*)(o + 256) = (u32x2){o0[0], o0[1]}; *(u32x2*)(o + 8 * 1280 + 256) = (u32x2){o1[0], o1[1]};
                        rowify<2>(knv[2 * pr], knv[2 * pr + 1], (unsigned (&)[2])o0, (unsigned (&)[2])o1, baddr); *(u32x2*)(o + 768) = (u32x2){o0[0], o0[1]}; *(u32x2*)(o + 8 * 1280 + 768) = (u32x2){o1[0], o1[1]};
                        rowify<2>(bbv[2 * pr], bbv[2 * pr + 1], (unsigned (&)[2])o0, (unsigned (&)[2])o1, baddr); *(u32x2*)(o + 1024) = (u32x2){o0[0], o0[1]}; *(u32x2*)(o + 8 * 1280 + 1024) = (u32x2){o1[0], o1[1]};
                        rowify<4>(wvv[2 * pr], wvv[2 * pr + 1], o0, o1, baddr); *(u32x4*)ow = (u32x4){o0[0], o0[1], o0[2], o0[3]}; *(u32x4*)(ow + 8 * 512) = (u32x4){o1[0], o1[1], o1[2], o1[3]}; }
                } else {
                    bf16x8 bw[2], bg[4];
#pragma unroll
                    for (int kb = 0; kb < 2; ++kb) bw[kb] = *(const LAS bf16x8*)(ib + 64 + kb * 32);
#pragma unroll
                    for (int kb = 0; kb < 4; ++kb) bg[kb] = *(const LAS bf16x8*)(ib + 192 + kb * 32);
#pragma unroll
                    for (int ct = 0; ct < 4; ++ct) {
#pragma unroll
                        for (int kb = 0; kb < 2; ++kb) accA[ct] = __builtin_amdgcn_mfma_f32_16x16x32_bf16(fa[ct][kb], bw[kb], accA[ct], 0, 0, 0);
#pragma unroll
                        for (int kb = 0; kb < 4; ++kb) accB[ct] = __builtin_amdgcn_mfma_f32_16x16x32_bf16(fb[ct][kb], bg[kb], accB[ct], 0, 0, 0); }
                    const int baddr = rowify_addr(lane), Rr = lane >> 3, cc = lane & 7;
                    unsigned wvv[4][4], gvv[4][4];
#pragma unroll
                    for (int ct = 0; ct < 4; ++ct) { const f32x4 w0v = *(const LAS f32x4*)(PRM + 1024 + ch0 + ct * 16);
#pragma unroll
                        for (int i = 0; i < 4; ++i) { const float t = __expf(-0.6065306597126334f * sigm(w0v[i] + accA[ct][i])), gq = accB[ct][i]; wvv[ct][i] = __builtin_bit_cast(unsigned, t); gvv[ct][i] = __builtin_bit_cast(unsigned, gq); } }
                    const size_t r0 = (size_t)ti * 16 + Rr;
#pragma unroll
                    for (int pr = 0; pr < 2; ++pr) { const int chn = hh * 64 + pr * 32 + 4 * cc; unsigned o0[4], o1[4];
                        float* o = RWW + r0 * 512 + 256 + chn; float* og = RG + r0 * 256 + chn;
                        rowify<4>(wvv[2 * pr], wvv[2 * pr + 1], o0, o1, baddr); *(u32x4*)o = (u32x4){o0[0], o0[1], o0[2], o0[3]}; *(u32x4*)(o + 8 * 512) = (u32x4){o1[0], o1[1], o1[2], o1[3]};
                        rowify<4>(gvv[2 * pr], gvv[2 * pr + 1], o0, o1, baddr); *(u32x4*)og = (u32x4){o0[0], o0[1], o0[2], o0[3]}; *(u32x4*)(og + 8 * 256) = (u32x4){o1[0], o1[1], o1[2], o1[3]}; }
                }
            }
            LDS_BARRIER();
        }
    }
}

__device__ __forceinline__ int seqrow(int b, int dir, int s) {
    if (s < 256) return NL + b * 256 + (dir ? 255 - s : s);
    const int p = s - 256; return b * 4096 + (dir ? 4095 - p : p);
}
__device__ __forceinline__ int seqrow0(int b, int dir, int c) { return c < 16 ? NL + b * 256 + (dir ? 255 - c * 16 : c * 16) : b * 4096 + (dir ? 4095 - (c * 16 - 256) : (c * 16 - 256)); }
template <int CTRL> __device__ __forceinline__ float dppz(float v) { return __builtin_bit_cast(float, __builtin_amdgcn_update_dpp(0, __builtin_bit_cast(int, v), CTRL, 0xF, 0xF, true)); }
__device__ __forceinline__ void phase_dnpre(const Args& a, LAS unsigned char* lds, int lane_, int wave, int bid, int G) {
    const bf16_t* DQ = (const bf16_t*)(a.ws + WS_DNQKV); const float* DG = (const float*)(a.ws + WS_DNGB);
    LAS float* sc = (LAS float*)(lds + wave * 13312);
    LAS unsigned char* stg = (LAS unsigned char*)(sc + 576);
    for (int u = bid * 8 + wave; u < DN_UNITS; u += G * 8) {
        const int lane = opq(lane_);
        const int chain = u / DN_NSUB, c = u % DN_NSUB, dir = chain & 1, h = (chain >> 1) & 3, b = chain >> 3;
        const int ti = lane & 15, kg = lane >> 4;
        const int Lh = lane & 31; const bool isw = lane >= 32;
        const size_t rowi = (size_t)seqrow(b, dir, c * 16 + ti);
        float gi = DG[rowi * 32 + 16 + dir * 4 + h], bi = DG[rowi * 32 + dir * 4 + h]; asm volatile("" : "+v"(gi), "+v"(bi));
        u32x4 kk[4], qq[4];
#pragma unroll
        for (int s = 0; s < 4; ++s) { kk[s] = *(const u32x4*)(DQ + rowi * 1536 + 512 + h * 128 + 32 * s + 8 * kg); qq[s] = *(const u32x4*)(DQ + rowi * 1536 + h * 128 + 32 * s + 8 * kg); }
        const bf16_t* src = DQ + (isw ? 512 : 1024) + h * 128 + 4 * Lh;
        f32x4 x[16];
#pragma unroll
        for (int i = 0; i < 16; ++i) { const size_t row = (size_t)seqrow(b, dir, c * 16 + i); x[i] = ldp4(src + row * 1536); }
        float gc = gi; gc += dppz<0x111>(gc); gc += dppz<0x112>(gc); gc += dppz<0x114>(gc); gc += dppz<0x118>(gc);
        if (lane < 16) { sc[lane] = gc; sc[16 + lane] = bi; }
        f32x4 KKd = {0.f, 0.f, 0.f, 0.f}, QKd = KKd;
#pragma unroll
        for (int s = 0; s < 4; ++s) { const bf16x8 kf = __builtin_bit_cast(bf16x8, kk[s]);
            KKd = __builtin_amdgcn_mfma_f32_16x16x32_bf16(kf, kf, KKd, 0, 0, 0); QKd = __builtin_amdgcn_mfma_f32_16x16x32_bf16(__builtin_bit_cast(bf16x8, qq[s]), kf, QKd, 0, 0, 0); }
        LDS_WAIT(); asm volatile("" ::: "memory");
        {
            const f32x4 gci = *(const LAS f32x4*)(sc + 4 * kg), bti = *(const LAS f32x4*)(sc + 16 + 4 * kg);
#pragma unroll
            for (int r = 0; r < 4; ++r) { const int i = 4 * kg + r; const float dec = __expf(gci[r] - gc);
                sc[32 + i * 16 + ti] = (i > ti) ? bti[r] * KKd[r] * dec : 0.f; sc[288 + i * 16 + ti] = (i >= ti) ? QKd[r] * dec : 0.f; }
        }
        {
            const float eq = __expf(gc);
#pragma unroll
            for (int s = 0; s < 4; ++s) { const unsigned w0 = qq[s].x, w1 = qq[s].y, w2 = qq[s].z, w3 = qq[s].w;
                u32x2 lo, hi2;
                lo.x = cvt2(__builtin_bit_cast(float, w0 << 16) * eq, __builtin_bit_cast(float, w0 & 0xffff0000u) * eq); lo.y = cvt2(__builtin_bit_cast(float, w1 << 16) * eq, __builtin_bit_cast(float, w1 & 0xffff0000u) * eq);
                hi2.x = cvt2(__builtin_bit_cast(float, w2 << 16) * eq, __builtin_bit_cast(float, w2 & 0xffff0000u) * eq); hi2.y = cvt2(__builtin_bit_cast(float, w3 << 16) * eq, __builtin_bit_cast(float, w3 & 0xffff0000u) * eq);
                const int kq0 = 2 * (kg & 1), hf = kg >> 1;
                *(LAS u32x2*)(stg + 4096 + ((s * 64 + kq0 * 16 + ti) * 8 + hf * 4) * 2) = lo; *(LAS u32x2*)(stg + 4096 + ((s * 64 + (kq0 + 1) * 16 + ti) * 8 + hf * 4) * 2) = hi2; }
        }
        LDS_WAIT(); asm volatile("" ::: "memory");
        unsigned char* ub = a.ws + WS_DNC + (size_t)u * 12800;
        {
            const f32x4 at = *(const LAS f32x4*)(sc + 288 + ti * 16 + 4 * kg);
            u32x2 o; o.x = cvt2(at.x, at.y); o.y = cvt2(at.z, at.w); *(u32x2*)(ub + 12288 + lane * 8) = o;
            if (lane == 15) ((float*)(a.ws + WS_DNG))[u] = __expf(gc);
        }
#pragma unroll
        for (int i = 0; i < 16; ++i) { const float gci = sc[i], bti = sc[16 + i]; x[i] = x[i] * (isw ? bti * __expf(gci) : bti);
#pragma unroll
            for (int j = 0; j < i; ++j) x[i] -= x[j] * sc[32 + i * 16 + j]; }
        const int sW = Lh >> 3, hfW = (Lh >> 2) & 1, kqW = Lh & 3;
        if (isw) {
#pragma unroll
            for (int m = 0; m < 16; ++m) { u32x2 o; o.x = cvt2(x[m].x, x[m].y); o.y = cvt2(x[m].z, x[m].w); *(LAS u32x2*)(stg + ((sW * 64 + kqW * 16 + m) * 8 + hfW * 4) * 2) = o; }
        }
        LDS_WAIT(); asm volatile("" ::: "memory");
#pragma unroll
        for (int q = 0; q < 8; ++q) *(u32x4*)(ub + q * 1024 + lane * 16) = *(const LAS u32x4*)(stg + q * 1024 + lane * 16);
        LDS_WAIT(); asm volatile("" ::: "memory");
        if (!isw) {
#pragma unroll
            for (int g = 0; g < 4; ++g)
#pragma unroll
                for (int q = 0; q < 4; ++q) { const f32x4 o = {x[4 * g][q], x[4 * g + 1][q], x[4 * g + 2][q], x[4 * g + 3][q]}; *(LAS f32x4*)(stg + ((Lh >> 2) * 256 + (g * 16 + 4 * (Lh & 3) + q) * 4) * 4) = o; }
        }
        LDS_WAIT(); asm volatile("" ::: "memory");
        { unsigned char* ud = a.ws + WS_DNU + (size_t)u * 8192;
#pragma unroll
          for (int q = 0; q < 8; ++q) *(u32x4*)(ud + q * 1024 + lane * 16) = *(const LAS u32x4*)(stg + q * 1024 + lane * 16); }
        LDS_WAIT(); asm volatile("" ::: "memory");
        {
            const float ek = __expf(sc[15] - gc);
            LAS bf16_t* kfi = (LAS bf16_t*)stg;
#pragma unroll
            for (int s = 0; s < 4; ++s) { const unsigned w[4] = {kk[s].x, kk[s].y, kk[s].z, kk[s].w};
#pragma unroll
                for (int e2 = 0; e2 < 4; ++e2) { const unsigned pk = cvt2(__builtin_bit_cast(float, w[e2] << 16) * ek, __builtin_bit_cast(float, w[e2] & 0xffff0000u) * ek);
                    const int d0 = 32 * s + 8 * kg + 2 * e2;
                    kfi[(((d0 >> 4) * 64 + (ti >> 2) * 16 + (d0 & 15)) * 4) + (ti & 3)] = (bf16_t)(pk & 0xffffu);
                    kfi[(((d0 >> 4) * 64 + (ti >> 2) * 16 + ((d0 + 1) & 15)) * 4) + (ti & 3)] = (bf16_t)(pk >> 16); } }
        }
        LDS_WAIT(); asm volatile("" ::: "memory");
#pragma unroll
        for (int q = 0; q < 4; ++q) *(u32x4*)(ub + 8192 + q * 1024 + lane * 16) = *(const LAS u32x4*)(stg + q * 1024 + lane * 16);
        LDS_WAIT(); asm volatile("" ::: "memory");
    }
}
__device__ __forceinline__ void phase_mbpre(const Args& a, int lane_, int wave, int bid, int G) {
    const bf16_t* MX = (const bf16_t*)(a.ws + WS_MXBC);
    for (int u = bid * 8 + wave; u < MB_UNITS; u += G * 8) {
        const int lane = opq(lane_);
        const int bg = u / DN_NSUB, gi = u % DN_NSUB, b = bg >> 1, grp = bg & 1;
        const size_t base = gi < 16 ? (size_t)NL + b * 256 + gi * 16 : (size_t)b * 4096 + (gi - 16) * 16;
        const int tk = lane & 15, kg = lane >> 4;
        unsigned char* ub0 = a.ws + WS_MBC + (size_t)u * 12288; unsigned char* ub = ub0 + lane * 16;
        const bf16_t* cp = MX + (base + tk) * 768 + 512 + grp * 128 + 4 * kg; const bf16_t* bp = MX + (base + tk) * 768 + 256 + grp * 128 + 4 * kg;
        u32x2 cv[4][2], bv[4][2]; unsigned short btv[8][4];
#pragma unroll
        for (int s = 0; s < 4; ++s) { cv[s][0] = *(const u32x2*)(cp + 32 * s); cv[s][1] = *(const u32x2*)(cp + 32 * s + 16); bv[s][0] = *(const u32x2*)(bp + 32 * s); bv[s][1] = *(const u32x2*)(bp + 32 * s + 16); }
        const bf16_t* bt = MX + (base + 4 * kg) * 768 + 256 + grp * 128 + tk;
#pragma unroll
        for (int dt = 0; dt < 8; ++dt) { btv[dt][0] = bt[16 * dt]; btv[dt][1] = bt[768 + 16 * dt]; btv[dt][2] = bt[1536 + 16 * dt]; btv[dt][3] = bt[2304 + 16 * dt]; }
        f32x4 G = {0.f, 0.f, 0.f, 0.f};
#pragma unroll
        for (int s = 0; s < 4; ++s) { const u32x4 oc = {cv[s][0].x, cv[s][0].y, cv[s][1].x, cv[s][1].y}, ob = {bv[s][0].x, bv[s][0].y, bv[s][1].x, bv[s][1].y};
            G = __builtin_amdgcn_mfma_f32_16x16x32_bf16(__builtin_bit_cast(bf16x8, ob), __builtin_bit_cast(bf16x8, oc), G, 0, 0, 0);
            *(u32x4*)(ub + s * 1024) = oc; }
        *(f32x4*)(ub + 4096) = G;
#pragma unroll
        for (int dt = 0; dt < 8; ++dt) { u32x2 o; o.x = (unsigned)btv[dt][0] | ((unsigned)btv[dt][1] << 16); o.y = (unsigned)btv[dt][2] | ((unsigned)btv[dt][3] << 16); *(u32x2*)(ub0 + 8192 + dt * 512 + lane * 8) = o; }
    }
}
constexpr int RING_OFF = 4608, RING_SLOT = 18432, RING_R = 7, RING_NP = 18;
struct RingSync { volatile LAS int* prog; volatile LAS int* lready; };
__device__ __forceinline__ void ring_wait_ready(const RingSync& rs, int c) { unsigned sp = 0; while (rs.lready[c & 3] < c + 1 && ++sp < (1u << 24)) __builtin_amdgcn_s_sleep(1); asm volatile("" ::: "memory"); }
__device__ __forceinline__ int ring_peek(const RingSync& rs, int c) { return rs.lready[c & 3]; }
__device__ __forceinline__ void ring_wait_peeked(const RingSync& rs, int c, int pf) { if (pf < c + 1) ring_wait_ready(rs, c); asm volatile("" ::: "memory"); }
__device__ __forceinline__ void ring_release(const RingSync& rs, int w, int c, int lane) { asm volatile("" ::: "memory"); if (lane == 0) rs.prog[w] = c + 1; asm volatile("" ::: "memory"); }
struct MbBuf { bf16x8 cf[4], btf[8]; f32x4 gt; float la, xr[4]; size_t base; };
__device__ __forceinline__ size_t mb_base(int b, int dir, int c, int& gi) { gi = c < 16 ? (dir ? 15 - c : c) : (dir ? 16 + 255 - (c - 16) : c); return gi < 16 ? (size_t)NL + b * 256 + gi * 16 : (size_t)b * 4096 + (gi - 16) * 16; }
__device__ __forceinline__ void mb_load(MbBuf& B, const LAS unsigned char* slot, int b, int h, int dir, int pt, int c, int lane) {
    const int n = lane & 15, g = lane >> 4; int gi;
    const LAS unsigned char* ub = slot + lane * 16;
#pragma unroll
    for (int s = 0; s < 4; ++s) B.cf[s] = *(const LAS bf16x8*)(ub + s * 1024);
    B.gt = *(const LAS f32x4*)(ub + 4096);
#pragma unroll
    for (int dt = 0; dt < 8; ++dt) { const u32x2 v = *(const volatile LAS u32x2*)(slot + 8192 + dt * 512 + lane * 8); const u32x4 f = {v.x, v.y, 0u, 0u}; B.btf[dt] = __builtin_bit_cast(bf16x8, f); }
    const LAS bf16_t* xs = (const LAS bf16_t*)(slot + 12288); const LAS float* md = (const LAS float*)(slot + 14336);
    B.la = md[n * 16 + 8 + dir * 4 + h];
#pragma unroll
    for (int r = 0; r < 4; ++r) B.xr[r] = bflo((unsigned)xs[(4 * g + r) * 64 + pt * 16 + n]) * md[(4 * g + r) * 16 + dir * 4 + h];
    B.base = mb_base(b, dir, c, gi);
}
struct MbPre { float cum, dtot; f32x4 cj; bf16x8 xdf, xd2f; };
__device__ __forceinline__ void mb_pre(MbPre& P, const MbBuf& B, LAS float* sc, int dir, int lane) {
    const int g = lane >> 4;
    float cum = B.la;
    if (dir == 0) { cum += dppz<0x111>(cum); cum += dppz<0x112>(cum); cum += dppz<0x114>(cum); cum += dppz<0x118>(cum); }
    else          { cum += dppz<0x101>(cum); cum += dppz<0x102>(cum); cum += dppz<0x104>(cum); cum += dppz<0x108>(cum); }
    if (lane < 16) sc[lane] = cum;
    LDS_WAIT(); asm volatile("" ::: "memory");
    const f32x4 cj = *(const LAS f32x4*)(sc + 4 * g); const float cend = sc[dir ? 0 : 15];
    LDS_WAIT(); asm volatile("" ::: "memory");
    u32x4 px, px2; px.x = cvt2(B.xr[0], B.xr[1]); px.y = cvt2(B.xr[2], B.xr[3]); px.z = 0u; px.w = 0u;
    px2.x = cvt2(B.xr[0] * __builtin_amdgcn_exp2f(cend - cj.x), B.xr[1] * __builtin_amdgcn_exp2f(cend - cj.y)); px2.y = cvt2(B.xr[2] * __builtin_amdgcn_exp2f(cend - cj.z), B.xr[3] * __builtin_amdgcn_exp2f(cend - cj.w)); px2.z = 0u; px2.w = 0u;
    P.xdf = __builtin_bit_cast(bf16x8, px); P.xd2f = __builtin_bit_cast(bf16x8, px2); P.cum = cum; P.cj = cj; P.dtot = __builtin_amdgcn_exp2f(cend);
}
__device__ __forceinline__ void mb_main(const MbBuf& B, const MbPre& P, f32x4 (&hT)[8], bf16_t* YM, int dir, int h, int pt, int lane) {
    const int n = lane & 15, g = lane >> 4;
    const f32x4 gt = B.gt; f32x4 yo = {0.f, 0.f, 0.f, 0.f};
#pragma unroll
    for (int s = 0; s < 4; ++s) {
        u32x4 p; p.x = cvt2(hT[2 * s].x, hT[2 * s].y); p.y = cvt2(hT[2 * s].z, hT[2 * s].w); p.z = cvt2(hT[2 * s + 1].x, hT[2 * s + 1].y); p.w = cvt2(hT[2 * s + 1].z, hT[2 * s + 1].w);
        yo = __builtin_amdgcn_mfma_f32_16x16x32_bf16(__builtin_bit_cast(bf16x8, p), B.cf[s], yo, 0, 0, 0); }
    float st[4];
#pragma unroll
    for (int r = 0; r < 4; ++r) { const int j = 4 * g + r; const bool ok = dir ? (j >= n) : (j <= n); st[r] = ok ? gt[r] * __builtin_amdgcn_exp2f(P.cum - P.cj[r]) : 0.f; }
    u32x4 ps; ps.x = cvt2(st[0], st[1]); ps.y = cvt2(st[2], st[3]); ps.z = 0u; ps.w = 0u;
    const f32x4 y = __builtin_amdgcn_mfma_f32_16x16x32_bf16(P.xdf, __builtin_bit_cast(bf16x8, ps), yo * __builtin_amdgcn_exp2f(P.cum), 0, 0, 0);
    *(u32x2*)(YM + (B.base + n) * 256 + h * 64 + pt * 16 + 4 * g) = pk4(y);
#pragma unroll
    for (int dt = 0; dt < 8; ++dt) hT[dt] = __builtin_amdgcn_mfma_f32_16x16x32_bf16(B.btf[dt], P.xd2f, hT[dt] * P.dtot, 0, 0, 0);
}
__device__ __forceinline__ void scan_mamba_seq(const Args& a, LAS unsigned char* lds, int chain, int pt, int lane, const RingSync& rs) {
    const int dir = chain & 1, h = (chain >> 1) & 3, b = chain >> 3;
    LAS float* sc = (LAS float*)(lds + 1024 + pt * 256);
    bf16_t* YM = (bf16_t*)(a.ws + WS_YM) + (size_t)dir * MALL * 256;
    f32x4 hT[8];
#pragma unroll
    for (int i = 0; i < 8; ++i) hT[i] = (f32x4){0.f, 0.f, 0.f, 0.f};
    MbBuf A, B; MbPre PA, PB;
    ring_wait_ready(rs, 0); mb_load(A, lds + RING_OFF, b, h, dir, pt, 0, lane); ring_release(rs, pt, 0, lane);
    mb_pre(PA, A, sc, dir, lane);
    int pf = ring_peek(rs, 1);
    for (int c = 0; c < DN_NSUB; c += 2) {
        ring_wait_peeked(rs, c + 1, pf); mb_load(B, lds + RING_OFF + ((c + 1) % RING_R) * RING_SLOT, b, h, dir, pt, c + 1, lane); ring_release(rs, pt, c + 1, lane); pf = ring_peek(rs, c + 2);
        mb_main(A, PA, hT, YM, dir, h, pt, lane);
        mb_pre(PB, B, sc, dir, lane);
        if (c + 2 < DN_NSUB) { ring_wait_peeked(rs, c + 2, pf); mb_load(A, lds + RING_OFF + ((c + 2) % RING_R) * RING_SLOT, b, h, dir, pt, c + 2, lane); ring_release(rs, pt, c + 2, lane); pf = ring_peek(rs, c + 3); }
        mb_main(B, PB, hT, YM, dir, h, pt, lane);
        if (c + 2 < DN_NSUB) mb_pre(PA, A, sc, dir, lane);
    }
}

template <int CTRL> __device__ __forceinline__ float dpp1(float v) { return __builtin_bit_cast(float, __builtin_amdgcn_update_dpp(0x3f800000, __builtin_bit_cast(int, v), CTRL, 0xF, 0xF, false)); }
__device__ __forceinline__ void phase_rwpre(const Args& a, LAS unsigned char* lds, int lane_, int wave, int bid, int G) {
    const bf16_t* RW = (const bf16_t*)(a.ws + WS_RW); const float* RWW = (const float*)(a.ws + WS_RWW);
    LAS unsigned char* wl = lds + wave * 13312;
    LAS bf16_t* Ab = (LAS bf16_t*)wl; LAS bf16_t* Rb = Ab + 1024; LAS bf16_t* Bb = Rb + 1024; LAS bf16_t* Kb = Bb + 1024;
    LAS float* Lab = (LAS float*)(wl + 8192); LAS float* Lak = Lab + 256; LAS float* Lbr = Lak + 256; LAS float* Lkr = Lbr + 256; LAS float* Nm = Lkr + 256;
    for (int u = bid * 8 + wave; u < DN_UNITS; u += G * 8) {
        const int lane = opq(lane_);
        const int chain = u / DN_NSUB, c = u % DN_NSUB, dir = chain & 1, h = (chain >> 1) & 3, b = chain >> 3;
        const int ti = lane & 15, kg = lane >> 4;
        const size_t rrow = (size_t)seqrow(b, dir, c * 16 + ti);
        const bf16_t* p = RW + rrow * 1280 + h * 64 + 8 * kg; const float* pw = RWW + rrow * 512 + dir * 256 + h * 64 + 8 * kg;
        float av[16], bv[16], kv[16], rv[16], wv[16];
#pragma unroll
        for (int s = 0; s < 2; ++s)
#pragma unroll
            for (int q = 0; q < 2; ++q) { const int o = 32 * s + 4 * q;
                const f32x4 r4 = ldp4(p + o), k4 = ldp4(p + 256 + o), a4 = ldp4(p + 768 + o), b4 = ldp4(p + 1024 + o), w4 = *(const f32x4*)(pw + o);
#pragma unroll
                for (int e = 0; e < 4; ++e) { const int x = 8 * s + 4 * q + e; rv[x] = r4[e]; kv[x] = k4[e]; av[x] = a4[e]; bv[x] = b4[e]; wv[x] = w4[e]; } }
        u32x4 fa[2], fr[2], fb[2], fk[2];
        float p15[16];
#pragma unroll
        for (int x = 0; x < 16; ++x) {
            float P = wv[x]; P *= dpp1<0x111>(P); P *= dpp1<0x112>(P); P *= dpp1<0x114>(P); P *= dpp1<0x118>(P);
            const float Pex = dpp1<0x111>(P), ip = frcp(P);
            av[x] *= Pex; rv[x] *= P; bv[x] *= ip; kv[x] *= ip;
            p15[x] = dppf<0x140>(P);
        }
#pragma unroll
        for (int s = 0; s < 2; ++s) {
            fa[s].x = cvt2(av[8 * s], av[8 * s + 1]); fa[s].y = cvt2(av[8 * s + 2], av[8 * s + 3]); fa[s].z = cvt2(av[8 * s + 4], av[8 * s + 5]); fa[s].w = cvt2(av[8 * s + 6], av[8 * s + 7]);
            fr[s].x = cvt2(rv[8 * s], rv[8 * s + 1]); fr[s].y = cvt2(rv[8 * s + 2], rv[8 * s + 3]); fr[s].z = cvt2(rv[8 * s + 4], rv[8 * s + 5]); fr[s].w = cvt2(rv[8 * s + 6], rv[8 * s + 7]);
            fb[s].x = cvt2(bv[8 * s], bv[8 * s + 1]); fb[s].y = cvt2(bv[8 * s + 2], bv[8 * s + 3]); fb[s].z = cvt2(bv[8 * s + 4], bv[8 * s + 5]); fb[s].w = cvt2(bv[8 * s + 6], bv[8 * s + 7]);
            fk[s].x = cvt2(kv[8 * s], kv[8 * s + 1]); fk[s].y = cvt2(kv[8 * s + 2], kv[8 * s + 3]); fk[s].z = cvt2(kv[8 * s + 4], kv[8 * s + 5]); fk[s].w = cvt2(kv[8 * s + 6], kv[8 * s + 7]);
            *(LAS u32x4*)(Ab + ti * 64 + 32 * s + 8 * kg) = fa[s]; *(LAS u32x4*)(Rb + ti * 64 + 32 * s + 8 * kg) = fr[s];
            *(LAS u32x4*)(Bb + ti * 64 + 32 * s + 8 * kg) = fb[s]; *(LAS u32x4*)(Kb + ti * 64 + 32 * s + 8 * kg) = fk[s];
        }
        unsigned char* ub = a.ws + WS_RWC + (size_t)u * 10496;
        if (ti == 0) {
            float* pp = (float*)(ub + 10240) + 8 * kg;
            *(f32x4*)(pp) = (f32x4){p15[0], p15[1], p15[2], p15[3]}; *(f32x4*)(pp + 4) = (f32x4){p15[4], p15[5], p15[6], p15[7]};
            *(f32x4*)(pp + 32) = (f32x4){p15[8], p15[9], p15[10], p15[11]}; *(f32x4*)(pp + 36) = (f32x4){p15[12], p15[13], p15[14], p15[15]};
        }
        f32x4 dab = {0.f, 0.f, 0.f, 0.f}, dak = dab, dbr = dab, dkr = dab;
#pragma unroll
        for (int s = 0; s < 2; ++s) { const bf16x8 A = __builtin_bit_cast(bf16x8, fa[s]), R = __builtin_bit_cast(bf16x8, fr[s]), B = __builtin_bit_cast(bf16x8, fb[s]), K = __builtin_bit_cast(bf16x8, fk[s]);
            dab = __builtin_amdgcn_mfma_f32_16x16x32_bf16(A, B, dab, 0, 0, 0); dak = __builtin_amdgcn_mfma_f32_16x16x32_bf16(A, K, dak, 0, 0, 0);
            dbr = __builtin_amdgcn_mfma_f32_16x16x32_bf16(R, B, dbr, 0, 0, 0); dkr = __builtin_amdgcn_mfma_f32_16x16x32_bf16(R, K, dkr, 0, 0, 0); }
#pragma unroll
        for (int r = 0; r < 4; ++r) { const int i = 4 * kg + r;
            Lab[i * 16 + ti] = (ti < i) ? dab[r] : 0.f; Lak[i * 16 + ti] = (ti < i) ? dak[r] : 0.f; Lbr[i * 16 + ti] = (ti <= i) ? dbr[r] : 0.f; Lkr[i * 16 + ti] = (ti <= i) ? dkr[r] : 0.f; }
        LDS_WAIT(); asm volatile("" ::: "memory");
        if (lane < 16) {
            float nn[16];
#pragma unroll
            for (int i = 0; i < 16; ++i) { float v = (i == lane) ? 1.f : 0.f;
#pragma unroll
                for (int j = 0; j < i; ++j) v += Lab[i * 16 + j] * nn[j];
                nn[i] = v; Nm[i * 16 + lane] = v; }
        }
        LDS_WAIT(); asm volatile("" ::: "memory");
        {
            const f32x4 m0 = *(const LAS f32x4*)(Lak + ti * 16 + 4 * kg), m1 = *(const LAS f32x4*)(Nm + ti * 16 + 4 * kg), m2 = *(const LAS f32x4*)(Lbr + ti * 16 + 4 * kg), m3 = *(const LAS f32x4*)(Lkr + ti * 16 + 4 * kg);
            u32x2 o;
            o.x = cvt2(m0.x, m0.y); o.y = cvt2(m0.z, m0.w); *(u32x2*)(ub + 4096 + lane * 8) = o;
            o.x = cvt2(m1.x, m1.y); o.y = cvt2(m1.z, m1.w); *(u32x2*)(ub + 4608 + lane * 8) = o;
            o.x = cvt2(m2.x, m2.y); o.y = cvt2(m2.z, m2.w); *(u32x2*)(ub + 5120 + lane * 8) = o;
            o.x = cvt2(m3.x, m3.y); o.y = cvt2(m3.z, m3.w); *(u32x2*)(ub + 5632 + lane * 8) = o;
        }
#pragma unroll
        for (int s = 0; s < 2; ++s) {
            u32x4 o; const u32x2 a0 = *(const LAS u32x2*)(Ab + ti * 64 + 32 * s + 4 * kg), a1 = *(const LAS u32x2*)(Ab + ti * 64 + 32 * s + 16 + 4 * kg);
            o.x = a0.x; o.y = a0.y; o.z = a1.x; o.w = a1.y; *(u32x4*)(ub + s * 1024 + lane * 16) = o;
            const u32x2 r0 = *(const LAS u32x2*)(Rb + ti * 64 + 32 * s + 4 * kg), r1 = *(const LAS u32x2*)(Rb + ti * 64 + 32 * s + 16 + 4 * kg);
            o.x = r0.x; o.y = r0.y; o.z = r1.x; o.w = r1.y; *(u32x4*)(ub + 2048 + s * 1024 + lane * 16) = o;
        }
#pragma unroll
        for (int dt = 0; dt < 4; ++dt) {
            u32x2 o;
            const LAS bf16_t* bp = Bb + (4 * kg) * 64 + 16 * dt + ti; const LAS bf16_t* kp = Kb + (4 * kg) * 64 + 16 * dt + ti;
            o.x = (unsigned)bp[0] | ((unsigned)bp[64] << 16); o.y = (unsigned)bp[128] | ((unsigned)bp[192] << 16); *(u32x2*)(ub + 6144 + dt * 512 + lane * 8) = o;
            o.x = (unsigned)kp[0] | ((unsigned)kp[64] << 16); o.y = (unsigned)kp[128] | ((unsigned)kp[192] << 16); *(u32x2*)(ub + 8192 + dt * 512 + lane * 8) = o;
        }
        LDS_WAIT(); asm volatile("" ::: "memory");
    }
}
struct RwBuf { bf16x8 atf[2], rtf[2], lakf, nf, lbrf, lkrf, bfr[4], kfr[4]; float vr[4]; };
struct RwBuf2 { f32x4 p15[4]; };
__device__ __forceinline__ void rw_load(RwBuf& B, f32x4 (&p15)[4], const LAS unsigned char* slot, int vt, int lane) {
    const int n = lane & 15, g = lane >> 4;
    const LAS unsigned char* ub = slot + lane * 16;
#pragma unroll
    for (int s = 0; s < 2; ++s) { B.atf[s] = *(const LAS bf16x8*)(ub + s * 1024); B.rtf[s] = *(const LAS bf16x8*)(ub + 2048 + s * 1024); }
#define RW_HALF(off) ({ const u32x2 v_ = *(const volatile LAS u32x2*)(slot + (off) + lane * 8); const u32x4 f_ = {v_.x, v_.y, 0u, 0u}; __builtin_bit_cast(bf16x8, f_); })
    B.lakf = RW_HALF(4096); B.nf = RW_HALF(4608); B.lbrf = RW_HALF(5120); B.lkrf = RW_HALF(5632);
#pragma unroll
    for (int dt = 0; dt < 4; ++dt) { B.bfr[dt] = RW_HALF(6144 + dt * 512); B.kfr[dt] = RW_HALF(8192 + dt * 512); p15[dt] = *(const LAS f32x4*)(slot + 10240 + (16 * dt + 4 * g) * 4); }
#undef RW_HALF
    const LAS bf16_t* vs = (const LAS bf16_t*)(slot + 11264);
#pragma unroll
    for (int r = 0; r < 4; ++r) B.vr[r] = __builtin_bit_cast(float, ((unsigned)vs[(4 * g + r) * 64 + vt * 16 + n]) << 16);
}
__device__ __forceinline__ void rw_step(const RwBuf& B, const f32x4 (&p15)[4], f32x4 (&Sd)[4], bf16_t* YR, int b, int dir, int h, int vt, int c, int lane) {
    const int n = lane & 15, g = lane >> 4;
    const f32x4 z4 = {0.f, 0.f, 0.f, 0.f};
    u32x4 pv; pv.x = cvt2(B.vr[0], B.vr[1]); pv.y = cvt2(B.vr[2], B.vr[3]); pv.z = 0u; pv.w = 0u;
    const bf16x8 vb = __builtin_bit_cast(bf16x8, pv);
    bf16x8 sb[2];
#pragma unroll
    for (int s = 0; s < 2; ++s) { u32x4 p; p.x = cvt2(Sd[2 * s].x, Sd[2 * s].y); p.y = cvt2(Sd[2 * s].z, Sd[2 * s].w); p.z = cvt2(Sd[2 * s + 1].x, Sd[2 * s + 1].y); p.w = cvt2(Sd[2 * s + 1].z, Sd[2 * s + 1].w); sb[s] = __builtin_bit_cast(bf16x8, p); }
    f32x4 X = __builtin_amdgcn_mfma_f32_16x16x32_bf16(B.atf[0], sb[0], z4, 0, 0, 0);
    X = __builtin_amdgcn_mfma_f32_16x16x32_bf16(B.atf[1], sb[1], X, 0, 0, 0);
    X = __builtin_amdgcn_mfma_f32_16x16x32_bf16(B.lakf, vb, X, 0, 0, 0);
    u32x4 px; px.x = cvt2(X.x, X.y); px.y = cvt2(X.z, X.w); px.z = 0u; px.w = 0u;
    const f32x4 UT = __builtin_amdgcn_mfma_f32_16x16x32_bf16(B.nf, __builtin_bit_cast(bf16x8, px), z4, 0, 0, 0);
    u32x4 pu; pu.x = cvt2(UT.x, UT.y); pu.y = cvt2(UT.z, UT.w); pu.z = 0u; pu.w = 0u;
    const bf16x8 ubf = __builtin_bit_cast(bf16x8, pu);
    f32x4 Y = __builtin_amdgcn_mfma_f32_16x16x32_bf16(B.rtf[0], sb[0], z4, 0, 0, 0);
    Y = __builtin_amdgcn_mfma_f32_16x16x32_bf16(B.rtf[1], sb[1], Y, 0, 0, 0);
    Y = __builtin_amdgcn_mfma_f32_16x16x32_bf16(B.lbrf, ubf, Y, 0, 0, 0);
    Y = __builtin_amdgcn_mfma_f32_16x16x32_bf16(B.lkrf, vb, Y, 0, 0, 0);
    { const int sgn = dir ? -1 : 1; bf16_t* yp = YR + (size_t)(seqrow0(b, dir, c) + sgn * 4 * g) * 256 + h * 64 + vt * 16 + n; const long st = (long)sgn * 256;
#pragma unroll
      for (int r = 0; r < 4; ++r) yp[r * st] = (bf16_t)f2bf(Y[r]); }
#pragma unroll
    for (int dt = 0; dt < 4; ++dt) { f32x4 t = __builtin_amdgcn_mfma_f32_16x16x32_bf16(B.bfr[dt], ubf, Sd[dt], 0, 0, 0); t = __builtin_amdgcn_mfma_f32_16x16x32_bf16(B.kfr[dt], vb, t, 0, 0, 0); Sd[dt] = t * p15[dt]; }
}
__device__ __forceinline__ void scan_rw_seq(const Args& a, LAS unsigned char* lds, int chain, int vt, int lane, const RingSync& rs) {
    const int dir = chain & 1, h = (chain >> 1) & 3, b = chain >> 3;
    bf16_t* YR = (bf16_t*)(a.ws + WS_YRW) + (size_t)dir * MALL * 256;
    f32x4 Sd[4];
#pragma unroll
    for (int i = 0; i < 4; ++i) Sd[i] = (f32x4){0.f, 0.f, 0.f, 0.f};
    RwBuf A, B; f32x4 pa[4], pb[4];
    ring_wait_ready(rs, 0); rw_load(A, pa, lds + RING_OFF, vt, lane); ring_release(rs, vt, 0, lane);
    int pf = ring_peek(rs, 1);
    for (int c = 0; c < DN_NSUB; c += 2) {
        ring_wait_peeked(rs, c + 1, pf); rw_load(B, pb, lds + RING_OFF + ((c + 1) % RING_R) * RING_SLOT, vt, lane); ring_release(rs, vt, c + 1, lane); pf = ring_peek(rs, c + 2);
        rw_step(A, pa, Sd, YR, b, dir, h, vt, c, lane);
        if (c + 2 < DN_NSUB) { ring_wait_peeked(rs, c + 2, pf); rw_load(A, pa, lds + RING_OFF + ((c + 2) % RING_R) * RING_SLOT, vt, lane); ring_release(rs, vt, c + 2, lane); pf = ring_peek(rs, c + 3); }
        rw_step(B, pb, Sd, YR, b, dir, h, vt, c + 1, lane);
    }
}

struct DnBuf { bf16x8 wf[4], qf[4], kf[8], af; f32x4 uv; float gam; };
__device__ __forceinline__ void dn_load(DnBuf& B, const LAS unsigned char* slot, int w, int lane) {
    const LAS unsigned char* ub = slot + lane * 16;
#pragma unroll
    for (int s = 0; s < 4; ++s) { B.wf[s] = *(const LAS bf16x8*)(ub + s * 1024); B.qf[s] = *(const LAS bf16x8*)(ub + 4096 + s * 1024); }
#pragma unroll
    for (int dt = 0; dt < 8; ++dt) { const u32x2 v = *(const volatile LAS u32x2*)(slot + 8192 + dt * 512 + lane * 8); const u32x4 f = {v.x, v.y, 0u, 0u}; B.kf[dt] = __builtin_bit_cast(bf16x8, f); }
    { const u32x2 v = *(const volatile LAS u32x2*)(slot + 12288 + lane * 8); const u32x4 f = {v.x, v.y, 0u, 0u}; B.af = __builtin_bit_cast(bf16x8, f); }
    B.uv = *(const LAS f32x4*)(ub + 13312 + w * 1024);
    B.gam = *(const LAS float*)(slot + 17408);
}
__device__ __forceinline__ void dn_step(const DnBuf& B, f32x4 (&Sd)[8], bf16_t* OD, int b, int dir, int h, int c, int ct, int n, int g) {
    f32x4 ws = {0.f, 0.f, 0.f, 0.f}, qs = ws;
#pragma unroll
    for (int s = 0; s < 4; ++s) { u32x4 p; p.x = cvt2(Sd[2 * s].x, Sd[2 * s].y); p.y = cvt2(Sd[2 * s].z, Sd[2 * s].w); p.z = cvt2(Sd[2 * s + 1].x, Sd[2 * s + 1].y); p.w = cvt2(Sd[2 * s + 1].z, Sd[2 * s + 1].w);
        const bf16x8 sb = __builtin_bit_cast(bf16x8, p);
        ws = __builtin_amdgcn_mfma_f32_16x16x32_bf16(B.wf[s], sb, ws, 0, 0, 0); qs = __builtin_amdgcn_mfma_f32_16x16x32_bf16(B.qf[s], sb, qs, 0, 0, 0); }
    const f32x4 vn = B.uv - ws;
    u32x4 pv; pv.x = cvt2(vn.x, vn.y); pv.y = cvt2(vn.z, vn.w); pv.z = 0u; pv.w = 0u;
    const bf16x8 vb = __builtin_bit_cast(bf16x8, pv);
    const f32x4 o = __builtin_amdgcn_mfma_f32_16x16x32_bf16(B.af, vb, qs, 0, 0, 0);
#pragma unroll
    for (int dt = 0; dt < 8; ++dt) Sd[dt] = __builtin_amdgcn_mfma_f32_16x16x32_bf16(B.kf[dt], vb, Sd[dt] * B.gam, 0, 0, 0);
    { const int sgn = dir ? -1 : 1; bf16_t* op = OD + (size_t)(seqrow0(b, dir, c) + sgn * 4 * g) * 512 + h * 128 + ct * 16 + n; const long st = (long)sgn * 512;
#pragma unroll
      for (int r = 0; r < 4; ++r) op[r * st] = (bf16_t)f2bf(o[r]); }
}
__device__ __forceinline__ void scan_dn_seq(const Args& a, LAS unsigned char* lds, int chain, int ct, int lane, const RingSync& rs) {
    const int dir = chain & 1, h = (chain >> 1) & 3, b = chain >> 3, w = ct & 3;
    const int n = lane & 15, g = lane >> 4;
    bf16_t* OD = (bf16_t*)(a.ws + WS_ODN) + (size_t)dir * MALL * 512;
    f32x4 Sd[8];
#pragma unroll
    for (int i = 0; i < 8; ++i) Sd[i] = (f32x4){0.f, 0.f, 0.f, 0.f};
    DnBuf A, B;
    ring_wait_ready(rs, 0); dn_load(A, lds + RING_OFF, w, lane); ring_release(rs, w, 0, lane);
    int pf = ring_peek(rs, 1);
    for (int c = 0; c < DN_NSUB; c += 2) {
        ring_wait_peeked(rs, c + 1, pf); dn_load(B, lds + RING_OFF + ((c + 1) % RING_R) * RING_SLOT, w, lane); ring_release(rs, w, c + 1, lane); pf = ring_peek(rs, c + 2);
        dn_step(A, Sd, OD, b, dir, h, c, ct, n, g);
        if (c + 2 < DN_NSUB) { ring_wait_peeked(rs, c + 2, pf); dn_load(A, lds + RING_OFF + ((c + 2) % RING_R) * RING_SLOT, w, lane); ring_release(rs, w, c + 2, lane); pf = ring_peek(rs, c + 3); }
        dn_step(B, Sd, OD, b, dir, h, c + 1, ct, n, g);
    }
}

__device__ __forceinline__ void ring_issue(const Args& a, LAS unsigned char* lds, int kind, int chain, int half, int c, int lane) {
    const int dir = chain & 1, h = (chain >> 1) & 3, b = chain >> 3, grp = h >> 1;
    LAS unsigned char* slot = lds + RING_OFF + (c % RING_R) * RING_SLOT;
    const size_t u = (size_t)chain * DN_NSUB + c;
    int gi; const size_t mbase = mb_base(b, dir, c, gi);
#pragma unroll
    for (int p = 0; p < RING_NP; ++p) {
        const int off = p * 1024 + lane * 16; const unsigned char* gp = nullptr;
        if (kind == 0) { if (off < 12800) gp = a.ws + WS_DNC + u * 12800 + off; else if (off >= 13312 && off < 17408) gp = a.ws + WS_DNU + u * 8192 + half * 4096 + (off - 13312); else if (off == 17408) gp = a.ws + WS_DNG + u * 4; }
        else if (kind == 1) { if (p < 5 || (p >= 8 && p < 12)) gp = a.ws + WS_MBC + ((size_t)(b * 2 + grp) * DN_NSUB + gi) * 12288 + off;
            else if (p < 14) gp = a.ws + WS_MXBC + ((mbase + (p - 12) * 8 + (lane >> 3)) * 768 + h * 64) * 2 + (lane & 7) * 16;
            else if (p == 14) gp = a.ws + WS_MDT + mbase * 64 + lane * 16; }
        else { if (off < 10496) gp = a.ws + WS_RWC + u * 10496 + off;
            else if (p >= 11 && p < 13) gp = a.ws + WS_RW + ((size_t)seqrow(b, dir, c * 16 + (p - 11) * 8 + (lane >> 3)) * 1280 + 512 + h * 64) * 2 + (lane & 7) * 16; }
        if (gp) __builtin_amdgcn_global_load_lds((const unsigned*)gp, (LAS unsigned*)(slot + p * 1024), 16, 0, 0);
        else asm volatile("s_nop 0");
    }
}
__device__ __forceinline__ void ring_loader(const Args& a, LAS unsigned char* lds, int kind, int chain, int half, int j, int lane, const RingSync& rs) {
    int c = j;
    ring_issue(a, lds, kind, chain, half, c, lane);
    for (; c < DN_NSUB; c += 4) {
        const int cn = c + 4;
        if (cn < DN_NSUB) {
            if (cn >= RING_R) { unsigned sp = 0; while ((rs.prog[0] < cn - RING_R + 1 || rs.prog[1] < cn - RING_R + 1 || rs.prog[2] < cn - RING_R + 1 || rs.prog[3] < cn - RING_R + 1) && ++sp < (1u << 24)) __builtin_amdgcn_s_sleep(1); }
            ring_issue(a, lds, kind, chain, half, cn, lane);
            if (kind == 0) asm volatile("s_waitcnt vmcnt(18)" ::: "memory"); else if (kind == 1) asm volatile("s_waitcnt vmcnt(12)" ::: "memory"); else asm volatile("s_waitcnt vmcnt(13)" ::: "memory");
        } else asm volatile("s_waitcnt vmcnt(0)" ::: "memory");
        if (lane == 0) rs.lready[j] = c + 1;
    }
}
__device__ __forceinline__ void phase_scan(const Args& a, int L, LAS unsigned char* lds, int tid_, int bid, int G) {
    RingSync rs; rs.prog = (volatile LAS int*)(lds + 4096); rs.lready = (volatile LAS int*)(lds + 4096 + 64);
    for (int item = bid; item < 128; item += G) {
        if (tid_ < 8) { if (tid_ < 4) rs.prog[tid_] = 0; else rs.lready[tid_ - 4] = 0; }
        __syncthreads();
        const int tid = opq(tid_), w = tid >> 6, lane = tid & 63;
        if (item < 64) { const int chain = item >> 1, half = item & 1;
            if (w < 4) scan_dn_seq(a, lds, chain, half * 4 + w, lane, rs); else ring_loader(a, lds, 0, chain, half, w - 4, lane, rs); }
        else if (item < 96) { const int chain = item - 64;
            if (w < 4) scan_mamba_seq(a, lds, chain, w, lane, rs); else ring_loader(a, lds, 1, chain, 0, w - 4, lane, rs); }
        else { const int chain = item - 96;
            if (w < 4) scan_rw_seq(a, lds, chain, w, lane, rs); else ring_loader(a, lds, 2, chain, 0, w - 4, lane, rs); }
        __syncthreads();
    }
    if (PREP_IN_SCAN) { const int tid = opq(tid_); const int wk = G > 128 ? bid - 128 : bid, nwk = G > 128 ? G - 128 : G;
        if (wk >= 0) prep_moe_l1(a, lds, L, wk, nwk, tid >> 6, tid & 63); }
}

struct FnBuf { f32x4 g; u32x2 xs, ym0, ym1, z, od0[2], od1[2], gt[2], yr0, yr1, rr, kk, vv; };
__device__ __forceinline__ void fn_load(FnBuf& B, const Args& a, int row, int lane) {
    const bf16_t* P = (const bf16_t*)(a.ws + WS_P);
    const bf16_t* MX = (const bf16_t*)(a.ws + WS_MXBC); const bf16_t* YM = (const bf16_t*)(a.ws + WS_YM);
    const bf16_t* OD = (const bf16_t*)(a.ws + WS_ODN); const bf16_t* YR = (const bf16_t*)(a.ws + WS_YRW);
    const bf16_t* RW = (const bf16_t*)(a.ws + WS_RW); const float* RG = (const float*)(a.ws + WS_RWG);
    const int c4 = lane * 4;
    B.xs = *(const u32x2*)(MX + (size_t)row * 768 + c4);
    B.ym0 = *(const u32x2*)(YM + (size_t)row * 256 + c4); B.ym1 = *(const u32x2*)(YM + (size_t)(MALL + row) * 256 + c4);
    B.z = *(const u32x2*)(P + (size_t)row * INP + c4);
    int dr = row;
    if (row < NL) { const int b = row >> 12, t = row & 4095; dr = b * 4096 + (t & 63) * 64 + (t >> 6); }
#pragma unroll
    for (int blk = 0; blk < 2; ++blk) { const int ch = blk * 256 + c4;
        B.od0[blk] = *(const u32x2*)(OD + (size_t)dr * 512 + ch); B.od1[blk] = *(const u32x2*)(OD + (size_t)(MALL + dr) * 512 + ch);
        B.gt[blk] = *(const u32x2*)(P + (size_t)row * INP + DN_OFF + 1536 + ch); }
    B.yr0 = *(const u32x2*)(YR + (size_t)row * 256 + c4); B.yr1 = *(const u32x2*)(YR + (size_t)(MALL + row) * 256 + c4);
    const bf16_t* rwp = RW + (size_t)row * 1280 + c4;
    B.rr = *(const u32x2*)rwp; B.kk = *(const u32x2*)(rwp + 256); B.vv = *(const u32x2*)(rwp + 512);
    B.g = *(const f32x4*)(RG + (size_t)row * 256 + c4);
}
__device__ __forceinline__ f32x4 up4(u32x2 v) { return (f32x4){__builtin_bit_cast(float, v.x << 16), __builtin_bit_cast(float, v.x & 0xffff0000u), __builtin_bit_cast(float, v.y << 16), __builtin_bit_cast(float, v.y & 0xffff0000u)}; }
__device__ __forceinline__ void fn_step(const FnBuf& B, const Args& a, int L, int row, int lane) {
    const int c4 = lane * 4;
    bf16_t* yo = (bf16_t*)(a.ws + WS_YMIX) + (size_t)row * D;
    const float dsk = a.in[14][L * 4 + (lane >> 4)];
    const f32x4 nwm = *(const f32x4*)(a.in[15] + L * 256 + c4), nwd0 = *(const f32x4*)(a.in[19] + L * 128 + (c4 & 127)), nwd1 = *(const f32x4*)(a.in[19] + L * 128 + ((256 + c4) & 127));
    const f32x4 lw = *(const f32x4*)(a.in[29] + L * 256 + c4), lb = *(const f32x4*)(a.in[30] + L * 256 + c4), rkw = *(const f32x4*)(a.in[28] + L * 256 + c4);
    {
        f32x4 y = upk4(B.xs) * dsk + upk4(B.ym0) + upk4(B.ym1);
        const f32x4 zz = upk4(B.z);
#pragma unroll
        for (int i = 0; i < 4; ++i) y[i] *= siluf(zz[i]);
        const float ss = grp_sum<32>((y.x * y.x + y.y * y.y) + (y.z * y.z + y.w * y.w));
        const float r = frsq(ss * (1.f / 128.f) + 1e-5f);
        y = y * r * nwm;
        u32x2 pk; pk.x = cvt2(y.x, y.y); pk.y = cvt2(y.z, y.w); *(u32x2*)(yo + c4) = pk;
    }
#pragma unroll
    for (int blk = 0; blk < 2; ++blk) {
        const int ch = blk * 256 + c4;
        f32x4 o = upk4(B.od0[blk]) + upk4(B.od1[blk]);
        const float ss = grp_sum<32>((o.x * o.x + o.y * o.y) + (o.z * o.z + o.w * o.w));
        const float r = frsq(ss * (1.f / 128.f) + 1e-6f);
        const f32x4 nw = blk ? nwd1 : nwd0, gg = upk4(B.gt[blk]);
#pragma unroll
        for (int i = 0; i < 4; ++i) o[i] = o[i] * r * nw[i] * siluf(gg[i]);
        u32x2 pk; pk.x = cvt2(o.x, o.y); pk.y = cvt2(o.z, o.w); *(u32x2*)(yo + 256 + ch) = pk;
    }
    {
        f32x4 y = upk4(B.yr0) + upk4(B.yr1);
        const float mean = grp_sum<16>((y.x + y.y) + (y.z + y.w)) * (1.f / 64.f);
        y = y - mean;
        const float var = grp_sum<16>((y.x * y.x + y.y * y.y) + (y.z * y.z + y.w * y.w)) * (1.f / 64.f);
        const float r = frsq(var + 64e-5f);
        const f32x4 rv = up4(B.rr), kv = up4(B.kk), vv = up4(B.vv);
        const float bs = grp_sum<16>((rv.x * kv.x * rkw.x + rv.y * kv.y * rkw.y) + (rv.z * kv.z * rkw.z + rv.w * kv.w * rkw.w));
        f32x4 o = (y * r * lw + lb + vv * bs) * B.g;
        u32x2 pk; pk.x = cvt2(o.x, o.y); pk.y = cvt2(o.z, o.w); *(u32x2*)(yo + 768 + c4) = pk;
    }
}
__device__ __forceinline__ void phase_finish(const Args& a, int L, int nrows, int lane_, int wave, int bid, int G) {
    const int lane = opq(lane_), r0 = bid * 8 + wave, st = G * 8;
    if (r0 >= nrows) return;
    FnBuf A, B; fn_load(A, a, r0, lane);
    for (int row = r0; row < nrows; row += 2 * st) {
        const int r1 = row + st, r2 = row + 2 * st;
        if (r1 < nrows) fn_load(B, a, r1, lane);
        fn_step(A, a, L, row, lane);
        if (r1 < nrows) { if (r2 < nrows) fn_load(A, a, r2, lane); fn_step(B, a, L, r1, lane); }
    }
}

__device__ __forceinline__ void phase_router(const Args& a, int L, int nrows, const bf16_t* xm, LAS unsigned char* lds, int tid, int lane, int wave, int bid, int G) {
    LAS float* wr = (LAS float*)lds;
    const float* wsrc = a.in[31] + (size_t)L * 1024 * 32;
    for (int i = tid; i < 8192; i += 512) { const f32x4 v = *(const f32x4*)(wsrc + i * 4); const int k = i >> 3, e = (i & 7) * 4;
        wr[(e + 0) * 1024 + k] = v.x; wr[(e + 1) * 1024 + k] = v.y; wr[(e + 2) * 1024 + k] = v.z; wr[(e + 3) * 1024 + k] = v.w; }
    __syncthreads();
    const float* mod = (const float*)(a.ws + WS_MOD) + (size_t)L * 5 * 6144;
    bf16_t* H2 = (bf16_t*)(a.ws + WS_HN);
    int* tok = (int*)(a.ws + WS_TOK + (size_t)L * TOK_STRIDE);
    LAS unsigned* hist = (LAS unsigned*)(lds + RING_BYTES + 2048);
    for (int rep_ = 0; rep_ < REPN(7); ++rep_) {
    __syncthreads();
    if (tid < 32) hist[tid] = 0u;
    for (int i = bid * 512 + tid; i < MAXSLOT; i = opq(i + G * 512)) tok[TK_ROWOF + i] = 0;
    __syncthreads();
    const int eid = (lane & 1) + 2 * ((lane >> 2) & 1) + 4 * ((lane >> 3) & 1) + 8 * ((lane >> 4) & 1) + 16 * ((lane >> 5) & 1);
    const float brt = a.in[32][L * 32 + eid];
    for (int ra = bid * 8 + wave; ra < nrows; ra += 2 * G * 8) {
        const bool hb = ra + G * 8 < nrows; const int rb = hb ? ra + G * 8 : ra;
        const int bia = ra < NL ? (ra >> 12) : 4, bib = rb < NL ? (rb >> 12) : 4;
        f32x4 va[4], vb[4];
        { u32x2 qa[4], qb[4];
#pragma unroll
          for (int j = 0; j < 4; ++j) { qa[j] = *(const u32x2*)(xm + (size_t)ra * D + j * 256 + lane * 4); qb[j] = *(const u32x2*)(xm + (size_t)rb * D + j * 256 + lane * 4); }
          asm volatile("" : "+v"(qa[0]), "+v"(qa[1]), "+v"(qa[2]), "+v"(qa[3]), "+v"(qb[0]), "+v"(qb[1]), "+v"(qb[2]), "+v"(qb[3]));
#pragma unroll
          for (int j = 0; j < 4; ++j) { va[j] = upk4(qa[j]); vb[j] = upk4(qb[j]); } }
        norm_mod_store<true>(va, a.in[7] + L * D, mod + (size_t)bia * 6144 + 3 * 1024, mod + (size_t)bia * 6144 + 4 * 1024, H2 + (size_t)ra * 512, lane);
        norm_mod_store<true>(vb, a.in[7] + L * D, mod + (size_t)bib * 6144 + 3 * 1024, mod + (size_t)bib * 6144 + 4 * 1024, H2 + (size_t)rb * 512, lane);
        float pa[32], pb[32];
#pragma unroll
        for (int e = 0; e < 32; ++e) { float p = 0.f, q = 0.f;
#pragma unroll
            for (int j = 0; j < 4; ++j) { const f32x4 w4 = *(const LAS f32x4*)(wr + e * 1024 + j * 256 + lane * 4);
                p += (va[j].x * w4.x + va[j].y * w4.y) + (va[j].z * w4.z + va[j].w * w4.w); q += (vb[j].x * w4.x + vb[j].y * w4.y) + (vb[j].z * w4.z + vb[j].w * w4.w); }
            pa[e] = p; pb[e] = q; }
        float mine[2];
#pragma unroll
        for (int rr = 0; rr < 2; ++rr) { float (&p)[32] = rr ? pb : pa;
#pragma unroll
            for (int e = 0; e < 16; ++e) { float x = p[e], y = p[e + 16]; pswap32(x, y); p[e] = x + y; }
#pragma unroll
            for (int e = 0; e < 8; ++e) { float x = p[e], y = p[e + 8]; pswap16(x, y); p[e] = x + y; }
#pragma unroll
            for (int e = 0; e < 4; ++e) { const int x = __builtin_bit_cast(int, p[e]), y = __builtin_bit_cast(int, p[e + 4]);
                const int t = __builtin_amdgcn_update_dpp(x, y, 0x128, 0xF, 0xC, false), u = __builtin_amdgcn_update_dpp(y, x, 0x128, 0xF, 0x3, false);
                p[e] = __builtin_bit_cast(float, t) + __builtin_bit_cast(float, u); }
#pragma unroll
            for (int e = 0; e < 2; ++e) { const int x = __builtin_bit_cast(int, p[e]), y = __builtin_bit_cast(int, p[e + 2]);
                const int t = __builtin_amdgcn_update_dpp(x, y, 0x114, 0xF, 0xA, false), u = __builtin_amdgcn_update_dpp(y, x, 0x104, 0xF, 0x5, false);
                p[e] = __builtin_bit_cast(float, t) + __builtin_bit_cast(float, u); }
            float x = p[0], y = p[1];
            x += dppf<0xB1>(x); x += dppf<0x4E>(x); y += dppf<0xB1>(y); y += dppf<0x4E>(y);
            mine[rr] = ((lane & 1) ? y : x) + brt; }
#pragma unroll
        for (int rr = 0; rr < 2; ++rr) if (rr == 0 || hb) { const int row = rr ? rb : ra; float mn = mine[rr];
            float tl[4]; int te[4];
#pragma unroll
            for (int k = 0; k < 4; ++k) { const float m = wave_max(mn); const unsigned long long bal = __ballot(mn == m); const int idx = __ffsll((long long)bal) - 1;
                const int ei = (idx & 1) + 2 * ((idx >> 2) & 1) + 4 * ((idx >> 3) & 1) + 8 * ((idx >> 4) & 1) + 16 * ((idx >> 5) & 1);
                tl[k] = m; te[k] = ei; if (eid == ei) mn = -3.0e38f; }
            const float e1 = __expf(tl[1] - tl[0]), e2 = __expf(tl[2] - tl[0]), e3 = __expf(tl[3] - tl[0]); const float inv = 1.f / (1.f + e1 + e2 + e3);
            if (lane < 4) { const int e = lane == 0 ? te[0] : lane == 1 ? te[1] : lane == 2 ? te[2] : te[3];
                const float g = (lane == 0 ? 1.f : lane == 1 ? e1 : lane == 2 ? e2 : e3) * inv;
                const unsigned pos = __hip_atomic_fetch_add(hist + e, 1u, __ATOMIC_RELAXED, __HIP_MEMORY_SCOPE_WORKGROUP);
                tok[TK_E + row * 4 + lane] = e; ((float*)tok)[TK_G + row * 4 + lane] = g; tok[TK_POS + row * 4 + lane] = (int)pos; } }
    }
    }
    __syncthreads();
    if (tid < 32) tok[TK_BCNT + bid * 32 + tid] = (int)hist[tid];
}
__device__ __forceinline__ void phase_scatter(const Args& a, int L, int nrows, LAS unsigned char* lds, int tid, int lane, int wave, int bid, int G) {
    LAS int* ps = (LAS int*)lds;
    int* tok = (int*)(a.ws + WS_TOK + (size_t)L * TOK_STRIDE);
    if (tid < 32) { int tot = 0, off = 0; for (int b = 0; b < G; ++b) { const int c = tok[TK_BCNT + b * 32 + tid]; tot += c; off += (b < bid) ? c : 0; } ps[64 + tid] = tot; ps[128 + tid] = off; }
    __syncthreads();
    if (tid == 0) { int acc = 0; for (int e = 0; e < 32; ++e) { ps[e] = acc; acc += (ps[64 + e] + 255) & ~255; } ps[32] = acc; }
    __syncthreads();
    if (tid < 32) ps[128 + tid] += ps[tid];
    if (bid == 0) { const int nblk = ps[32] >> 8;
        for (int m = tid; m < MAXBLK; m += 512) { int e = 0; for (int q = 1; q < 32; ++q) if ((m << 8) >= ps[q]) e = q; tok[TK_BLKE + m] = e; }
        if (tid == 0) tok[TK_NBLK] = nblk; }
    __syncthreads();
    for (int row = bid * 8 + wave; row < nrows; row = opq(row + G * 8)) if (lane < 4) { const int i = row * 4 + lane; const int e = tok[TK_E + i], pos = tok[TK_POS + i]; const int slot = ps[128 + e] + pos; tok[TK_SLOT + i] = slot; tok[TK_ROWOF + slot] = row; }
}
struct CbTok { int slot[4]; float g[4]; };
struct CbBuf { unsigned y[4][4]; u32x2 x[4]; float g[4]; };
__device__ __forceinline__ void cb_tok(CbTok& T, const int* tok, int row) {
#pragma unroll
    for (int k = 0; k < 4; ++k) { T.slot[k] = tok[TK_SLOT + row * 4 + k]; T.g[k] = ((const float*)tok)[TK_G + row * 4 + k]; }
}
__device__ __forceinline__ void cb_load(CbBuf& B, const CbTok& T, const unsigned char* Y, const bf16_t* xm, int row, int lane) {
#pragma unroll
    for (int k = 0; k < 4; ++k) { B.g[k] = T.g[k];
#pragma unroll
        for (int j = 0; j < 4; ++j) B.y[k][j] = *(const unsigned*)(Y + (size_t)T.slot[k] * D + j * 256 + lane * 4); }
#pragma unroll
    for (int j = 0; j < 4; ++j) B.x[j] = *(const u32x2*)(xm + (size_t)row * D + j * 256 + lane * 4);
}
__device__ __forceinline__ void cb_finish(const CbBuf& B, const Args& a, int L, const float* mod, int row, int lane) {
    const int bi = row < NL ? (row >> 12) : 4;
    f32x4 v[4], gt5[4], nfw[4];
#pragma unroll
    for (int j = 0; j < 4; ++j) { gt5[j] = *(const f32x4*)(mod + (size_t)bi * 6144 + 5 * 1024 + j * 256 + lane * 4); if (L != 0) nfw[j] = *(const f32x4*)(a.in[37] + j * 256 + lane * 4); }
#pragma unroll
    for (int j = 0; j < 4; ++j) { f32x4 acc = {0.f, 0.f, 0.f, 0.f};
#pragma unroll
        for (int k = 0; k < 4; ++k) { const unsigned yv = B.y[k][j]; const f32x2v ylo = __builtin_amdgcn_cvt_pk_f32_fp8((int)yv, false), yhi = __builtin_amdgcn_cvt_pk_f32_fp8((int)yv, true);
            acc += (f32x4){ylo.x, ylo.y, yhi.x, yhi.y} * B.g[k]; }
        v[j] = upk4(B.x[j]) + gt5[j] * acc; }
    if (L == 0) {
        bf16_t* xb = (bf16_t*)(a.ws + WS_XB) + (size_t)row * D;
#pragma unroll
        for (int j = 0; j < 4; ++j) *(u32x2*)(xb + j * 256 + lane * 4) = pk4(v[j]);
        const float* mod1 = (const float*)(a.ws + WS_MOD) + (size_t)5 * 6144;
        norm_mod_store(v, a.in[6] + D, mod1 + (size_t)bi * 6144, mod1 + (size_t)bi * 6144 + 1024, (bf16_t*)(a.ws + WS_HN) + (size_t)row * D, lane);
    } else {
        float ss = 0.f;
#pragma unroll
        for (int j = 0; j < 4; ++j) ss += (v[j].x * v[j].x + v[j].y * v[j].y) + (v[j].z * v[j].z + v[j].w * v[j].w);
        const float r = frsq(wave_sum(ss) * (1.f / D) + 1e-6f);
#pragma unroll
        for (int j = 0; j < 4; ++j) { const int c = j * 256 + lane * 4; *(f32x4*)(a.out + (size_t)row * D + c) = v[j] * r * nfw[j]; }
    }
}
__device__ __forceinline__ void phase_combine(const Args& a, int L, int nrows, const bf16_t* xm, int lane_, int wave, int bid, int G) {
    const float* mod = (const float*)(a.ws + WS_MOD) + (size_t)L * 5 * 6144;
    const int* tok = (const int*)(a.ws + WS_TOK + (size_t)L * TOK_STRIDE);
    const unsigned char* Y = (const unsigned char*)(a.ws + WS_Y);
    const int lane = opq(lane_), r0 = bid * 8 + wave, st = G * 8;
    if (r0 >= nrows) return;
    CbTok T0, T1; CbBuf A, B;
    cb_tok(T0, tok, r0); cb_load(A, T0, Y, xm, r0, lane);
    if (r0 + st < nrows) cb_tok(T1, tok, r0 + st);
    for (int row = r0; row < nrows; row += 2 * st) {
        const int r1 = row + st, r2 = row + 2 * st, r3 = row + 3 * st;
        if (r1 < nrows) cb_load(B, T1, Y, xm, r1, lane);
        if (r2 < nrows) cb_tok(T0, tok, r2);
        cb_finish(A, a, L, mod, row, lane);
        if (r1 < nrows) {
            if (r2 < nrows) cb_load(A, T0, Y, xm, r2, lane);
            if (r3 < nrows) cb_tok(T1, tok, r3);
            cb_finish(B, a, L, mod, r1, lane);
        }
    }
}

__global__ void __launch_bounds__(512, 2) fwd_kernel(Args a) {
    extern __shared__ __attribute__((aligned(16))) unsigned char lds_raw[];
    LAS unsigned char* lds = (LAS unsigned char*)lds_raw;
    const int wave0 = __builtin_amdgcn_readfirstlane((int)threadIdx.x >> 6), bid = blockIdx.x, G = gridDim.x;
    const int tid0 = threadIdx.x;
    volatile LAS unsigned* MISC = (volatile LAS unsigned*)(lds + MISC_OFF);
    for (int u = tid0; u < (LDS_BYTES - RING_BYTES) / 4; u += 512) ((LAS unsigned*)(lds + RING_BYTES))[u] = 0u;
    __syncthreads();
    const int lo = a.ph_lo, hi = a.ph_hi;
    XcdBarrier bar; bar.bar = (unsigned*)(a.ws + WS_CTL) + CW_BAR; bar.x = 0; bar.st = nullptr;
    if (hi - lo > 1) bar = xcd_barrier_post((unsigned*)(a.ws + WS_CTL) + CW_BAR, MISC + 8);
#define IN(k) (lo <= (k) && (k) < hi)
#define SEAM(k) do { if (IN(k) && IN((k) + 1)) xcd_barrier(bar); } while (0)

#define PH_IDS const int lane = lane_id_v(), wave = wave0, tid = wave0 * 64 + lane
    if (IN(0)) for (int rep_ = 0; rep_ < REPN(0); ++rep_) { PH_IDS; phase_prep(a, lds, tid, lane, wave, bid, G); __syncthreads(); }
    SEAM(0);
    if (IN(1)) { PH_IDS; phase_norm1(a, 0, a.in[0], a.in[2], lane, wave, bid, G); }
    SEAM(1);
    for (int L = 0; L < 2; ++L) {
        const int pb = 2 + L * 10;
        const void* xl = L == 0 ? (const void*)a.in[0] : (const void*)(a.ws + WS_XB);
        const void* xc = L == 0 ? (const void*)a.in[2] : (const void*)((const bf16_t*)(a.ws + WS_XB) + (size_t)NL * D);
        const int nrows = L == 0 ? MALL : NL;
        bf16_t* xm = (bf16_t*)(a.ws + WS_XA);
        int* tok = (int*)(a.ws + WS_TOK + (size_t)L * TOK_STRIDE);
        if (IN(pb + 0)) for (int rep_ = 0; rep_ < REPN(2); ++rep_) {
            pg8::StaticSched S; S.init((const bf16_t*)(a.ws + WS_HN), (const bf16_t*)(a.ws + WS_WIN) + (size_t)L * INP * 1024, MALL, INP, 1024, G, bid);
            EpiP E{(bf16_t*)(a.ws + WS_P)};
            pg8::gemm_phase<EpiP, pg8::StaticSched, false, 2>(lds, 1024, S, E, wave0, STG_IN);
        }
        SEAM(pb + 0);
        if (IN(pb + 1)) for (int rep_ = 0; rep_ < REPN(3); ++rep_) { PH_IDS; phase_mixprep(a, L, lds, lane, wave, bid, G); }
        SEAM(pb + 1);
        if (IN(pb + 2)) for (int rep_ = 0; rep_ < REPN(4); ++rep_) { for (int r2_ = 0; r2_ < 1 + (PROBE_SCAN & 1); ++r2_) { PH_IDS; for (int r3_ = 0; r3_ < 1 + ((PROBE_SCAN >> 2) & 1); ++r3_) phase_dnpre(a, lds, lane, wave, bid, G); for (int r3_ = 0; r3_ < 1 + ((PROBE_SCAN >> 3) & 1); ++r3_) phase_mbpre(a, lane, wave, bid, G); for (int r3_ = 0; r3_ < 1 + ((PROBE_SCAN >> 4) & 1); ++r3_) phase_rwpre(a, lds, lane, wave, bid, G); } if (hi - lo > 1) xcd_barrier(bar); for (int r2_ = 0; r2_ < 1 + ((PROBE_SCAN >> 1) & 1); ++r2_) { PH_IDS; phase_scan(a, L, lds, tid, bid, G); } }
        SEAM(pb + 2);
        if (IN(pb + 3)) for (int rep_ = 0; rep_ < REPN(5); ++rep_) { PH_IDS; phase_finish(a, L, nrows, lane, wave, bid, G); }
        SEAM(pb + 3);
        if (IN(pb + 4)) for (int rep_ = 0; rep_ < REPN(6); ++rep_) {
            pg8::StaticSched S; S.init((const bf16_t*)(a.ws + WS_YMIX), (const bf16_t*)(a.ws + WS_WOUT) + (size_t)L * 1024 * 1024, nrows, 1024, 1024, G, bid);
            EpiOut E{xl, xc, xm, (const float*)(a.ws + WS_MOD) + (size_t)L * 5 * 6144 + 2 * 1024, L};
            pg8::gemm_phase<EpiOut, pg8::StaticSched, false, 6>(lds, 1024, S, E, wave0);
        }
        SEAM(pb + 4);
        if (IN(pb + 5)) { PH_IDS; phase_router(a, L, nrows, xm, lds, tid, lane, wave, bid, G); }
        SEAM(pb + 5);
        if (IN(pb + 6)) for (int rep_ = 0; rep_ < REPN(8); ++rep_) { PH_IDS; phase_scatter(a, L, nrows, lds, tid, lane, wave, bid, G); __syncthreads(); }
        SEAM(pb + 6);
        if (IN(pb + 7)) for (int rep_ = 0; rep_ < REPN(9); ++rep_) {
            pg8::MoeSched S; S.nN = 8; S.nunits = tok[TK_NBLK] * 8; S.G = G; S.c = bid; S.A = (const char*)(a.ws + WS_HN); S.rowof = tok + TK_ROWOF; S.W = (const char*)(a.ws + WS_WGU) + (size_t)L * 32 * 2048 * 1024;
            S.tstep = (size_t)256 * 1024; S.astep = 0; S.estride = (size_t)2048 * 1024; S.blk_e = tok + TK_BLKE;
            EpiGU E{(unsigned char*)(a.ws + WS_ACT), a.in[34] + (size_t)L * 32 * 2048, tok + TK_BLKE};
            pg8::gemm_phase<EpiGU, pg8::MoeSched, true, 9, true>(lds, 512, S, E, wave0);
        }
        SEAM(pb + 7);
        if (IN(pb + 8)) for (int rep_ = 0; rep_ < REPN(10); ++rep_) {
            pg8::MoeSched S; S.nN = 4; S.nunits = tok[TK_NBLK] * 4; S.G = G; S.c = bid; S.A = (const char*)(a.ws + WS_ACT); S.W = (const char*)(a.ws + WS_WD) + (size_t)L * 32 * 1024 * 1024;
            S.tstep = (size_t)256 * 1024; S.astep = S.tstep; S.rowof = nullptr; S.estride = (size_t)1024 * 1024; S.blk_e = tok + TK_BLKE;
            EpiDown E{(unsigned char*)(a.ws + WS_Y), a.in[36] + (size_t)L * 32 * 1024, tok + TK_BLKE};
            pg8::gemm_phase<EpiDown, pg8::MoeSched, true, 10>(lds, 512, S, E, wave0, STG_DN);
        }
        SEAM(pb + 8);
        if (IN(pb + 9)) for (int rep_ = 0; rep_ < REPN(11); ++rep_) { PH_IDS; phase_combine(a, L, nrows, xm, lane, wave, bid, G); }
        SEAM(pb + 9);
    }
#undef IN
#undef SEAM
}

extern "C" void kernel_launch(void* const* d_in, const int* in_sizes, int n_in, void* d_out, int out_size, void* d_ws, size_t ws_size, hipStream_t stream) {
    static int grid = 0;
    if (grid == 0) {
        if (n_in != 38 || ws_size < WS_END) { fprintf(stderr, "kernel_launch: unexpected n_in %d / ws %zu\n", n_in, ws_size); grid = -1; return; }
        int dev = 0, cus = 0, per_cu = 0;
        if (hipGetDevice(&dev) != hipSuccess || hipDeviceGetAttribute(&cus, hipDeviceAttributeMultiprocessorCount, dev) != hipSuccess) { grid = -1; return; }
        if (hipFuncSetAttribute((const void*)fwd_kernel, hipFuncAttributeMaxDynamicSharedMemorySize, LDS_BYTES) != hipSuccess) { fprintf(stderr, "kernel_launch: hipFuncSetAttribute failed\n"); grid = -1; return; }
        if (hipOccupancyMaxActiveBlocksPerMultiprocessor(&per_cu, (const void*)fwd_kernel, 512, LDS_BYTES) != hipSuccess || per_cu < 1) { fprintf(stderr, "kernel_launch: occupancy query says %d\n", per_cu); }
        (void)hipGetLastError();
        grid = cus;
    }
    if (grid < 0) return;
    (void)hipMemsetAsync((char*)d_ws + WS_CTL, 0, CTL_BYTES, stream);
    Args a{};
    for (int i = 0; i < 38; ++i) a.in[i] = (const float*)d_in[i];
    a.out = (float*)d_out; a.ws = (unsigned char*)d_ws;
#if MK_PER_PHASE
    for (int p = 0; p < NPHASE; ++p) { a.ph_lo = p; a.ph_hi = p + 1; hipLaunchKernelGGL(fwd_kernel, dim3(grid), dim3(512), LDS_BYTES, stream, a); }
#else
    a.ph_lo = 0; a.ph_hi = NPHASE;
    hipLaunchKernelGGL(fwd_kernel, dim3(grid), dim3(512), LDS_BYTES, stream, a);
#endif
}
```
